# Optimizing an MI355X kernel written in HIP

```python
import jax, jax.numpy as jnp
from jax import lax
import numpy as np

D_MODEL = 1024
BATCH = 32
SEQ = 2048
DEPTH = 1

HEAD_DIM = 64
RWKV_HEADS = 8
RWKV_WIDTH = RWKV_HEADS * HEAD_DIM
ATT_HEADS = 8
ATT_KV_HEADS = 2
ATT_GROUP = ATT_HEADS // ATT_KV_HEADS
ATT_WIDTH = ATT_HEADS * HEAD_DIM
ATT_KV_WIDTH = ATT_KV_HEADS * HEAD_DIM
DECAY_LORA = 64
ICLR_LORA = 64
N_DIR = 2
WINDOW = 128
BLOCK = 128
N_BRANCH = 2
NORM_EPS = 1e-6
GN_EPS = 64e-5

RWKV_COLS = 4 * RWKV_WIDTH + N_DIR * (DECAY_LORA + ICLR_LORA)
ATT_COLS = 2 * ATT_WIDTH + 2 * ATT_KV_WIDTH
GATE_COLS = N_BRANCH * D_MODEL
IN_COLS = RWKV_COLS + ATT_COLS + GATE_COLS

kernel_name = "hybrid_rwkv7_swa_gated_block"


def rms_norm(t, g):
    tf = t.astype(jnp.float32)
    tf = tf * lax.rsqrt(jnp.mean(tf * tf, axis=-1, keepdims=True) + NORM_EPS)
    return (tf * g.astype(jnp.float32)).astype(t.dtype)


def alibi_slopes(n_heads):
    return jnp.exp2(-8.0 * jnp.arange(1, n_heads + 1, dtype=jnp.float32) / n_heads)


def rwkv7_bidir(p, mu, w0, w_up, a0, a_up, k_k, k_a, r_k, gn_w, gn_b):
    B, S, _ = p.shape
    f32 = jnp.float32
    p = p.astype(f32)
    p_prev = jnp.pad(p, ((0, 0), (1, 0), (0, 0)))[:, :-1]
    p_next = jnp.pad(p, ((0, 0), (0, 1), (0, 0)))[:, 1:]
    mu = mu.astype(f32)
    p = p + mu[0] * (p_prev - p) + mu[1] * (p_next - p)
    W = RWKV_WIDTH
    r, k, v, g = jnp.split(p[..., :4 * W], 4, axis=-1)
    lo = p[..., 4 * W:]
    w_lo = lo[..., :N_DIR * DECAY_LORA].reshape(B, S, N_DIR, DECAY_LORA)
    a_lo = lo[..., N_DIR * DECAY_LORA:].reshape(B, S, N_DIR, ICLR_LORA)
    w_raw = w0.astype(f32)[:, None, None, :] + jnp.einsum('bsdr,drc->dbsc', jnp.tanh(w_lo), w_up.astype(f32))
    decay = jnp.exp(-jnp.exp(-jax.nn.softplus(-w_raw) - 0.5))
    a = jax.nn.sigmoid(a0.astype(f32)[:, None, None, :] + jnp.einsum('bsdr,drc->dbsc', a_lo, a_up.astype(f32)))
    kk = (k * k_k.astype(f32)).reshape(B, S, RWKV_HEADS, HEAD_DIM)
    kk = kk / jnp.maximum(jnp.sqrt(jnp.sum(kk * kk, axis=-1, keepdims=True)), 1e-12)
    k_dir = k[None] * (1.0 + (a - 1.0) * k_a.astype(f32))

    hs = lambda t: t.reshape(t.shape[:-1] + (RWKV_HEADS, HEAD_DIM))
    r_h, v_h = hs(r), hs(v)
    decay_h, a_h, k_h = hs(decay), hs(a), hs(k_dir)

    both = lambda t: jnp.stack([t, jnp.flip(t, axis=1)])
    order = lambda t: jnp.stack([t[0], jnp.flip(t[1], axis=1)])
    tm = lambda t: jnp.moveaxis(t, 2, 0)
    xs = (tm(both(r_h)), tm(order(decay_h)), tm(order(k_h)), tm(both(v_h)),
          tm(both(kk)), tm(order(a_h)))

    def step(state, inp):
        r_t, w_t, k_t, v_t, kk_t, a_t = inp
        sa = jnp.einsum('dbhij,dbhj->dbhi', state, kk_t)
        state = (state * w_t[..., None, :]
                 - sa[..., :, None] * (kk_t * a_t)[..., None, :]
                 + v_t[..., :, None] * k_t[..., None, :])
        y = jnp.einsum('dbhij,dbhj->dbhi', state, r_t)
        return state, y

    state0 = jnp.zeros((N_DIR, B, RWKV_HEADS, HEAD_DIM, HEAD_DIM), f32)
    _, ys = lax.scan(step, state0, xs)
    ys = jnp.moveaxis(ys, 0, 2)
    y = ys[0] + jnp.flip(ys[1], axis=1)
    mean = jnp.mean(y, axis=-1, keepdims=True)
    var = jnp.mean(jnp.square(y - mean), axis=-1, keepdims=True)
    y = (y - mean) * lax.rsqrt(var + GN_EPS)
    y = y * hs(gn_w.astype(f32)) + hs(gn_b.astype(f32))
    bonus = jnp.sum(jnp.sum(r_h[None] * k_h * r_k.astype(f32), axis=-1, keepdims=True) * v_h[None], axis=0)
    out = (y + bonus).reshape(B, S, W) * jax.nn.silu(g)
    return out


def windowed_gqa_sink(p, slopes, sink):
    B, S, _ = p.shape
    f32 = jnp.float32
    q = p[..., :ATT_WIDTH].reshape(B, S, ATT_KV_HEADS, ATT_GROUP, HEAD_DIM)
    k = p[..., ATT_WIDTH:ATT_WIDTH + ATT_KV_WIDTH].reshape(B, S, ATT_KV_HEADS, HEAD_DIM)
    v = p[..., ATT_WIDTH + ATT_KV_WIDTH:ATT_WIDTH + 2 * ATT_KV_WIDTH].reshape(B, S, ATT_KV_HEADS, HEAD_DIM)
    g = p[..., ATT_WIDTH + 2 * ATT_KV_WIDTH:]
    pad = ((0, 0), (BLOCK, BLOCK), (0, 0), (0, 0))
    k_pad = jnp.pad(k, pad)
    v_pad = jnp.pad(v, pad)
    n_blocks = S // BLOCK
    rel_q = jnp.arange(BLOCK)
    rel_k = jnp.arange(3 * BLOCK) - BLOCK
    dist = jnp.abs(rel_q[:, None] - rel_k[None, :])
    in_win = dist <= WINDOW
    bias = -slopes.reshape(ATT_KV_HEADS, ATT_GROUP)[:, :, None, None] * dist.astype(f32)
    sink_l = sink.astype(f32).reshape(ATT_KV_HEADS, ATT_GROUP)[None, :, :, None, None]
    scale = HEAD_DIM ** -0.5

    def block(i):
        start = i * BLOCK
        q_b = lax.dynamic_slice_in_dim(q, start, BLOCK, axis=1)
        k_b = lax.dynamic_slice_in_dim(k_pad, start, 3 * BLOCK, axis=1)
        v_b = lax.dynamic_slice_in_dim(v_pad, start, 3 * BLOCK, axis=1)
        kpos = start + rel_k
        valid = in_win & ((kpos >= 0) & (kpos < S))[None, :]
        s = jnp.einsum('bqkgd,bskd->bkgqs', q_b, k_b).astype(f32) * scale + bias
        s = jnp.where(valid, s, -1e30)
        sk = jnp.broadcast_to(sink_l, s.shape[:-1] + (1,))
        prob = jax.nn.softmax(jnp.concatenate([s, sk], axis=-1), axis=-1)[..., :-1]
        return jnp.einsum('bkgqs,bskd->bqkgd', prob.astype(v.dtype), v_b)

    o = lax.map(block, jnp.arange(n_blocks))
    o = jnp.moveaxis(o, 0, 1).reshape(B, S, ATT_WIDTH)
    return o * jax.nn.silu(g)


def setup_inputs(seed: int = 0) -> dict:
    key = jax.random.key(seed)
    ks = jax.random.split(key, 24)
    f32 = jnp.float32
    nrm = lambda k, shape, s: jax.random.normal(k, shape, f32) * s
    L, D, W = DEPTH, D_MODEL, RWKV_WIDTH
    return {
        "x": nrm(ks[0], (BATCH, SEQ, D), 1.0),
        "c": nrm(ks[1], (BATCH, D), 1.0),
        "w_ada": nrm(ks[2], (L, D, 3 * D), D ** -0.5),
        "b_ada": nrm(ks[3], (L, 3 * D), 0.01),
        "g_pre": 1.0 + nrm(ks[4], (L, D), 0.02),
        "g_post": 1.0 + nrm(ks[5], (L, D), 0.02),
        "w_in": nrm(ks[6], (L, D, IN_COLS), D ** -0.5),
        "mu_shift": jax.random.uniform(ks[7], (L, 2, RWKV_COLS), f32, 0.0, 0.5),
        "w0": nrm(ks[8], (L, N_DIR, W), 0.5) + 0.5,
        "w_up": nrm(ks[9], (L, N_DIR, DECAY_LORA, W), 0.5 * DECAY_LORA ** -0.5),
        "a0": nrm(ks[10], (L, N_DIR, W), 0.3),
        "a_up": nrm(ks[11], (L, N_DIR, ICLR_LORA, W), 0.5 * ICLR_LORA ** -0.5),
        "k_k": 0.85 + nrm(ks[12], (L, W), 0.05),
        "k_a": 1.0 + nrm(ks[13], (L, W), 0.05),
        "r_k": nrm(ks[14], (L, RWKV_HEADS, HEAD_DIM), 0.1),
        "gn_w": 1.0 + nrm(ks[15], (L, W), 0.02),
        "gn_b": nrm(ks[16], (L, W), 0.01),
        "sink": nrm(ks[17], (L, ATT_HEADS), 1.0),
        "w_br_rwkv": nrm(ks[18], (L, W, D), W ** -0.5),
        "w_br_att": nrm(ks[19], (L, ATT_WIDTH, D), ATT_WIDTH ** -0.5),
        "w_out": nrm(ks[20], (L, D, D), D ** -0.5),
    }


def reference(x, c, w_ada, b_ada, g_pre, g_post, w_in, mu_shift, w0, w_up, a0, a_up,
              k_k, k_a, r_k, gn_w, gn_b, sink, w_br_rwkv, w_br_att, w_out):
    slopes = alibi_slopes(ATT_HEADS)
    cond = jax.nn.silu(c)
    for l in range(DEPTH):
        ada = cond @ w_ada[l] + b_ada[l]
        shift, scale, gate = jnp.split(ada, 3, axis=-1)
        h = rms_norm(x, g_pre[l]) * (1.0 + scale[:, None, :]) + shift[:, None, :]
        p = h @ w_in[l]
        p_rwkv = p[..., :RWKV_COLS]
        p_att = p[..., RWKV_COLS:RWKV_COLS + ATT_COLS]
        gate_logits = p[..., RWKV_COLS + ATT_COLS:]
        y_r = rwkv7_bidir(p_rwkv, mu_shift[l], w0[l], w_up[l], a0[l], a_up[l],
                          k_k[l], k_a[l], r_k[l], gn_w[l], gn_b[l]).astype(x.dtype)
        y_a = windowed_gqa_sink(p_att, slopes, sink[l])
        br_r = y_r @ w_br_rwkv[l]
        br_a = y_a @ w_br_att[l]
        g_r, g_a = jnp.split(jax.nn.sigmoid(gate_logits), 2, axis=-1)
        out = (g_r * br_r + g_a * br_a) @ w_out[l]
        x = x + gate[:, None, :] * rms_norm(out, g_post[l])
    return x
```

```cpp
#include <hip/hip_runtime.h>
#include <cstdio>
#include <cstdint>
namespace pg8 {
#define PG8_LAS __attribute__((address_space(3)))
typedef unsigned short bf16_t;
typedef short bf16x8 __attribute__((ext_vector_type(8)));
typedef float f32x4 __attribute__((ext_vector_type(4)));
typedef unsigned u32x4 __attribute__((ext_vector_type(4)));
constexpr int BM = 256, BK = 64, HALF = 128, HTB = HALF * BK * 2  , STAGE_BYTES = 8 * HTB, NXCD = 8, WGM = 8;

__host__ __device__ __forceinline__ int lds_byte(int r, int c) { const int st = (r >> 4) * 2 + (c >> 5), rr = r & 15, cc = c & 31, ob = rr * 64 + cc * 2; return st * 1024 + (ob ^ (((ob >> 9) & 1) << 5)); }
__host__ __device__ __forceinline__ void stage_rc(int b, int& R, int& C) { const int st = b / 1024, sb = b % 1024, swz = sb ^ (((sb >> 9) & 1) << 5); R = (st >> 1) * 16 + swz / 64; C = (st & 1) * 32 + (swz % 64) / 2; }
__host__ __device__ __forceinline__ int perm32(int rho) { const int n = rho >> 4, i = rho & 15; return 8 * (i >> 2) + 4 * n + (i & 3); }

struct Unit { int pm, pn; };
struct Gemm { const bf16_t* A; const bf16_t* Bt; int M, N, K, lda; };

struct StaticOrder {
    int nM, nN, nwg, G, c;
    __host__ __device__ void init(int M, int N, int G_, int c_) { nM = M / BM; nN = N / BM; nwg = nM * nN; G = G_; c = c_; }
    __host__ __device__ bool next(int i, Unit& u) const {
        const long L = (long)i * G + c; if (L >= nwg) return false;
        int wgid = (int)L; { const int q = nwg / NXCD, r = nwg % NXCD, xcd = wgid % NXCD, off = wgid / NXCD; wgid = (xcd < r ? xcd * (q + 1) : r * (q + 1) + (xcd - r) * q) + off; }
        const int nig = WGM * nN, gid = wgid / nig, fm = gid * WGM, gsz = (nM - fm) < WGM ? (nM - fm) : WGM;
        u.pm = fm + ((wgid % nig) % gsz); u.pn = (wgid % nig) / gsz; return true;
    }
    __device__ __forceinline__ void a_ready(const Unit&) const {}
    __device__ __forceinline__ void done(const Unit&) const {}
};

__device__ __forceinline__ unsigned cvt_pk_bf16(float lo, float hi) { unsigned r; asm volatile("v_cvt_pk_bf16_f32 %0, %1, %2" : "=v"(r) : "v"(lo), "v"(hi)); return r; }
typedef float f32x2 __attribute__((ext_vector_type(2)));
__device__ __forceinline__ f32x2 gelu_pk(f32x2 v) {
    const f32x2 av = __builtin_elementwise_abs(v), d = av * 0.2316418882f + 1.0f;
    f32x2 t; t.x = __builtin_amdgcn_rcpf(d.x); t.y = __builtin_amdgcn_rcpf(d.y);
    f32x2 q = t * 0.5307027145f + (-0.7265760135f); q = q * t + 0.7107068705f; q = q * t + (-0.142248368f); q = q * t + 0.127414796f; q = q * t;
    const f32x2 s = (v * v) * (-0.72134752044f);
    f32x2 e; e.x = __builtin_amdgcn_exp2f(s.x); e.y = __builtin_amdgcn_exp2f(s.y);
    const f32x2 m = v * (q * e), r = v - m;
    f32x2 o; o.x = v.x < 0.f ? m.x : r.x; o.y = v.y < 0.f ? m.y : r.y; return o;
}

template <int ACT  > struct EpiBf16 {
    static constexpr bool PERM = true, AFTER_DRAIN = false; static_assert(ACT == 0 || ACT == 1, "EpiBf16: ACT is 0 (none) or 1 (gelu_pk)");
    bf16_t* O; int ldc; const float* bias; int split_cols; size_t split_stride; float scale0;
    __device__ __forceinline__ void operator()(const f32x4 (&acc)[2][2][4][2], const Unit& u, int wr, int wc, int fr, int fq) const {
        const int row0 = u.pm * BM + wr * 64 + fr; int colt = u.pn * BM; bf16_t* base = O;
        float sc = 1.f; if (split_cols) { const int t = colt / split_cols; base += (size_t)t * split_stride; colt -= t * split_cols; if (t == 0) sc = scale0; }
        const int col0 = colt + wc * 32 + 8 * fq, bcol0 = u.pn * BM + wc * 32 + 8 * fq;
        f32x4 bv[2][2];
#pragma unroll
        for (int bj = 0; bj < 2; ++bj)
#pragma unroll
            for (int n = 0; n < 2; ++n) bv[bj][n] = bias ? *(const f32x4*)(bias + bcol0 + bj * HALF + 4 * n) : (f32x4){0.f, 0.f, 0.f, 0.f};
#pragma unroll
        for (int ai = 0; ai < 2; ++ai)
#pragma unroll
            for (int m = 0; m < 4; ++m) { bf16_t* rowp = base + (size_t)(row0 + ai * HALF + m * 16) * ldc + col0;
#pragma unroll
                for (int bj = 0; bj < 2; ++bj) { f32x4 v0 = acc[ai][bj][m][0] + bv[bj][0], v1 = acc[ai][bj][m][1] + bv[bj][1];
                    if (ACT == 1) { f32x2 a = gelu_pk((f32x2){v0[0], v0[1]}), b = gelu_pk((f32x2){v0[2], v0[3]}), c = gelu_pk((f32x2){v1[0], v1[1]}), d = gelu_pk((f32x2){v1[2], v1[3]});
                        v0 = (f32x4){a.x, a.y, b.x, b.y}; v1 = (f32x4){c.x, c.y, d.x, d.y}; }
                    v0 = v0 * sc; v1 = v1 * sc; u32x4 w; w.x = cvt_pk_bf16(v0[0], v0[1]); w.y = cvt_pk_bf16(v0[2], v0[3]); w.z = cvt_pk_bf16(v1[0], v1[1]); w.w = cvt_pk_bf16(v1[2], v1[3]);
                    *(u32x4*)(rowp + bj * HALF) = w; } }
    }
};
template <class Epi, class Sched, bool ALIGN_EPI = false, bool SP2 = false>
__device__ __forceinline__ void gemm_phase(PG8_LAS unsigned char* lds, const Gemm g, const Sched& S, const Epi& E) {
    const int tid = threadIdx.x, wid = __builtin_amdgcn_readfirstlane(tid >> 6), lane = tid & 63, wr = wid >> 2, wc = wid & 3, fr = lane & 15, fq = lane >> 4;
    const int K = g.K, nt = K / BK;
    unsigned voffA[2], voffB[2];
#pragma unroll
    for (int i = 0; i < 2; ++i) { int R, C; stage_rc(tid * 16 + i * 8192, R, C); const int Rb = Epi::PERM ? ((R & ~31) + perm32(R & 31)) : R;
        voffA[i] = (unsigned)(R * g.lda + C) * 2u; voffB[i] = (unsigned)(Rb * K + C) * 2u; }
    const size_t kstep = (size_t)(BK * 2);
    const size_t hstepB = (size_t)HALF * K * 2, hstepA = (size_t)HALF * g.lda * 2;
    const size_t tstepB = 2 * hstepB, tstepA = 2 * hstepA;
    const unsigned ldsw = (unsigned)wid * 1024u;
    const int aoff = lds_byte(wr * 64 + fr, fq * 8), boff = lds_byte(wc * 32 + fr, fq * 8);
#define PG8_SA(b, h) (((b) * 2 + (h)) * HTB)
#define PG8_SB(b, h) ((4 + (b) * 2 + (h)) * HTB)
#define PG8_STAGE(bufoff, gbase, voff) do { _Pragma("unroll") for (int _i = 0; _i < 2; ++_i) \
        __builtin_amdgcn_global_load_lds((const unsigned*)((const char*)(gbase) + (voff)[_i]), (PG8_LAS unsigned*)(lds + (bufoff) + ldsw + _i * 8192), 16, 0, 0); } while (0)
#define PG8_LDA(dst, b, h) do { _Pragma("unroll") for (int m = 0; m < 4; ++m) _Pragma("unroll") for (int k = 0; k < 2; ++k) dst[m][k] = *(const PG8_LAS bf16x8*)(lds + PG8_SA(b, h) + aoff + m * 2048 + k * 1024); } while (0)
#define PG8_LDB(dst, b, h) do { _Pragma("unroll") for (int n = 0; n < 2; ++n) _Pragma("unroll") for (int k = 0; k < 2; ++k) dst[n][k] = *(const PG8_LAS bf16x8*)(lds + PG8_SB(b, h) + boff + n * 2048 + k * 1024); } while (0)
#define PG8_MMA(ai, bj, At, Bt) do { __builtin_amdgcn_s_setprio(1); _Pragma("unroll") for (int m = 0; m < 4; ++m) _Pragma("unroll") for (int n = 0; n < 2; ++n) _Pragma("unroll") for (int k = 0; k < 2; ++k) \
        acc[ai][bj][m][n] = __builtin_amdgcn_mfma_f32_16x16x32_bf16(Bt[n][k], At[m][k], acc[ai][bj][m][n], 0, 0, 0); __builtin_amdgcn_s_setprio(0); } while (0)
#define PG8_WAIT_V(n) asm volatile("s_waitcnt vmcnt(" #n ")" ::: "memory")
#define PG8_WAIT_L(n) asm volatile("s_waitcnt lgkmcnt(" #n ")" ::: "memory")
#define PG8_BAR __builtin_amdgcn_s_barrier()
#define PG8_SCHED __builtin_amdgcn_sched_barrier(0)
    Unit cur, nxt; int ui = 0;
    if (!S.next(0, cur)) return;
    f32x4 acc[2][2][4][2];
#pragma unroll
    for (int a = 0; a < 2; ++a)
#pragma unroll
        for (int b = 0; b < 2; ++b)
#pragma unroll
            for (int m = 0; m < 4; ++m)
#pragma unroll
                for (int n = 0; n < 2; ++n) acc[a][b][m][n] = (f32x4){0.f, 0.f, 0.f, 0.f};
    bf16x8 At[4][2], B0[2][2], B1[2][2];
    const char* cA = (const char*)g.A + (size_t)cur.pm * tstepA; const char* cB = (const char*)g.Bt + (size_t)cur.pn * tstepB;
    S.a_ready(cur);
    if constexpr (SP2) {
        PG8_STAGE(PG8_SB(0, 0), cB, voffB); PG8_STAGE(PG8_SB(0, 1), cB + hstepB, voffB); PG8_STAGE(PG8_SA(0, 0), cA, voffA); PG8_STAGE(PG8_SA(0, 1), cA + hstepA, voffA);
        if (wr == 1) PG8_BAR;
        PG8_WAIT_V(2); PG8_BAR;
        PG8_STAGE(PG8_SB(1, 0), cB + kstep, voffB); PG8_STAGE(PG8_SA(1, 0), cA + kstep, voffA); PG8_STAGE(PG8_SB(1, 1), cB + hstepB + kstep, voffB);
        PG8_WAIT_V(6); PG8_BAR;
    } else {
        PG8_STAGE(PG8_SB(0, 0), cB, voffB); PG8_STAGE(PG8_SA(0, 0), cA, voffA); PG8_STAGE(PG8_SB(0, 1), cB + hstepB, voffB); PG8_STAGE(PG8_SA(0, 1), cA + hstepA, voffA);
        if (wr == 1) PG8_BAR;
        PG8_WAIT_V(4); PG8_BAR;
        PG8_STAGE(PG8_SB(1, 0), cB + kstep, voffB); PG8_STAGE(PG8_SA(1, 0), cA + kstep, voffA); PG8_STAGE(PG8_SB(1, 1), cB + hstepB + kstep, voffB);
        PG8_WAIT_V(6); PG8_BAR;
    }
    for (;;) {
        const bool has_next = S.next(ui + 1, nxt);
        const char* nA = has_next ? (const char*)g.A + (size_t)nxt.pm * tstepA : cA; const char* nB = has_next ? (const char*)g.Bt + (size_t)nxt.pn * tstepB : cB;
        for (int t = 0; t < nt; t += 2) {
            const bool last = (t == nt - 2);
            const char* a1 = cA + (size_t)(t + 1) * kstep;
            const char* a2 = last ? nA : cA + (size_t)(t + 2) * kstep; const char* b2 = last ? nB : cB + (size_t)(t + 2) * kstep;
            const char* a3 = a2 + kstep; const char* b3 = b2 + kstep;
            if (last && has_next) S.a_ready(nxt);
            if constexpr (SP2) {
            PG8_LDB(B0, 0, 0); PG8_LDB(B1, 0, 1); PG8_SCHED; PG8_LDA(At, 0, 0); PG8_STAGE(PG8_SA(1, 1), a1 + hstepA, voffA);
            PG8_WAIT_V(8); PG8_WAIT_L(0); PG8_BAR; PG8_MMA(0, 0, At, B0); PG8_MMA(0, 1, At, B1); PG8_BAR; PG8_SCHED;
            PG8_LDA(At, 0, 1); PG8_STAGE(PG8_SB(0, 0), b2, voffB); PG8_STAGE(PG8_SB(0, 1), b2 + hstepB, voffB); PG8_STAGE(PG8_SA(0, 0), a2, voffA);
            PG8_WAIT_V(8); PG8_WAIT_L(0); PG8_BAR; PG8_MMA(1, 0, At, B0); PG8_MMA(1, 1, At, B1); PG8_BAR; PG8_SCHED;
            PG8_LDB(B0, 1, 0); PG8_LDB(B1, 1, 1); PG8_SCHED; PG8_LDA(At, 1, 0); PG8_STAGE(PG8_SA(0, 1), a2 + hstepA, voffA);
            PG8_WAIT_V(8); PG8_WAIT_L(0); PG8_BAR; PG8_MMA(0, 0, At, B0); PG8_MMA(0, 1, At, B1); PG8_BAR; PG8_SCHED;
            PG8_LDA(At, 1, 1); PG8_STAGE(PG8_SB(1, 0), b3, voffB); PG8_STAGE(PG8_SB(1, 1), b3 + hstepB, voffB); PG8_STAGE(PG8_SA(1, 0), a3, voffA);
            PG8_WAIT_V(8); PG8_WAIT_L(0); PG8_BAR; PG8_MMA(1, 0, At, B0); PG8_MMA(1, 1, At, B1); PG8_BAR; PG8_SCHED;
            } else {
            PG8_LDB(B0, 0, 0); PG8_SCHED; PG8_LDA(At, 0, 0); PG8_STAGE(PG8_SA(1, 1), a1 + hstepA, voffA);
            PG8_WAIT_L(8); PG8_BAR; PG8_WAIT_L(0); PG8_MMA(0, 0, At, B0); PG8_BAR; PG8_SCHED;
            PG8_LDB(B1, 0, 1); PG8_STAGE(PG8_SB(0, 0), b2, voffB);
            PG8_BAR; PG8_WAIT_L(0); PG8_MMA(0, 1, At, B1); PG8_BAR;
            PG8_LDA(At, 0, 1); PG8_STAGE(PG8_SA(0, 0), a2, voffA);
            PG8_BAR; PG8_WAIT_L(0); PG8_MMA(1, 0, At, B0); PG8_BAR; PG8_SCHED;
            PG8_STAGE(PG8_SB(0, 1), b2 + hstepB, voffB);
            PG8_WAIT_V(6); PG8_BAR; PG8_MMA(1, 1, At, B1); PG8_BAR;
            PG8_LDB(B0, 1, 0); PG8_SCHED; PG8_LDA(At, 1, 0); PG8_STAGE(PG8_SA(0, 1), a2 + hstepA, voffA);
            PG8_WAIT_L(8); PG8_BAR; PG8_WAIT_L(0); PG8_MMA(0, 0, At, B0); PG8_BAR; PG8_SCHED;
            PG8_LDB(B1, 1, 1); PG8_STAGE(PG8_SB(1, 0), b3, voffB);
            PG8_BAR; PG8_WAIT_L(0); PG8_MMA(0, 1, At, B1); PG8_BAR;
            PG8_LDA(At, 1, 1); PG8_STAGE(PG8_SA(1, 0), a3, voffA);
            PG8_BAR; PG8_WAIT_L(0); PG8_MMA(1, 0, At, B0); PG8_BAR; PG8_SCHED;
            PG8_STAGE(PG8_SB(1, 1), b3 + hstepB, voffB);
            PG8_WAIT_V(6); PG8_BAR; PG8_MMA(1, 1, At, B1); PG8_BAR;
            }
        }
        if constexpr (ALIGN_EPI) { if (wr == 0) PG8_BAR; }
        if constexpr (!Epi::AFTER_DRAIN) { E(acc, cur, wr, wc, fr, fq); S.done(cur); }
        if (!has_next) break;
#pragma unroll
        for (int a = 0; a < 2; ++a)
#pragma unroll
            for (int b = 0; b < 2; ++b)
#pragma unroll
                for (int m = 0; m < 4; ++m)
#pragma unroll
                    for (int n = 0; n < 2; ++n) acc[a][b][m][n] = (f32x4){0.f, 0.f, 0.f, 0.f};
        cur = nxt; cA = nA; cB = nB; ++ui;
        if constexpr (ALIGN_EPI) { if (wr == 1) PG8_BAR; }
    }
    PG8_WAIT_V(0);
    if constexpr (!ALIGN_EPI) { if (wr == 0) PG8_BAR; }
    PG8_BAR;
    if constexpr (Epi::AFTER_DRAIN) { E.fused(acc, cur, wr, wc, fr, fq, lds, wid, lane); S.done(cur); }
#undef PG8_SA
#undef PG8_SB
#undef PG8_STAGE
#undef PG8_LDA
#undef PG8_LDB
#undef PG8_MMA
#undef PG8_WAIT_V
#undef PG8_WAIT_L
#undef PG8_BAR
#undef PG8_SCHED
}
}
namespace pg8 {
struct EpiRoute {
    static constexpr bool PERM = true, AFTER_DRAIN = false;
    bf16_t* base[3]; int ldc[3]; int tile0[3]; int nseg;
    __device__ __forceinline__ void operator()(const f32x4 (&acc)[2][2][4][2], const Unit& u, int wr, int wc, int fr, int fq) const {
        int s = 0;
        if (nseg > 1 && u.pn >= tile0[1]) s = 1;
        if (nseg > 2 && u.pn >= tile0[2]) s = 2;
        bf16_t* O = base[s]; const int ld = ldc[s]; const int colt = (u.pn - tile0[s]) * BM;
        const int row0 = u.pm * BM + wr * 64 + fr;
        const int col0 = colt + wc * 32 + 8 * fq;
#pragma unroll
        for (int ai = 0; ai < 2; ++ai)
#pragma unroll
            for (int m = 0; m < 4; ++m) { bf16_t* rowp = O + (size_t)(row0 + ai * HALF + m * 16) * ld + col0;
#pragma unroll
                for (int bj = 0; bj < 2; ++bj) { const f32x4 v0 = acc[ai][bj][m][0], v1 = acc[ai][bj][m][1];
                    u32x4 w; w.x = cvt_pk_bf16(v0[0], v0[1]); w.y = cvt_pk_bf16(v0[2], v0[3]); w.z = cvt_pk_bf16(v1[0], v1[1]); w.w = cvt_pk_bf16(v1[2], v1[3]);
                    *(u32x4*)(rowp + bj * HALF) = w; } }
    }
};
}
#define GAS __attribute__((address_space(1)))
#define LAS __attribute__((address_space(3)))
typedef unsigned short bf16;
typedef unsigned v4u __attribute__((ext_vector_type(4)));
typedef float f32x4 __attribute__((ext_vector_type(4)));
typedef short bf16x8 __attribute__((ext_vector_type(8)));
typedef GAS unsigned gu32;
typedef GAS unsigned long long gu64;
#define RLX_AGENT __ATOMIC_RELAXED, __HIP_MEMORY_SCOPE_AGENT
#define LDS_WAIT() asm volatile("s_waitcnt lgkmcnt(0)" ::: "memory")
#define VM_WAIT() asm volatile("s_waitcnt vmcnt(0)" ::: "memory")
__device__ __forceinline__ unsigned long long rt() { return __builtin_amdgcn_s_memrealtime(); }
__device__ __forceinline__ unsigned f2bf(float f) { unsigned u = __builtin_bit_cast(unsigned, f); return (u + 0x7fffu + ((u >> 16) & 1u)) >> 16; }
__device__ __forceinline__ unsigned pk2(float lo, float hi) { return f2bf(lo) | (f2bf(hi) << 16); }
#define XB_TMO      128
#define XB_XCNT(j)  (256  + 64 * (j))
#define XB_XSUB(j)  (1280 + 64 * (j))
#define XB_XGEN(j)  (2304 + 64 * (j))
#define XB_TOP      3328
#define XB_TOPGEN   3392
#define XCD_BAR_WORDS 3456
#define XB_SPIN_CAP (1u << 18)

__device__ __forceinline__ unsigned xb_ld(unsigned* p)              { return __hip_atomic_load(p, __ATOMIC_RELAXED, __HIP_MEMORY_SCOPE_AGENT); }
__device__ __forceinline__ unsigned xb_add(unsigned* p, unsigned v) { return __hip_atomic_fetch_add(p, v, __ATOMIC_RELAXED, __HIP_MEMORY_SCOPE_AGENT); }
__device__ __forceinline__ unsigned xb_xcc_id() { return (unsigned)__builtin_amdgcn_s_getreg((3 << 11) | 20) & 0xFu; }
#define XB_SPIN(cond, bar) do { unsigned _sp = 0; while (cond) { __builtin_amdgcn_s_sleep(1); \
    if ((++_sp & 255u) == 0u) { if (xb_ld(&(bar)[XB_TMO])) break; if (_sp > XB_SPIN_CAP) { atomicAdd(&(bar)[XB_TMO], 1u); break; } } } } while (0)

struct XcdBarrier {
    unsigned* bar; unsigned x;
    volatile LAS unsigned* st;
};

__device__ __forceinline__ XcdBarrier xcd_barrier_post(unsigned* bar, volatile LAS unsigned* st) {
    XcdBarrier b; b.bar = bar; b.x = xb_xcc_id(); b.st = st;
    if (threadIdx.x == 0) (void)xb_add(&bar[XB_XCNT(b.x)], 1u);
    return b;
}
__device__ __forceinline__ void xcd_barrier_complete(unsigned* bar, unsigned x, unsigned& nloc, unsigned& nx) {
    const unsigned G = gridDim.x * gridDim.y * gridDim.z;
    unsigned sum, cnt, mine, sp = 0u;
    for (;;) {
        sum = 0u; cnt = 0u; mine = 0u;
#pragma unroll
        for (unsigned j = 0; j < 16; ++j) { const unsigned c = xb_ld(&bar[XB_XCNT(j)]); sum += c; cnt += (c > 0u) ? 1u : 0u; mine = (j == x) ? c : mine; }
        if (sum == G) break;
        __builtin_amdgcn_s_sleep(1);
        if ((++sp & 255u) == 0u) { if (xb_ld(&bar[XB_TMO])) break; if (sp > XB_SPIN_CAP) { atomicAdd(&bar[XB_TMO], 1u); break; } }
    }
    nloc = mine > 0u ? mine : 1u; nx = cnt > 0u ? cnt : 1u;
}

__device__ __forceinline__ void xcd_barrier(const XcdBarrier& b) {
    asm volatile("s_waitcnt vmcnt(0)" ::: "memory");
    __syncthreads();
    if (threadIdx.x == 0) {
        unsigned* bar = b.bar;
        __builtin_amdgcn_s_waitcnt(0);
        unsigned nloc = b.st[0], nx = b.st[1];
        if (nloc == 0u) { xcd_barrier_complete(bar, b.x, nloc, nx); b.st[0] = nloc; b.st[1] = nx; }
        const unsigned old = xb_add(&bar[XB_XSUB(b.x)], 1u);
        const unsigned gen = old / nloc;
        if (old + 1u == (gen + 1u) * nloc) {
            __builtin_amdgcn_fence(__ATOMIC_RELEASE, "agent");
            asm volatile("s_waitcnt vmcnt(0)" ::: "memory");
            const unsigned og = xb_add(&bar[XB_TOP], 1u);
            const unsigned tg = og / nx;
            if (og + 1u == (tg + 1u) * nx) xb_add(&bar[XB_TOPGEN], 1u);
            else XB_SPIN(xb_ld(&bar[XB_TOPGEN]) == tg, bar);
            __builtin_amdgcn_fence(__ATOMIC_ACQUIRE, "agent");
            xb_add(&bar[XB_XGEN(b.x)], 1u);
            asm volatile("s_waitcnt vmcnt(0)" ::: "memory");
        } else {
            XB_SPIN(xb_ld(&bar[XB_XGEN(b.x)]) == gen, bar);
            __builtin_amdgcn_fence(__ATOMIC_ACQUIRE, "agent");
            asm volatile("s_waitcnt vmcnt(0)" ::: "memory");
        }
    }
    __syncthreads();
}
constexpr int NWAVES = 8;
constexpr int BATCH = 32, SEQ = 2048, DM = 1024, M = BATCH * SEQ;
constexpr int RW = 512, RCOLS = 2304, ACOLS = 1280, GCOLS = 2048;
enum { I_X = 0, I_C, I_WADA, I_BADA, I_GPRE, I_GPOST, I_WIN, I_MU, I_W0, I_WUP, I_A0, I_AUP, I_KK, I_KA, I_RK, I_GNW, I_GNB, I_SINK, I_WBRR, I_WBRA, I_WOUT, NIN };
#ifndef MK_N_LAUNCHES
#define MK_N_LAUNCHES 1
#endif
constexpr int N_PHASES = 12;
constexpr int N_LAUNCHES = MK_N_LAUNCHES;
constexpr size_t MiB = 1u << 20;
constexpr size_t WS_CTL = 0, CTL_ZERO_BYTES = 1 * MiB;
constexpr size_t WS_ADA = 1 * MiB;
constexpr size_t WS_BSUM = 2 * MiB;
constexpr size_t WS_WINT = 4 * MiB;
constexpr size_t WS_WBRR = 15 * MiB, WS_WBRA = 16 * MiB, WS_WOUT = 17 * MiB, WS_WLORA = 19 * MiB;
constexpr size_t WS_H = 24 * MiB;
constexpr size_t WS_PA = 152 * MiB;
constexpr size_t WS_PR = 312 * MiB;
constexpr size_t WS_KD1 = 568 * MiB;
constexpr size_t WS_LA = 600 * MiB;
constexpr size_t WS_R = 632 * MiB, WS_K = 696 * MiB, WS_V = 760 * MiB, WS_G = 824 * MiB, WS_KK = 888 * MiB;
constexpr size_t WS_BR = 568 * MiB;
constexpr size_t WS_BA = 824 * MiB;
constexpr size_t WS_END = 1024 * MiB;
constexpr int CW_BAR = 4096;
constexpr int RING_BYTES = 131072, LDSCTL_OFF = RING_BYTES, MISC_OFF = LDSCTL_OFF + 320, LDS_BYTES = 147456;

__device__ __forceinline__ float bflo(unsigned w) { return __builtin_bit_cast(float, w << 16); }
__device__ __forceinline__ float bfhi(unsigned w) { return __builtin_bit_cast(float, w & 0xffff0000u); }
__device__ __forceinline__ float bf2f(bf16 u) { return __builtin_bit_cast(float, (unsigned)u << 16); }
__device__ __forceinline__ void unpack8(const v4u q, float* f) { f[0] = bflo(q.x); f[1] = bfhi(q.x); f[2] = bflo(q.y); f[3] = bfhi(q.y); f[4] = bflo(q.z); f[5] = bfhi(q.z); f[6] = bflo(q.w); f[7] = bfhi(q.w); }
__device__ __forceinline__ v4u pack8(const float* f) { v4u o; o.x = pk2(f[0], f[1]); o.y = pk2(f[2], f[3]); o.z = pk2(f[4], f[5]); o.w = pk2(f[6], f[7]); return o; }
__device__ __forceinline__ float sigmoidf_(float x) { return 1.0f / (1.0f + __expf(-x)); }
__device__ __forceinline__ float wave_sum(float v) {
#pragma unroll
    for (int o = 1; o < 64; o <<= 1) v += __shfl_xor(v, o);
    return v;
}
__device__ __forceinline__ void transpose_item(const float* W, int K, int N, bf16* WT, int ldwt, int row_off, int kcol_off, LAS float* scr, int item, int lane) {
    const int nblk = N / 32, kb = item / nblk, nb = item % nblk, k0 = 64 * kb, n0 = 32 * nb;
#pragma unroll 8
    for (int i = 0; i < 32; ++i) { const int kk = 2 * i + (lane >> 5); scr[kk * 33 + (lane & 31)] = W[(size_t)(k0 + kk) * N + n0 + (lane & 31)]; }
    LDS_WAIT(); asm volatile("" ::: "memory");
    const int c = lane & 7;
#pragma unroll
    for (int j = 0; j < 4; ++j) { const int n = (lane >> 3) + 8 * j; const LAS float* s = scr + (8 * c) * 33 + n;
        v4u o; o.x = pk2(s[0 * 33], s[1 * 33]); o.y = pk2(s[2 * 33], s[3 * 33]); o.z = pk2(s[4 * 33], s[5 * 33]); o.w = pk2(s[6 * 33], s[7 * 33]);
        *(GAS v4u*)(WT + (size_t)(row_off + n0 + n) * ldwt + kcol_off + k0 + 8 * c) = o; }
    LDS_WAIT(); asm volatile("" ::: "memory");
}

struct Args { const float* in[NIN]; float* out; unsigned char* ws; int ph_lo, ph_hi, li, pad; };

__global__ void __launch_bounds__(NWAVES * 64, 2) mk_fwd(Args args) {
    extern __shared__ __attribute__((aligned(16))) unsigned char lds_raw[];
    LAS unsigned char* lds = (LAS unsigned char*)lds_raw;
    volatile LAS unsigned* MISC = (volatile LAS unsigned*)(lds + MISC_OFF);
    const int tid = threadIdx.x, lane = tid & 63, wave = __builtin_amdgcn_readfirstlane(tid >> 6);
    const int G = gridDim.x, bx = blockIdx.x;
    const int vcu = (G % 8 == 0) ? (bx % 8) * (G / 8) + bx / 8 : bx;
    const int gw = vcu * NWAVES + wave, NGW = G * NWAVES;
    unsigned char* ws = args.ws;
    gu32* ctl = (gu32*)(ws + WS_CTL);
    for (int u = tid; u < (LDS_BYTES - LDSCTL_OFF) / 4; u += NWAVES * 64) ((LAS unsigned*)(lds + LDSCTL_OFF))[u] = 0u;
    __syncthreads();
    XcdBarrier bar; bar.bar = (unsigned*)(ctl + CW_BAR); bar.x = 0; bar.st = nullptr;
    if (N_LAUNCHES == 1) bar = xcd_barrier_post((unsigned*)(ctl + CW_BAR), MISC + 8);
#define GRID_BAR() do { if (N_LAUNCHES == 1) xcd_barrier(bar); } while (0)
    const int lo = args.ph_lo, hi = args.ph_hi;
#define IN(k) (lo <= (k) && (k) < hi)
#define BOTH(k) (IN(k) && IN((k) + 1))
    const float* x = args.in[I_X]; const float* cin = args.in[I_C]; const float* wada = args.in[I_WADA]; const float* bada = args.in[I_BADA];
    const float* gpre = args.in[I_GPRE]; const float* gpost = args.in[I_GPOST]; const float* win = args.in[I_WIN]; const float* mu = args.in[I_MU];
    const float* w0 = args.in[I_W0]; const float* wup = args.in[I_WUP]; const float* a0 = args.in[I_A0]; const float* aup = args.in[I_AUP];
    const float* k_k = args.in[I_KK]; const float* k_a = args.in[I_KA]; const float* r_k = args.in[I_RK]; const float* gnw = args.in[I_GNW]; const float* gnb = args.in[I_GNB];
    const float* sink = args.in[I_SINK]; const float* wbrr = args.in[I_WBRR]; const float* wbra = args.in[I_WBRA]; const float* wout = args.in[I_WOUT];
    float* out = args.out;
    float* ADA = (float*)(ws + WS_ADA); float* BSUM = (float*)(ws + WS_BSUM);
    bf16* WinT = (bf16*)(ws + WS_WINT); bf16* WbrrT = (bf16*)(ws + WS_WBRR); bf16* WbraT = (bf16*)(ws + WS_WBRA); bf16* WoutT = (bf16*)(ws + WS_WOUT); bf16* WloraT = (bf16*)(ws + WS_WLORA);
    bf16* Hb = (bf16*)(ws + WS_H); bf16* MG = (bf16*)(ws + WS_H);
    bf16* PA = (bf16*)(ws + WS_PA); bf16* PR = (bf16*)(ws + WS_PR); bf16* RAW = (bf16*)(ws + WS_PR); bf16* PG = (bf16*)(ws + WS_PR); bf16* OUTB = (bf16*)(ws + WS_PR);
    bf16* KD1 = (bf16*)(ws + WS_KD1); bf16* LA = (bf16*)(ws + WS_LA);
    bf16* Rb = (bf16*)(ws + WS_R); bf16* Kb = (bf16*)(ws + WS_K); bf16* Vb = (bf16*)(ws + WS_V); bf16* Gb = (bf16*)(ws + WS_G); bf16* KKb = (bf16*)(ws + WS_KK);
    bf16* BR = (bf16*)(ws + WS_BR); bf16* BA = (bf16*)(ws + WS_BA);

    if (IN(0)) {
        LAS float* scr = (LAS float*)(lds + wave * 16384);
        constexpr int I_IN = 16 * 176, I_BRR = 8 * 32, I_OUT = 16 * 32, I_LORA = 64, NT = I_IN + 2 * I_BRR + I_OUT + I_LORA;
        for (int it = gw; it < NT; it += NGW) {
            int r = it;
            if (r < I_IN) { transpose_item(win, 1024, 5632, WinT, 1024, 0, 0, scr, r, lane); continue; } r -= I_IN;
            if (r < I_BRR) { transpose_item(wbrr, 512, 1024, WbrrT, 512, 0, 0, scr, r, lane); continue; } r -= I_BRR;
            if (r < I_BRR) { transpose_item(wbra, 512, 1024, WbraT, 512, 0, 0, scr, r, lane); continue; } r -= I_BRR;
            if (r < I_OUT) { transpose_item(wout, 1024, 1024, WoutT, 1024, 0, 0, scr, r, lane); continue; } r -= I_OUT;
            { const int mat = r >> 4, nb = r & 15; const float* W = (mat < 2 ? wup : aup) + (size_t)(mat & 1) * 64 * 512;
              transpose_item(W, 64, 512, WloraT, 256, mat * 512, mat * 64, scr, nb, lane);
#pragma unroll
              for (int i = 0; i < 12; ++i) { const int q = lane + 64 * i, row = q / 24, cc = q % 24, chunk = cc < mat * 8 ? cc : cc + 8;
                  *(GAS v4u*)(WloraT + (size_t)(mat * 512 + nb * 32 + row) * 256 + chunk * 8) = (v4u){0u, 0u, 0u, 0u}; } }
        }
        for (int it = gw; it < 384; it += NGW) {
            const int nblk = it % 48, bg = it / 48, n = nblk * 64 + lane, b0 = bg * 4;
#pragma unroll
            for (int bb = 0; bb < 4; ++bb)
#pragma unroll 4
                for (int kk = 0; kk < 16; ++kk) { const int k = lane + 64 * kk; const float cv = cin[(b0 + bb) * 1024 + k]; scr[k * 4 + bb] = cv * sigmoidf_(cv); }
            LDS_WAIT(); asm volatile("" ::: "memory");
            float acc[4] = {0.f, 0.f, 0.f, 0.f};
#pragma unroll 8
            for (int k = 0; k < 1024; ++k) { const float wv = wada[(size_t)k * 3072 + n]; const f32x4 s = *(const LAS f32x4*)(scr + k * 4);
                acc[0] += s[0] * wv; acc[1] += s[1] * wv; acc[2] += s[2] * wv; acc[3] += s[3] * wv; }
            const float bn = bada[n];
#pragma unroll
            for (int bb = 0; bb < 4; ++bb) ADA[(b0 + bb) * 3072 + n] = acc[bb] + bn;
            LDS_WAIT(); asm volatile("" ::: "memory");
        }
        if (BOTH(0)) GRID_BAR();
    }
    if (IN(1)) {
        for (int m = gw; m < M; m += NGW) {
            const int b = m >> 11;
            const GAS f32x4* xr = (const GAS f32x4*)(x + (size_t)m * DM) + lane;
            f32x4 v[4]; float s = 0.f;
#pragma unroll
            for (int j = 0; j < 4; ++j) { v[j] = xr[64 * j]; s += (v[j].x * v[j].x + v[j].y * v[j].y) + (v[j].z * v[j].z + v[j].w * v[j].w); }
            const float rinv = 1.0f / sqrtf(wave_sum(s) * (1.f / DM) + 1e-6f);
            GAS unsigned long long* o8 = (GAS unsigned long long*)(Hb + (size_t)m * DM) + lane;
#pragma unroll
            for (int j = 0; j < 4; ++j) { const int c = 4 * (lane + 64 * j);
                const f32x4 gp = *(const f32x4*)(gpre + c), sh = *(const f32x4*)(ADA + b * 3072 + c), sc = *(const f32x4*)(ADA + b * 3072 + 1024 + c);
                const f32x4 hh = v[j] * rinv * gp * (sc + 1.0f) + sh;
                o8[64 * j] = (unsigned long long)pk2(hh.x, hh.y) | ((unsigned long long)pk2(hh.z, hh.w) << 32); }
        }
        if (BOTH(1)) GRID_BAR();
    }
    if (IN(2)) {
        pg8::Gemm g{Hb, WinT, M, 3584, 1024, 1024}; pg8::StaticOrder S; S.init(M, 3584, G, bx);
        pg8::EpiRoute E; E.base[0] = PR; E.base[1] = PA; E.base[2] = nullptr; E.ldc[0] = RCOLS; E.ldc[1] = ACOLS; E.ldc[2] = 0; E.tile0[0] = 0; E.tile0[1] = 9; E.tile0[2] = 0; E.nseg = 2;
        pg8::gemm_phase<pg8::EpiRoute, pg8::StaticOrder, true, true>(lds, g, S, E);
        if (BOTH(2)) GRID_BAR();
    }
    if (IN(3)) {
        for (int m = gw; m < M; m += NGW) {
            const int t = m & 2047;
            const bf16* pc = PR + (size_t)m * RCOLS;
#pragma unroll
            for (int i = 0; i < 9; ++i) {
                const int c = 4 * (lane + 64 * i);
                const uint2 cur = *(const uint2*)(pc + c);
                uint2 prv = make_uint2(0u, 0u), nxt = make_uint2(0u, 0u);
                if (t > 0) prv = *(const uint2*)(pc - RCOLS + c);
                if (t < 2047) nxt = *(const uint2*)(pc + RCOLS + c);
                const f32x4 m0 = *(const f32x4*)(mu + c), m1 = *(const f32x4*)(mu + RCOLS + c);
                const float p[4] = {bflo(cur.x), bfhi(cur.x), bflo(cur.y), bfhi(cur.y)};
                const float pp[4] = {bflo(prv.x), bfhi(prv.x), bflo(prv.y), bfhi(prv.y)};
                const float pn[4] = {bflo(nxt.x), bfhi(nxt.x), bflo(nxt.y), bfhi(nxt.y)};
                float o[4];
#pragma unroll
                for (int e = 0; e < 4; ++e) o[e] = p[e] + m0[e] * (pp[e] - p[e]) + m1[e] * (pn[e] - p[e]);
                if (i < 2) { *(uint2*)(Rb + (size_t)m * RW + c) = make_uint2(pk2(o[0], o[1]), pk2(o[2], o[3])); }
                else if (i < 4) { const int cc = c - 512;
                    *(uint2*)(Kb + (size_t)m * RW + cc) = make_uint2(pk2(o[0], o[1]), pk2(o[2], o[3]));
                    const f32x4 kkw = *(const f32x4*)(k_k + cc);
                    float kr[4]; float ss = 0.f;
#pragma unroll
                    for (int e = 0; e < 4; ++e) { kr[e] = o[e] * kkw[e]; ss += kr[e] * kr[e]; }
                    ss += __shfl_xor(ss, 1); ss += __shfl_xor(ss, 2); ss += __shfl_xor(ss, 4); ss += __shfl_xor(ss, 8);
                    const float inv = 1.0f / fmaxf(sqrtf(ss), 1e-12f);
                    *(uint2*)(KKb + (size_t)m * RW + cc) = make_uint2(pk2(kr[0] * inv, kr[1] * inv), pk2(kr[2] * inv, kr[3] * inv)); }
                else if (i < 6) { *(uint2*)(Vb + (size_t)m * RW + (c - 1024)) = make_uint2(pk2(o[0], o[1]), pk2(o[2], o[3])); }
                else if (i < 8) { *(uint2*)(Gb + (size_t)m * RW + (c - 1536)) = make_uint2(pk2(o[0], o[1]), pk2(o[2], o[3])); }
                else { if (lane < 32) {
#pragma unroll
                        for (int e = 0; e < 4; ++e) o[e] = tanhf(o[e]); }
                    *(uint2*)(LA + (size_t)m * 256 + (c - 2048)) = make_uint2(pk2(o[0], o[1]), pk2(o[2], o[3])); }
            }
        }
        if (BOTH(3)) GRID_BAR();
    }
    if (IN(4)) {
        pg8::Gemm g{LA, WloraT, M, 2048, 256, 256}; pg8::StaticOrder S; S.init(M, 2048, G, bx);
        pg8::EpiRoute E; E.base[0] = RAW; E.base[1] = nullptr; E.base[2] = nullptr; E.ldc[0] = 2048; E.ldc[1] = 0; E.ldc[2] = 0; E.tile0[0] = 0; E.tile0[1] = 0; E.tile0[2] = 0; E.nseg = 1;
        pg8::gemm_phase<pg8::EpiRoute, pg8::StaticOrder, true, true>(lds, g, S, E);
        if (BOTH(4)) GRID_BAR();
    }
    if (IN(5)) {
        for (int m = gw; m < M; m += NGW) {
            const int c0 = 8 * lane;
            bf16* rawrow = RAW + (size_t)m * 2048;
            float kf[8], kkf[8], rf[8], kaf[8], rkf[8];
            unpack8(*(const v4u*)(Kb + (size_t)m * RW + c0), kf); unpack8(*(const v4u*)(KKb + (size_t)m * RW + c0), kkf); unpack8(*(const v4u*)(Rb + (size_t)m * RW + c0), rf);
            { const f32x4 a = *(const f32x4*)(k_a + c0), b = *(const f32x4*)(k_a + c0 + 4); kaf[0] = a.x; kaf[1] = a.y; kaf[2] = a.z; kaf[3] = a.w; kaf[4] = b.x; kaf[5] = b.y; kaf[6] = b.z; kaf[7] = b.w; }
            { const f32x4 a = *(const f32x4*)(r_k + c0), b = *(const f32x4*)(r_k + c0 + 4); rkf[0] = a.x; rkf[1] = a.y; rkf[2] = a.z; rkf[3] = a.w; rkf[4] = b.x; rkf[5] = b.y; rkf[6] = b.z; rkf[7] = b.w; }
            float bs = 0.f;
#pragma unroll
            for (int d = 0; d < 2; ++d) {
                float wr[8], ar[8], w0f[8], a0f[8], dec[8], bb[8], kd[8];
                unpack8(*(const v4u*)(rawrow + d * 512 + c0), wr); unpack8(*(const v4u*)(rawrow + 1024 + d * 512 + c0), ar);
                { const f32x4 a = *(const f32x4*)(w0 + d * 512 + c0), b = *(const f32x4*)(w0 + d * 512 + c0 + 4); w0f[0] = a.x; w0f[1] = a.y; w0f[2] = a.z; w0f[3] = a.w; w0f[4] = b.x; w0f[5] = b.y; w0f[6] = b.z; w0f[7] = b.w; }
                { const f32x4 a = *(const f32x4*)(a0 + d * 512 + c0), b = *(const f32x4*)(a0 + d * 512 + c0 + 4); a0f[0] = a.x; a0f[1] = a.y; a0f[2] = a.z; a0f[3] = a.w; a0f[4] = b.x; a0f[5] = b.y; a0f[6] = b.z; a0f[7] = b.w; }
#pragma unroll
                for (int e = 0; e < 8; ++e) {
                    const float sg = sigmoidf_(wr[e] + w0f[e]);
                    dec[e] = __expf(-0.6065306597f * sg);
                    const float a = sigmoidf_(ar[e] + a0f[e]);
                    kd[e] = kf[e] * (1.0f + (a - 1.0f) * kaf[e]);
                    bb[e] = kkf[e] * a;
                    bs += rf[e] * kd[e] * rkf[e];
                }
                *(v4u*)(rawrow + d * 512 + c0) = pack8(dec);
                *(v4u*)(rawrow + 1024 + d * 512 + c0) = pack8(bb);
                if (d == 0) *(v4u*)(Kb + (size_t)m * RW + c0) = pack8(kd); else *(v4u*)(KD1 + (size_t)m * RW + c0) = pack8(kd);
            }
            bs += __shfl_xor(bs, 1); bs += __shfl_xor(bs, 2); bs += __shfl_xor(bs, 4);
            if ((lane & 7) == 0) BSUM[(size_t)m * 8 + (lane >> 3)] = bs;
        }
        if (BOTH(5)) GRID_BAR();
    }
    if (IN(6)) {
        if (wave < 2) {
            const int s = 2 * vcu + wave; const int d = s & 1, bh = s >> 1, b = bh >> 3, h = bh & 7;
            float S[64];
#pragma unroll
            for (int j = 0; j < 64; ++j) S[j] = 0.f;
            bf16* decb = RAW + d * 512 + h * 64;
            const bf16* bbb = RAW + 1024 + d * 512 + h * 64;
            const bf16* kdb = (d ? KD1 : Kb) + h * 64;
            const bf16* kkb = KKb + h * 64; const bf16* rb = Rb + h * 64; const bf16* vb = Vb + h * 64;
            for (int n = 0; n < SEQ; ++n) {
                const int t = d ? (SEQ - 1 - n) : n; const size_t m = (size_t)b * SEQ + t;
                const float vi = bf2f(vb[m * RW + lane]);
                float sa0 = 0.f, sa1 = 0.f, sa2 = 0.f, sa3 = 0.f;
#pragma unroll
                for (int j8 = 0; j8 < 8; ++j8) { float f[8]; unpack8(*(const v4u*)(kkb + m * RW + 8 * j8), f);
                    sa0 += S[8 * j8 + 0] * f[0]; sa1 += S[8 * j8 + 1] * f[1]; sa2 += S[8 * j8 + 2] * f[2]; sa3 += S[8 * j8 + 3] * f[3];
                    sa0 += S[8 * j8 + 4] * f[4]; sa1 += S[8 * j8 + 5] * f[5]; sa2 += S[8 * j8 + 6] * f[6]; sa3 += S[8 * j8 + 7] * f[7]; }
                const float sa = (sa0 + sa1) + (sa2 + sa3);
                float y0 = 0.f, y1 = 0.f, y2 = 0.f, y3 = 0.f;
#pragma unroll
                for (int j8 = 0; j8 < 8; ++j8) { float fw[8], fb[8], fk[8], fr[8];
                    unpack8(*(const v4u*)(decb + m * 2048 + 8 * j8), fw); unpack8(*(const v4u*)(bbb + m * 2048 + 8 * j8), fb);
                    unpack8(*(const v4u*)(kdb + m * RW + 8 * j8), fk); unpack8(*(const v4u*)(rb + m * RW + 8 * j8), fr);
#pragma unroll
                    for (int e = 0; e < 8; ++e) { const int j = 8 * j8 + e; const float tt = vi * fk[e] - sa * fb[e]; S[j] = S[j] * fw[e] + tt; }
                    y0 += S[8 * j8 + 0] * fr[0]; y1 += S[8 * j8 + 1] * fr[1]; y2 += S[8 * j8 + 2] * fr[2]; y3 += S[8 * j8 + 3] * fr[3];
                    y0 += S[8 * j8 + 4] * fr[4]; y1 += S[8 * j8 + 5] * fr[5]; y2 += S[8 * j8 + 6] * fr[6]; y3 += S[8 * j8 + 7] * fr[7]; }
                const float y = (y0 + y1) + (y2 + y3);
                decb[m * 2048 + lane] = (bf16)f2bf(y);
            }
        } else {
            const int aw = vcu * 6 + (wave - 2), NAW = G * 6;
            for (int u = aw; u < 8192; u += NAW) {
                const int mblk = u >> 3, hq = u & 7, kvh = hq >> 2;
                const int m = mblk * 64 + lane, b = m >> 11, t = m & 2047;
                const float slope = exp2f(-(float)(hq + 1));
                const float snk = sink[hq];
                bf16* qp = PA + (size_t)m * ACOLS + hq * 64;
                float q[64], o[64];
#pragma unroll
                for (int j8 = 0; j8 < 8; ++j8) { float f[8]; unpack8(*(const v4u*)(qp + 8 * j8), f);
#pragma unroll
                    for (int e = 0; e < 8; ++e) { q[8 * j8 + e] = f[e] * 0.125f; o[8 * j8 + e] = 0.f; } }
                float mx = snk, l = 1.0f;
                for (int off = -128; off <= 128; ++off) {
                    const int s = t + off;
                    if (s >= 0 && s < SEQ) {
                        const bf16* kp = PA + ((size_t)b * SEQ + s) * ACOLS + 512 + kvh * 64;
                        float d0 = 0.f, d1 = 0.f;
#pragma unroll
                        for (int j8 = 0; j8 < 8; ++j8) { float f[8]; unpack8(*(const v4u*)(kp + 8 * j8), f);
#pragma unroll
                            for (int e = 0; e < 8; e += 2) { d0 += q[8 * j8 + e] * f[e]; d1 += q[8 * j8 + e + 1] * f[e + 1]; } }
                        const float sc = (d0 + d1) - slope * fabsf((float)off);
                        if (sc > mx) { const float f = __expf(mx - sc); l *= f;
#pragma unroll
                            for (int j = 0; j < 64; ++j) o[j] *= f;
                            mx = sc; }
                        const float p = __expf(sc - mx); l += p;
                        const bf16* vp = kp + 128;
#pragma unroll
                        for (int j8 = 0; j8 < 8; ++j8) { float f[8]; unpack8(*(const v4u*)(vp + 8 * j8), f);
#pragma unroll
                            for (int e = 0; e < 8; ++e) o[8 * j8 + e] += p * f[e]; }
                    }
                }
                const float inv = 1.0f / l;
                const bf16* gp = PA + (size_t)m * ACOLS + 768 + hq * 64;
#pragma unroll
                for (int j8 = 0; j8 < 8; ++j8) { float f[8], r[8]; unpack8(*(const v4u*)(gp + 8 * j8), f);
#pragma unroll
                    for (int e = 0; e < 8; ++e) r[e] = o[8 * j8 + e] * inv * f[e] * sigmoidf_(f[e]);
                    *(v4u*)(qp + 8 * j8) = pack8(r); }
            }
        }
        if (BOTH(6)) GRID_BAR();
    }
    if (IN(7)) {
        for (int m = gw; m < M; m += NGW) {
            const int c0 = 8 * lane, h = lane >> 3;
            const bf16* rawrow = RAW + (size_t)m * 2048;
            float y0[8], y1[8], vf[8], gf[8], y[8];
            unpack8(*(const v4u*)(rawrow + c0), y0); unpack8(*(const v4u*)(rawrow + 512 + c0), y1);
            unpack8(*(const v4u*)(Vb + (size_t)m * RW + c0), vf); unpack8(*(const v4u*)(Gb + (size_t)m * RW + c0), gf);
            float s = 0.f;
#pragma unroll
            for (int e = 0; e < 8; ++e) { y[e] = y0[e] + y1[e]; s += y[e]; }
            s += __shfl_xor(s, 1); s += __shfl_xor(s, 2); s += __shfl_xor(s, 4);
            const float mean = s * (1.f / 64.f); float q = 0.f;
#pragma unroll
            for (int e = 0; e < 8; ++e) { const float dd = y[e] - mean; q += dd * dd; }
            q += __shfl_xor(q, 1); q += __shfl_xor(q, 2); q += __shfl_xor(q, 4);
            const float rstd = 1.0f / sqrtf(q * (1.f / 64.f) + 64e-5f);
            const float bsum = BSUM[(size_t)m * 8 + h];
            const f32x4 gwa = *(const f32x4*)(gnw + c0), gwb = *(const f32x4*)(gnw + c0 + 4), gba = *(const f32x4*)(gnb + c0), gbb = *(const f32x4*)(gnb + c0 + 4);
            const float gw8[8] = {gwa.x, gwa.y, gwa.z, gwa.w, gwb.x, gwb.y, gwb.z, gwb.w}, gb8[8] = {gba.x, gba.y, gba.z, gba.w, gbb.x, gbb.y, gbb.z, gbb.w};
            float r[8];
#pragma unroll
            for (int e = 0; e < 8; ++e) { const float yn = (y[e] - mean) * rstd * gw8[e] + gb8[e]; r[e] = (yn + bsum * vf[e]) * gf[e] * sigmoidf_(gf[e]); }
            *(v4u*)(Vb + (size_t)m * RW + c0) = pack8(r);
        }
        if (BOTH(7)) GRID_BAR();
    }
    if (IN(8)) {
        { pg8::Gemm g{Hb, WinT + (size_t)3584 * 1024, M, 2048, 1024, 1024}; pg8::StaticOrder S; S.init(M, 2048, G, bx);
          pg8::EpiRoute E; E.base[0] = PG; E.base[1] = nullptr; E.base[2] = nullptr; E.ldc[0] = 2048; E.ldc[1] = 0; E.ldc[2] = 0; E.tile0[0] = 0; E.tile0[1] = 0; E.tile0[2] = 0; E.nseg = 1;
          pg8::gemm_phase<pg8::EpiRoute, pg8::StaticOrder, true, true>(lds, g, S, E); }
        { pg8::Gemm g{Vb, WbrrT, M, 1024, 512, 512}; pg8::StaticOrder S; S.init(M, 1024, G, bx);
          pg8::EpiRoute E; E.base[0] = BR; E.base[1] = nullptr; E.base[2] = nullptr; E.ldc[0] = 1024; E.ldc[1] = 0; E.ldc[2] = 0; E.tile0[0] = 0; E.tile0[1] = 0; E.tile0[2] = 0; E.nseg = 1;
          pg8::gemm_phase<pg8::EpiRoute, pg8::StaticOrder, true, true>(lds, g, S, E); }
        { pg8::Gemm g{PA, WbraT, M, 1024, 512, ACOLS}; pg8::StaticOrder S; S.init(M, 1024, G, bx);
          pg8::EpiRoute E; E.base[0] = BA; E.base[1] = nullptr; E.base[2] = nullptr; E.ldc[0] = 1024; E.ldc[1] = 0; E.ldc[2] = 0; E.tile0[0] = 0; E.tile0[1] = 0; E.tile0[2] = 0; E.nseg = 1;
          pg8::gemm_phase<pg8::EpiRoute, pg8::StaticOrder, true, true>(lds, g, S, E); }
        if (BOTH(8)) GRID_BAR();
    }
    if (IN(9)) {
        for (int m = gw; m < M; m += NGW) {
#pragma unroll
            for (int j = 0; j < 2; ++j) { const int c = 8 * (lane + 64 * j);
                float g0[8], g1[8], r0[8], r1[8], o[8];
                unpack8(*(const v4u*)(PG + (size_t)m * 2048 + c), g0); unpack8(*(const v4u*)(PG + (size_t)m * 2048 + 1024 + c), g1);
                unpack8(*(const v4u*)(BR + (size_t)m * 1024 + c), r0); unpack8(*(const v4u*)(BA + (size_t)m * 1024 + c), r1);
#pragma unroll
                for (int e = 0; e < 8; ++e) o[e] = sigmoidf_(g0[e]) * r0[e] + sigmoidf_(g1[e]) * r1[e];
                *(v4u*)(MG + (size_t)m * 1024 + c) = pack8(o); }
        }
        if (BOTH(9)) GRID_BAR();
    }
    if (IN(10)) {
        pg8::Gemm g{MG, WoutT, M, 1024, 1024, 1024}; pg8::StaticOrder S; S.init(M, 1024, G, bx);
        pg8::EpiRoute E; E.base[0] = OUTB; E.base[1] = nullptr; E.base[2] = nullptr; E.ldc[0] = 1024; E.ldc[1] = 0; E.ldc[2] = 0; E.tile0[0] = 0; E.tile0[1] = 0; E.tile0[2] = 0; E.nseg = 1;
        pg8::gemm_phase<pg8::EpiRoute, pg8::StaticOrder, true, true>(lds, g, S, E);
        if (BOTH(10)) GRID_BAR();
    }
    if (IN(11)) {
        for (int m = gw; m < M; m += NGW) {
            const int b = m >> 11;
            float o[2][8]; float s = 0.f;
#pragma unroll
            for (int j = 0; j < 2; ++j) { unpack8(*(const v4u*)(OUTB + (size_t)m * 1024 + 8 * (lane + 64 * j)), o[j]);
#pragma unroll
                for (int e = 0; e < 8; ++e) s += o[j][e] * o[j][e]; }
            const float rinv = 1.0f / sqrtf(wave_sum(s) * (1.f / DM) + 1e-6f);
#pragma unroll
            for (int j = 0; j < 2; ++j) { const int c = 8 * (lane + 64 * j);
#pragma unroll
                for (int hlf = 0; hlf < 2; ++hlf) { const int cc = c + 4 * hlf;
                    const f32x4 xv = *(const f32x4*)(x + (size_t)m * DM + cc), gp = *(const f32x4*)(gpost + cc), gt = *(const f32x4*)(ADA + b * 3072 + 2048 + cc);
                    f32x4 ov; ov.x = o[j][4 * hlf + 0]; ov.y = o[j][4 * hlf + 1]; ov.z = o[j][4 * hlf + 2]; ov.w = o[j][4 * hlf + 3];
                    *(f32x4*)(out + (size_t)m * DM + cc) = xv + gt * (ov * rinv * gp); } }
        }
    }
#undef IN
#undef BOTH
#undef GRID_BAR
}

extern "C" void kernel_launch(void* const* d_in, const int* in_sizes, int n_in, void* d_out, int out_size, void* d_ws, size_t ws_size, hipStream_t stream) {
    static int grid = 0;
    if (grid == 0) {
        if (n_in != NIN || in_sizes[0] != M * DM || out_size != M * DM || ws_size < WS_END) { fprintf(stderr, "kernel_launch: unexpected shapes: n_in %d in0 %d out %d ws %zu (need %zu)\n", n_in, n_in > 0 ? in_sizes[0] : -1, out_size, ws_size, (size_t)WS_END); grid = -1; return; }
        int dev = 0, cus = 0;
        if (hipGetDevice(&dev) != hipSuccess || hipDeviceGetAttribute(&cus, hipDeviceAttributeMultiprocessorCount, dev) != hipSuccess) { fprintf(stderr, "kernel_launch: device query failed\n"); grid = -1; return; }
        if (hipFuncSetAttribute((const void*)mk_fwd, hipFuncAttributeMaxDynamicSharedMemorySize, LDS_BYTES) != hipSuccess) { fprintf(stderr, "kernel_launch: hipFuncSetAttribute failed\n"); grid = -1; return; }
        (void)hipGetLastError();
        grid = cus;
        if (grid != 256) fprintf(stderr, "kernel_launch: %d CUs (built for 256)\n", grid);
    }
    if (grid < 0) return;
    if (hipMemsetAsync((char*)d_ws + WS_CTL, 0, CTL_ZERO_BYTES, stream) != hipSuccess) { fprintf(stderr, "kernel_launch: memset failed\n"); return; }
    Args a{};
    for (int i = 0; i < NIN; ++i) a.in[i] = (const float*)d_in[i];
    a.out = (float*)d_out; a.ws = (unsigned char*)d_ws;
    for (int li = 0; li < N_LAUNCHES; ++li) {
        a.ph_lo = (N_LAUNCHES == 1) ? 0 : li; a.ph_hi = (N_LAUNCHES == 1) ? N_PHASES : li + 1; a.li = li;
        hipLaunchKernelGGL(mk_fwd, dim3(grid), dim3(NWAVES * 64), LDS_BYTES, stream, a);
        const hipError_t le = hipPeekAtLastError();
        if (le != hipSuccess) { fprintf(stderr, "kernel_launch: launch %d failed: %s\n", li, hipGetErrorName(le)); break; }
    }
}
```

```cpp
#include <hip/hip_runtime.h>
#include <cstdio>
#include <cstdint>
namespace pg8 {
#define PG8_LAS __attribute__((address_space(3)))
typedef unsigned short bf16_t;
typedef short bf16x8 __attribute__((ext_vector_type(8)));
typedef float f32x4 __attribute__((ext_vector_type(4)));
typedef unsigned u32x4 __attribute__((ext_vector_type(4)));
constexpr int BM = 256, BK = 64, HALF = 128, HTB = HALF * BK * 2  , STAGE_BYTES = 8 * HTB, NXCD = 8, WGM = 8;

__host__ __device__ __forceinline__ int lds_byte(int r, int c) { const int st = (r >> 4) * 2 + (c >> 5), rr = r & 15, cc = c & 31, ob = rr * 64 + cc * 2; return st * 1024 + (ob ^ (((ob >> 9) & 1) << 5)); }
__host__ __device__ __forceinline__ void stage_rc(int b, int& R, int& C) { const int st = b / 1024, sb = b % 1024, swz = sb ^ (((sb >> 9) & 1) << 5); R = (st >> 1) * 16 + swz / 64; C = (st & 1) * 32 + (swz % 64) / 2; }
__host__ __device__ __forceinline__ int perm32(int rho) { const int n = rho >> 4, i = rho & 15; return 8 * (i >> 2) + 4 * n + (i & 3); }

struct Unit { int pm, pn; };
struct Gemm { const bf16_t* A; const bf16_t* Bt; int M, N, K, lda; };

struct StaticOrder {
    int nM, nN, nwg, G, c;
    __host__ __device__ void init(int M, int N, int G_, int c_) { nM = M / BM; nN = N / BM; nwg = nM * nN; G = G_; c = c_; }
    __host__ __device__ bool next(int i, Unit& u) const {
        const long L = (long)i * G + c; if (L >= nwg) return false;
        int wgid = (int)L; { const int q = nwg / NXCD, r = nwg % NXCD, xcd = wgid % NXCD, off = wgid / NXCD; wgid = (xcd < r ? xcd * (q + 1) : r * (q + 1) + (xcd - r) * q) + off; }
        const int nig = WGM * nN, gid = wgid / nig, fm = gid * WGM, gsz = (nM - fm) < WGM ? (nM - fm) : WGM;
        u.pm = fm + ((wgid % nig) % gsz); u.pn = (wgid % nig) / gsz; return true;
    }
    __device__ __forceinline__ void a_ready(const Unit&) const {}
    __device__ __forceinline__ void done(const Unit&) const {}
};

__device__ __forceinline__ unsigned cvt_pk_bf16(float lo, float hi) { unsigned r; asm volatile("v_cvt_pk_bf16_f32 %0, %1, %2" : "=v"(r) : "v"(lo), "v"(hi)); return r; }
typedef float f32x2 __attribute__((ext_vector_type(2)));
__device__ __forceinline__ f32x2 gelu_pk(f32x2 v) {
    const f32x2 av = __builtin_elementwise_abs(v), d = av * 0.2316418882f + 1.0f;
    f32x2 t; t.x = __builtin_amdgcn_rcpf(d.x); t.y = __builtin_amdgcn_rcpf(d.y);
    f32x2 q = t * 0.5307027145f + (-0.7265760135f); q = q * t + 0.7107068705f; q = q * t + (-0.142248368f); q = q * t + 0.127414796f; q = q * t;
    const f32x2 s = (v * v) * (-0.72134752044f);
    f32x2 e; e.x = __builtin_amdgcn_exp2f(s.x); e.y = __builtin_amdgcn_exp2f(s.y);
    const f32x2 m = v * (q * e), r = v - m;
    f32x2 o; o.x = v.x < 0.f ? m.x : r.x; o.y = v.y < 0.f ? m.y : r.y; return o;
}

template <int ACT  > struct EpiBf16 {
    static constexpr bool PERM = true, AFTER_DRAIN = false; static_assert(ACT == 0 || ACT == 1, "EpiBf16: ACT is 0 (none) or 1 (gelu_pk)");
    bf16_t* O; int ldc; const float* bias; int split_cols; size_t split_stride; float scale0;
    __device__ __forceinline__ void operator()(const f32x4 (&acc)[2][2][4][2], const Unit& u, int wr, int wc, int fr, int fq) const {
        const int row0 = u.pm * BM + wr * 64 + fr; int colt = u.pn * BM; bf16_t* base = O;
        float sc = 1.f; if (split_cols) { const int t = colt / split_cols; base += (size_t)t * split_stride; colt -= t * split_cols; if (t == 0) sc = scale0; }
        const int col0 = colt + wc * 32 + 8 * fq, bcol0 = u.pn * BM + wc * 32 + 8 * fq;
        f32x4 bv[2][2];
#pragma unroll
        for (int bj = 0; bj < 2; ++bj)
#pragma unroll
            for (int n = 0; n < 2; ++n) bv[bj][n] = bias ? *(const f32x4*)(bias + bcol0 + bj * HALF + 4 * n) : (f32x4){0.f, 0.f, 0.f, 0.f};
#pragma unroll
        for (int ai = 0; ai < 2; ++ai)
#pragma unroll
            for (int m = 0; m < 4; ++m) { bf16_t* rowp = base + (size_t)(row0 + ai * HALF + m * 16) * ldc + col0;
#pragma unroll
                for (int bj = 0; bj < 2; ++bj) { f32x4 v0 = acc[ai][bj][m][0] + bv[bj][0], v1 = acc[ai][bj][m][1] + bv[bj][1];
                    if (ACT == 1) { f32x2 a = gelu_pk((f32x2){v0[0], v0[1]}), b = gelu_pk((f32x2){v0[2], v0[3]}), c = gelu_pk((f32x2){v1[0], v1[1]}), d = gelu_pk((f32x2){v1[2], v1[3]});
                        v0 = (f32x4){a.x, a.y, b.x, b.y}; v1 = (f32x4){c.x, c.y, d.x, d.y}; }
                    v0 = v0 * sc; v1 = v1 * sc; u32x4 w; w.x = cvt_pk_bf16(v0[0], v0[1]); w.y = cvt_pk_bf16(v0[2], v0[3]); w.z = cvt_pk_bf16(v1[0], v1[1]); w.w = cvt_pk_bf16(v1[2], v1[3]);
                    *(u32x4*)(rowp + bj * HALF) = w; } }
    }
};
template <class Epi, class Sched, bool ALIGN_EPI = false, bool SP2 = false>
__device__ __forceinline__ void gemm_phase(PG8_LAS unsigned char* lds, const Gemm g, const Sched& S, const Epi& E) {
    const int tid = threadIdx.x, wid = __builtin_amdgcn_readfirstlane(tid >> 6), lane = tid & 63, wr = wid >> 2, wc = wid & 3, fr = lane & 15, fq = lane >> 4;
    const int K = g.K, nt = K / BK;
    unsigned voffA[2], voffB[2];
#pragma unroll
    for (int i = 0; i < 2; ++i) { int R, C; stage_rc(tid * 16 + i * 8192, R, C); const int Rb = Epi::PERM ? ((R & ~31) + perm32(R & 31)) : R;
        voffA[i] = (unsigned)(R * g.lda + C) * 2u; voffB[i] = (unsigned)(Rb * K + C) * 2u; }
    const size_t kstep = (size_t)(BK * 2);
    const size_t hstepB = (size_t)HALF * K * 2, hstepA = (size_t)HALF * g.lda * 2;
    const size_t tstepB = 2 * hstepB, tstepA = 2 * hstepA;
    const unsigned ldsw = (unsigned)wid * 1024u;
    const int aoff = lds_byte(wr * 64 + fr, fq * 8), boff = lds_byte(wc * 32 + fr, fq * 8);
#define PG8_SA(b, h) (((b) * 2 + (h)) * HTB)
#define PG8_SB(b, h) ((4 + (b) * 2 + (h)) * HTB)
#define PG8_STAGE(bufoff, gbase, voff) do { _Pragma("unroll") for (int _i = 0; _i < 2; ++_i) \
        __builtin_amdgcn_global_load_lds((const unsigned*)((const char*)(gbase) + (voff)[_i]), (PG8_LAS unsigned*)(lds + (bufoff) + ldsw + _i * 8192), 16, 0, 0); } while (0)
#define PG8_LDA(dst, b, h) do { _Pragma("unroll") for (int m = 0; m < 4; ++m) _Pragma("unroll") for (int k = 0; k < 2; ++k) dst[m][k] = *(const PG8_LAS bf16x8*)(lds + PG8_SA(b, h) + aoff + m * 2048 + k * 1024); } while (0)
#define PG8_LDB(dst, b, h) do { _Pragma("unroll") for (int n = 0; n < 2; ++n) _Pragma("unroll") for (int k = 0; k < 2; ++k) dst[n][k] = *(const PG8_LAS bf16x8*)(lds + PG8_SB(b, h) + boff + n * 2048 + k * 1024); } while (0)
#define PG8_MMA(ai, bj, At, Bt) do { __builtin_amdgcn_s_setprio(1); _Pragma("unroll") for (int m = 0; m < 4; ++m) _Pragma("unroll") for (int n = 0; n < 2; ++n) _Pragma("unroll") for (int k = 0; k < 2; ++k) \
        acc[ai][bj][m][n] = __builtin_amdgcn_mfma_f32_16x16x32_bf16(Bt[n][k], At[m][k], acc[ai][bj][m][n], 0, 0, 0); __builtin_amdgcn_s_setprio(0); } while (0)
#define PG8_WAIT_V(n) asm volatile("s_waitcnt vmcnt(" #n ")" ::: "memory")
#define PG8_WAIT_L(n) asm volatile("s_waitcnt lgkmcnt(" #n ")" ::: "memory")
#define PG8_BAR __builtin_amdgcn_s_barrier()
#define PG8_SCHED __builtin_amdgcn_sched_barrier(0)
    Unit cur, nxt; int ui = 0;
    if (!S.next(0, cur)) return;
    f32x4 acc[2][2][4][2];
#pragma unroll
    for (int a = 0; a < 2; ++a)
#pragma unroll
        for (int b = 0; b < 2; ++b)
#pragma unroll
            for (int m = 0; m < 4; ++m)
#pragma unroll
                for (int n = 0; n < 2; ++n) acc[a][b][m][n] = (f32x4){0.f, 0.f, 0.f, 0.f};
    bf16x8 At[4][2], B0[2][2], B1[2][2];
    const char* cA = (const char*)g.A + (size_t)cur.pm * tstepA; const char* cB = (const char*)g.Bt + (size_t)cur.pn * tstepB;
    S.a_ready(cur);
    if constexpr (SP2) {
        PG8_STAGE(PG8_SB(0, 0), cB, voffB); PG8_STAGE(PG8_SB(0, 1), cB + hstepB, voffB); PG8_STAGE(PG8_SA(0, 0), cA, voffA); PG8_STAGE(PG8_SA(0, 1), cA + hstepA, voffA);
        if (wr == 1) PG8_BAR;
        PG8_WAIT_V(2); PG8_BAR;
        PG8_STAGE(PG8_SB(1, 0), cB + kstep, voffB); PG8_STAGE(PG8_SA(1, 0), cA + kstep, voffA); PG8_STAGE(PG8_SB(1, 1), cB + hstepB + kstep, voffB);
        PG8_WAIT_V(6); PG8_BAR;
    } else {
        PG8_STAGE(PG8_SB(0, 0), cB, voffB); PG8_STAGE(PG8_SA(0, 0), cA, voffA); PG8_STAGE(PG8_SB(0, 1), cB + hstepB, voffB); PG8_STAGE(PG8_SA(0, 1), cA + hstepA, voffA);
        if (wr == 1) PG8_BAR;
        PG8_WAIT_V(4); PG8_BAR;
        PG8_STAGE(PG8_SB(1, 0), cB + kstep, voffB); PG8_STAGE(PG8_SA(1, 0), cA + kstep, voffA); PG8_STAGE(PG8_SB(1, 1), cB + hstepB + kstep, voffB);
        PG8_WAIT_V(6); PG8_BAR;
    }
    for (;;) {
        const bool has_next = S.next(ui + 1, nxt);
        const char* nA = has_next ? (const char*)g.A + (size_t)nxt.pm * tstepA : cA; const char* nB = has_next ? (const char*)g.Bt + (size_t)nxt.pn * tstepB : cB;
        for (int t = 0; t < nt; t += 2) {
            const bool last = (t == nt - 2);
            const char* a1 = cA + (size_t)(t + 1) * kstep;
            const char* a2 = last ? nA : cA + (size_t)(t + 2) * kstep; const char* b2 = last ? nB : cB + (size_t)(t + 2) * kstep;
            const char* a3 = a2 + kstep; const char* b3 = b2 + kstep;
            if (last && has_next) S.a_ready(nxt);
            if constexpr (SP2) {
            PG8_LDB(B0, 0, 0); PG8_LDB(B1, 0, 1); PG8_SCHED; PG8_LDA(At, 0, 0); PG8_STAGE(PG8_SA(1, 1), a1 + hstepA, voffA);
            PG8_WAIT_V(8); PG8_WAIT_L(0); PG8_BAR; PG8_MMA(0, 0, At, B0); PG8_MMA(0, 1, At, B1); PG8_BAR; PG8_SCHED;
            PG8_LDA(At, 0, 1); PG8_STAGE(PG8_SB(0, 0), b2, voffB); PG8_STAGE(PG8_SB(0, 1), b2 + hstepB, voffB); PG8_STAGE(PG8_SA(0, 0), a2, voffA);
            PG8_WAIT_V(8); PG8_WAIT_L(0); PG8_BAR; PG8_MMA(1, 0, At, B0); PG8_MMA(1, 1, At, B1); PG8_BAR; PG8_SCHED;
            PG8_LDB(B0, 1, 0); PG8_LDB(B1, 1, 1); PG8_SCHED; PG8_LDA(At, 1, 0); PG8_STAGE(PG8_SA(0, 1), a2 + hstepA, voffA);
            PG8_WAIT_V(8); PG8_WAIT_L(0); PG8_BAR; PG8_MMA(0, 0, At, B0); PG8_MMA(0, 1, At, B1); PG8_BAR; PG8_SCHED;
            PG8_LDA(At, 1, 1); PG8_STAGE(PG8_SB(1, 0), b3, voffB); PG8_STAGE(PG8_SB(1, 1), b3 + hstepB, voffB); PG8_STAGE(PG8_SA(1, 0), a3, voffA);
            PG8_WAIT_V(8); PG8_WAIT_L(0); PG8_BAR; PG8_MMA(1, 0, At, B0); PG8_MMA(1, 1, At, B1); PG8_BAR; PG8_SCHED;
            } else {
            PG8_LDB(B0, 0, 0); PG8_SCHED; PG8_LDA(At, 0, 0); PG8_STAGE(PG8_SA(1, 1), a1 + hstepA, voffA);
            PG8_WAIT_L(8); PG8_BAR; PG8_WAIT_L(0); PG8_MMA(0, 0, At, B0); PG8_BAR; PG8_SCHED;
            PG8_LDB(B1, 0, 1); PG8_STAGE(PG8_SB(0, 0), b2, voffB);
            PG8_BAR; PG8_WAIT_L(0); PG8_MMA(0, 1, At, B1); PG8_BAR;
            PG8_LDA(At, 0, 1); PG8_STAGE(PG8_SA(0, 0), a2, voffA);
            PG8_BAR; PG8_WAIT_L(0); PG8_MMA(1, 0, At, B0); PG8_BAR; PG8_SCHED;
            PG8_STAGE(PG8_SB(0, 1), b2 + hstepB, voffB);
            PG8_WAIT_V(6); PG8_BAR; PG8_MMA(1, 1, At, B1); PG8_BAR;
            PG8_LDB(B0, 1, 0); PG8_SCHED; PG8_LDA(At, 1, 0); PG8_STAGE(PG8_SA(0, 1), a2 + hstepA, voffA);
            PG8_WAIT_L(8); PG8_BAR; PG8_WAIT_L(0); PG8_MMA(0, 0, At, B0); PG8_BAR; PG8_SCHED;
            PG8_LDB(B1, 1, 1); PG8_STAGE(PG8_SB(1, 0), b3, voffB);
            PG8_BAR; PG8_WAIT_L(0); PG8_MMA(0, 1, At, B1); PG8_BAR;
            PG8_LDA(At, 1, 1); PG8_STAGE(PG8_SA(1, 0), a3, voffA);
            PG8_BAR; PG8_WAIT_L(0); PG8_MMA(1, 0, At, B0); PG8_BAR; PG8_SCHED;
            PG8_STAGE(PG8_SB(1, 1), b3 + hstepB, voffB);
            PG8_WAIT_V(6); PG8_BAR; PG8_MMA(1, 1, At, B1); PG8_BAR;
            }
        }
        if constexpr (ALIGN_EPI) { if (wr == 0) PG8_BAR; }
        if constexpr (!Epi::AFTER_DRAIN) { E(acc, cur, wr, wc, fr, fq); S.done(cur); }
        if (!has_next) break;
#pragma unroll
        for (int a = 0; a < 2; ++a)
#pragma unroll
            for (int b = 0; b < 2; ++b)
#pragma unroll
                for (int m = 0; m < 4; ++m)
#pragma unroll
                    for (int n = 0; n < 2; ++n) acc[a][b][m][n] = (f32x4){0.f, 0.f, 0.f, 0.f};
        cur = nxt; cA = nA; cB = nB; ++ui;
        if constexpr (ALIGN_EPI) { if (wr == 1) PG8_BAR; }
    }
    PG8_WAIT_V(0);
    if constexpr (!ALIGN_EPI) { if (wr == 0) PG8_BAR; }
    PG8_BAR;
    if constexpr (Epi::AFTER_DRAIN) { E.fused(acc, cur, wr, wc, fr, fq, lds, wid, lane); S.done(cur); }
#undef PG8_SA
#undef PG8_SB
#undef PG8_STAGE
#undef PG8_LDA
#undef PG8_LDB
#undef PG8_MMA
#undef PG8_WAIT_V
#undef PG8_WAIT_L
#undef PG8_BAR
#undef PG8_SCHED
}
}
namespace pg8 {
struct EpiRoute {
    static constexpr bool PERM = true, AFTER_DRAIN = false;
    bf16_t* base0; bf16_t* base1; int ldc0, ldc1, tile1;
    __device__ __forceinline__ void operator()(const f32x4 (&acc)[2][2][4][2], const Unit& u, int wr, int wc, int fr, int fq) const {
        const bool second = u.pn >= tile1;
        bf16_t* O = second ? base1 : base0; const int ld = second ? ldc1 : ldc0; const int colt = (second ? u.pn - tile1 : u.pn) * BM;
        const int row0 = u.pm * BM + wr * 64 + fr;
        const int col0 = colt + wc * 32 + 8 * fq;
#pragma unroll
        for (int ai = 0; ai < 2; ++ai)
#pragma unroll
            for (int m = 0; m < 4; ++m) { bf16_t* rowp = O + (size_t)(row0 + ai * HALF + m * 16) * ld + col0;
#pragma unroll
                for (int bj = 0; bj < 2; ++bj) { const f32x4 v0 = acc[ai][bj][m][0], v1 = acc[ai][bj][m][1];
                    u32x4 w; w.x = cvt_pk_bf16(v0[0], v0[1]); w.y = cvt_pk_bf16(v0[2], v0[3]); w.z = cvt_pk_bf16(v1[0], v1[1]); w.w = cvt_pk_bf16(v1[2], v1[3]);
                    *(u32x4*)(rowp + bj * HALF) = w; } }
    }
};
}
namespace pg8 {
__device__ __forceinline__ float sigm(float x) { return __builtin_amdgcn_rcpf(1.0f + __expf(-x)); }
struct EpiLora {
    static constexpr bool PERM = true, AFTER_DRAIN = false;
    bf16_t* O; const float* w0; const float* a0;
    __device__ __forceinline__ void operator()(const f32x4 (&acc)[2][2][4][2], const Unit& u, int wr, int wc, int fr, int fq) const {
        const int row0 = u.pm * BM + wr * 64 + fr, col0 = u.pn * BM + wc * 32 + 8 * fq;
        const float* par = (u.pn >= 4) ? (a0 - 1024) : w0;
#pragma unroll
        for (int ai = 0; ai < 2; ++ai)
#pragma unroll
            for (int m = 0; m < 4; ++m) {
#pragma unroll
                for (int bj = 0; bj < 2; ++bj) { bf16_t* rowp = O + (size_t)(row0 + ai * HALF + m * 16) * 2048 + col0 + bj * HALF;
                    const f32x4 x0 = acc[ai][bj][m][0] + *(const f32x4*)(par + col0 + bj * HALF), x1 = acc[ai][bj][m][1] + *(const f32x4*)(par + col0 + bj * HALF + 4); u32x4 w;
                    w.x = cvt_pk_bf16(sigm(x0[0]), sigm(x0[1])); w.y = cvt_pk_bf16(sigm(x0[2]), sigm(x0[3])); w.z = cvt_pk_bf16(sigm(x1[0]), sigm(x1[1])); w.w = cvt_pk_bf16(sigm(x1[2]), sigm(x1[3]));
                    *(u32x4*)rowp = w; }
                asm volatile("" ::: "memory"); }
    }
};
template <int MODE> struct EpiGate {
    static constexpr bool PERM = true, AFTER_DRAIN = false;
    bf16_t* O; const bf16_t* Gl;
    __device__ __forceinline__ void operator()(const f32x4 (&acc)[2][2][4][2], const Unit& u, int wr, int wc, int fr, int fq) const {
        const int row0 = u.pm * BM + wr * 64 + fr, col0 = u.pn * BM + wc * 32 + 8 * fq;
#pragma unroll
        for (int ai = 0; ai < 2; ++ai) {
            u32x4 gq[4][2], tq[4][2];
#pragma unroll
            for (int m = 0; m < 4; ++m)
#pragma unroll
                for (int bj = 0; bj < 2; ++bj) { const size_t row = (size_t)(row0 + ai * HALF + m * 16); const int col = col0 + bj * HALF;
                    gq[m][bj] = *(const u32x4*)(Gl + row * 2048 + MODE * 1024 + col);
                    if (MODE == 1) tq[m][bj] = *(const u32x4*)(O + row * 1024 + col); }
#pragma unroll
            for (int m = 0; m < 4; ++m)
#pragma unroll
                for (int bj = 0; bj < 2; ++bj) { const size_t row = (size_t)(row0 + ai * HALF + m * 16); const int col = col0 + bj * HALF;
                    const unsigned gw[4] = {gq[m][bj].x, gq[m][bj].y, gq[m][bj].z, gq[m][bj].w}; float g[8];
#pragma unroll
                    for (int e = 0; e < 4; ++e) { g[2 * e] = sigm(__builtin_bit_cast(float, gw[e] << 16)); g[2 * e + 1] = sigm(__builtin_bit_cast(float, gw[e] & 0xffff0000u)); }
                    const f32x4 v0 = acc[ai][bj][m][0], v1 = acc[ai][bj][m][1];
                    float r[8] = {g[0] * v0[0], g[1] * v0[1], g[2] * v0[2], g[3] * v0[3], g[4] * v1[0], g[5] * v1[1], g[6] * v1[2], g[7] * v1[3]};
                    if (MODE == 1) { const unsigned tw[4] = {tq[m][bj].x, tq[m][bj].y, tq[m][bj].z, tq[m][bj].w};
#pragma unroll
                        for (int e = 0; e < 4; ++e) { r[2 * e] += __builtin_bit_cast(float, tw[e] << 16); r[2 * e + 1] += __builtin_bit_cast(float, tw[e] & 0xffff0000u); } }
                    u32x4 w; w.x = cvt_pk_bf16(r[0], r[1]); w.y = cvt_pk_bf16(r[2], r[3]); w.z = cvt_pk_bf16(r[4], r[5]); w.w = cvt_pk_bf16(r[6], r[7]);
                    *(u32x4*)(O + row * 1024 + col) = w; }
        }
    }
};
}
namespace pg8 {
struct EpiGateCat {
    static constexpr bool PERM = true, AFTER_DRAIN = false;
    bf16_t* O; const bf16_t* Gl;
    __device__ __forceinline__ void mid(f32x4 (&acc)[2][2][4][2], const Unit& u, int wr, int wc, int fr, int fq) const {
        const int row0 = u.pm * BM + wr * 64 + fr, col0 = u.pn * BM + wc * 32 + 8 * fq;
#pragma unroll
        for (int ai = 0; ai < 2; ++ai) {
            u32x4 gr[4][2], ga[4][2];
#pragma unroll
            for (int m = 0; m < 4; ++m)
#pragma unroll
                for (int bj = 0; bj < 2; ++bj) { const size_t row = (size_t)(row0 + ai * HALF + m * 16); const int col = col0 + bj * HALF;
                    gr[m][bj] = *(const u32x4*)(Gl + row * 2048 + col); ga[m][bj] = *(const u32x4*)(Gl + row * 2048 + 1024 + col); }
#pragma unroll
            for (int m = 0; m < 4; ++m)
#pragma unroll
                for (int bj = 0; bj < 2; ++bj) { const unsigned wr_[4] = {gr[m][bj].x, gr[m][bj].y, gr[m][bj].z, gr[m][bj].w}, wa_[4] = {ga[m][bj].x, ga[m][bj].y, ga[m][bj].z, ga[m][bj].w}; float rt[8];
#pragma unroll
                    for (int e = 0; e < 4; ++e) {
                        const float r0 = __builtin_bit_cast(float, wr_[e] << 16), r1 = __builtin_bit_cast(float, wr_[e] & 0xffff0000u), a0 = __builtin_bit_cast(float, wa_[e] << 16), a1 = __builtin_bit_cast(float, wa_[e] & 0xffff0000u);
                        rt[2 * e] = (1.0f + __expf(-a0)) * __builtin_amdgcn_rcpf(1.0f + __expf(-r0)); rt[2 * e + 1] = (1.0f + __expf(-a1)) * __builtin_amdgcn_rcpf(1.0f + __expf(-r1)); }
                    acc[ai][bj][m][0] = acc[ai][bj][m][0] * (f32x4){rt[0], rt[1], rt[2], rt[3]}; acc[ai][bj][m][1] = acc[ai][bj][m][1] * (f32x4){rt[4], rt[5], rt[6], rt[7]}; }
        }
    }
    __device__ __forceinline__ void operator()(const f32x4 (&acc)[2][2][4][2], const Unit& u, int wr, int wc, int fr, int fq) const {
        const int row0 = u.pm * BM + wr * 64 + fr, col0 = u.pn * BM + wc * 32 + 8 * fq;
#pragma unroll
        for (int ai = 0; ai < 2; ++ai) {
            u32x4 ga[4][2];
#pragma unroll
            for (int m = 0; m < 4; ++m)
#pragma unroll
                for (int bj = 0; bj < 2; ++bj) { const size_t row = (size_t)(row0 + ai * HALF + m * 16); const int col = col0 + bj * HALF; ga[m][bj] = *(const u32x4*)(Gl + row * 2048 + 1024 + col); }
#pragma unroll
            for (int m = 0; m < 4; ++m)
#pragma unroll
                for (int bj = 0; bj < 2; ++bj) { const size_t row = (size_t)(row0 + ai * HALF + m * 16); const int col = col0 + bj * HALF;
                    const unsigned wa_[4] = {ga[m][bj].x, ga[m][bj].y, ga[m][bj].z, ga[m][bj].w}; float g[8];
#pragma unroll
                    for (int e = 0; e < 4; ++e) { g[2 * e] = sigm(__builtin_bit_cast(float, wa_[e] << 16)); g[2 * e + 1] = sigm(__builtin_bit_cast(float, wa_[e] & 0xffff0000u)); }
                    const f32x4 v0 = acc[ai][bj][m][0], v1 = acc[ai][bj][m][1];
                    u32x4 w; w.x = cvt_pk_bf16(g[0] * v0[0], g[1] * v0[1]); w.y = cvt_pk_bf16(g[2] * v0[2], g[3] * v0[3]); w.z = cvt_pk_bf16(g[4] * v1[0], g[5] * v1[1]); w.w = cvt_pk_bf16(g[6] * v1[2], g[7] * v1[3]);
                    *(u32x4*)(O + row * 1024 + col) = w; }
        }
    }
};
}
#define GAS __attribute__((address_space(1)))
#define LAS __attribute__((address_space(3)))
typedef unsigned short bf16;
typedef unsigned v4u __attribute__((ext_vector_type(4)));
typedef float f32x4 __attribute__((ext_vector_type(4)));
typedef short bf16x8 __attribute__((ext_vector_type(8)));
typedef GAS unsigned gu32;
typedef GAS unsigned long long gu64;
#define RLX_AGENT __ATOMIC_RELAXED, __HIP_MEMORY_SCOPE_AGENT
#define LDS_WAIT() asm volatile("s_waitcnt lgkmcnt(0)" ::: "memory")
#define VM_WAIT() asm volatile("s_waitcnt vmcnt(0)" ::: "memory")
__device__ __forceinline__ unsigned long long rt() { return __builtin_amdgcn_s_memrealtime(); }
__device__ __forceinline__ unsigned f2bf(float f) { unsigned u = __builtin_bit_cast(unsigned, f); return (u + 0x7fffu + ((u >> 16) & 1u)) >> 16; }
__device__ __forceinline__ unsigned pk2(float lo, float hi) { return f2bf(lo) | (f2bf(hi) << 16); }
#define XB_TMO      128
#define XB_XCNT(j)  (256  + 64 * (j))
#define XB_XSUB(j)  (1280 + 64 * (j))
#define XB_XGEN(j)  (2304 + 64 * (j))
#define XB_TOP      3328
#define XB_TOPGEN   3392
#define XCD_BAR_WORDS 3456
#define XB_SPIN_CAP (1u << 18)

__device__ __forceinline__ unsigned xb_ld(unsigned* p)              { return __hip_atomic_load(p, __ATOMIC_RELAXED, __HIP_MEMORY_SCOPE_AGENT); }
__device__ __forceinline__ unsigned xb_add(unsigned* p, unsigned v) { return __hip_atomic_fetch_add(p, v, __ATOMIC_RELAXED, __HIP_MEMORY_SCOPE_AGENT); }
__device__ __forceinline__ unsigned xb_xcc_id() { return (unsigned)__builtin_amdgcn_s_getreg((3 << 11) | 20) & 0xFu; }
#define XB_SPIN(cond, bar) do { unsigned _sp = 0; while (cond) { __builtin_amdgcn_s_sleep(1); \
    if ((++_sp & 255u) == 0u) { if (xb_ld(&(bar)[XB_TMO])) break; if (_sp > XB_SPIN_CAP) { atomicAdd(&(bar)[XB_TMO], 1u); break; } } } } while (0)

struct XcdBarrier {
    unsigned* bar; unsigned x;
    volatile LAS unsigned* st;
};

__device__ __forceinline__ XcdBarrier xcd_barrier_post(unsigned* bar, volatile LAS unsigned* st) {
    XcdBarrier b; b.bar = bar; b.x = xb_xcc_id(); b.st = st;
    if (threadIdx.x == 0) (void)xb_add(&bar[XB_XCNT(b.x)], 1u);
    return b;
}
__device__ __forceinline__ void xcd_barrier_complete(unsigned* bar, unsigned x, unsigned& nloc, unsigned& nx) {
    const unsigned G = gridDim.x * gridDim.y * gridDim.z;
    unsigned sum, cnt, mine, sp = 0u;
    for (;;) {
        sum = 0u; cnt = 0u; mine = 0u;
#pragma unroll
        for (unsigned j = 0; j < 16; ++j) { const unsigned c = xb_ld(&bar[XB_XCNT(j)]); sum += c; cnt += (c > 0u) ? 1u : 0u; mine = (j == x) ? c : mine; }
        if (sum == G) break;
        __builtin_amdgcn_s_sleep(1);
        if ((++sp & 255u) == 0u) { if (xb_ld(&bar[XB_TMO])) break; if (sp > XB_SPIN_CAP) { atomicAdd(&bar[XB_TMO], 1u); break; } }
    }
    nloc = mine > 0u ? mine : 1u; nx = cnt > 0u ? cnt : 1u;
}

__device__ __forceinline__ void xcd_barrier(const XcdBarrier& b) {
    asm volatile("s_waitcnt vmcnt(0)" ::: "memory");
    __syncthreads();
    if (threadIdx.x == 0) {
        unsigned* bar = b.bar;
        __builtin_amdgcn_s_waitcnt(0);
        unsigned nloc = b.st[0], nx = b.st[1];
        if (nloc == 0u) { xcd_barrier_complete(bar, b.x, nloc, nx); b.st[0] = nloc; b.st[1] = nx; }
        const unsigned old = xb_add(&bar[XB_XSUB(b.x)], 1u);
        const unsigned gen = old / nloc;
        if (old + 1u == (gen + 1u) * nloc) {
            __builtin_amdgcn_fence(__ATOMIC_RELEASE, "agent");
            asm volatile("s_waitcnt vmcnt(0)" ::: "memory");
            const unsigned og = xb_add(&bar[XB_TOP], 1u);
            const unsigned tg = og / nx;
            if (og + 1u == (tg + 1u) * nx) xb_add(&bar[XB_TOPGEN], 1u);
            else XB_SPIN(xb_ld(&bar[XB_TOPGEN]) == tg, bar);
            __builtin_amdgcn_fence(__ATOMIC_ACQUIRE, "agent");
            xb_add(&bar[XB_XGEN(b.x)], 1u);
            asm volatile("s_waitcnt vmcnt(0)" ::: "memory");
        } else {
            XB_SPIN(xb_ld(&bar[XB_XGEN(b.x)]) == gen, bar);
            __builtin_amdgcn_fence(__ATOMIC_ACQUIRE, "agent");
            asm volatile("s_waitcnt vmcnt(0)" ::: "memory");
        }
    }
    __syncthreads();
}
constexpr int NWAVES = 8;
constexpr int BATCH = 32, SEQ = 2048, DM = 1024, M = BATCH * SEQ;
constexpr int RW = 512, RCOLS = 2304, ACOLS = 1280, GCOLS = 2048;
enum { I_X = 0, I_C, I_WADA, I_BADA, I_GPRE, I_GPOST, I_WIN, I_MU, I_W0, I_WUP, I_A0, I_AUP, I_KK, I_KA, I_RK, I_GNW, I_GNB, I_SINK, I_WBRR, I_WBRA, I_WOUT, NIN };
#ifndef MK_N_LAUNCHES
#define MK_N_LAUNCHES 1
#endif
constexpr int N_PHASES = 12;
#ifndef MK_PLAN
#define MK_PLAN {{0, N_PHASES}}
#endif
#ifndef MK_PROBE_FLAGS
#define MK_PROBE_FLAGS 0
#endif
constexpr int N_LAUNCHES = MK_N_LAUNCHES;
constexpr size_t MiB = 1u << 20;
constexpr size_t WS_CTL = 0, CTL_ZERO_BYTES = 1 * MiB;
constexpr size_t WS_ADA = 512 * 1024;
constexpr size_t WS_BSUM = 2 * MiB;
constexpr size_t WS_BP4 = 984 * MiB;
constexpr size_t WS_WINT = 4 * MiB;
constexpr size_t WS_WBRR = 15 * MiB, WS_WBRA = 16 * MiB, WS_WOUT = 17 * MiB, WS_WLORA = 19 * MiB;
constexpr size_t WS_H = 24 * MiB;
constexpr size_t WS_PA = 152 * MiB;
constexpr size_t WS_PR = 312 * MiB;
constexpr size_t WS_KD1 = 568 * MiB;
constexpr size_t WS_LA = 600 * MiB;
constexpr size_t WS_R = 632 * MiB, WS_K = 696 * MiB, WS_V = 760 * MiB, WS_G = 824 * MiB, WS_KK = 888 * MiB;
constexpr size_t WS_MG = 568 * MiB;
constexpr size_t WS_PG = 312 * MiB;
constexpr size_t WS_BR = 568 * MiB;
constexpr size_t WS_BA = 824 * MiB;
constexpr size_t WS_KB = 952 * MiB, WS_VB = 968 * MiB;
constexpr size_t WS_END = 1024 * MiB;
constexpr int CW_BAR = 4096;
constexpr int RING_BYTES = 155648, LDSCTL_OFF = RING_BYTES, MISC_OFF = LDSCTL_OFF + 320, LDS_BYTES = 163840;

__device__ __forceinline__ float bflo(unsigned w) { return __builtin_bit_cast(float, w << 16); }
__device__ __forceinline__ float bfhi(unsigned w) { return __builtin_bit_cast(float, w & 0xffff0000u); }
__device__ __forceinline__ float bf2f(bf16 u) { return __builtin_bit_cast(float, (unsigned)u << 16); }
__device__ __forceinline__ void unpack8(const v4u q, float* f) { f[0] = bflo(q.x); f[1] = bfhi(q.x); f[2] = bflo(q.y); f[3] = bfhi(q.y); f[4] = bflo(q.z); f[5] = bfhi(q.z); f[6] = bflo(q.w); f[7] = bfhi(q.w); }
__device__ __forceinline__ unsigned cvtpk_c(float lo, float hi);
__device__ __forceinline__ v4u pack8(const float* f) { v4u o; o.x = cvtpk_c(f[0], f[1]); o.y = cvtpk_c(f[2], f[3]); o.z = cvtpk_c(f[4], f[5]); o.w = cvtpk_c(f[6], f[7]); return o; }
__device__ __forceinline__ float sigmoidf_(float x) { return __builtin_amdgcn_rcpf(1.0f + __expf(-x)); }
__device__ __forceinline__ float wave_sum(float v) {
#pragma unroll
    for (int o = 1; o < 64; o <<= 1) v += __shfl_xor(v, o);
    return v;
}
__device__ __forceinline__ void transpose_item(const float* W, int K, int N, bf16* WT, int ldwt, int row_off, int kcol_off, LAS float* scr, int item, int lane) {
    const int nblk = N / 32, kb = item / nblk, nb = item % nblk, k0 = 64 * kb, n0 = 32 * nb;
#pragma unroll 8
    for (int i = 0; i < 32; ++i) { const int kk = 2 * i + (lane >> 5); scr[kk * 33 + (lane & 31)] = W[(size_t)(k0 + kk) * N + n0 + (lane & 31)]; }
    LDS_WAIT(); asm volatile("" ::: "memory");
    const int c = lane & 7;
#pragma unroll
    for (int j = 0; j < 4; ++j) { const int n = (lane >> 3) + 8 * j; const LAS float* s = scr + (8 * c) * 33 + n;
        v4u o; o.x = pk2(s[0 * 33], s[1 * 33]); o.y = pk2(s[2 * 33], s[3 * 33]); o.z = pk2(s[4 * 33], s[5 * 33]); o.w = pk2(s[6 * 33], s[7 * 33]);
        *(GAS v4u*)(WT + (size_t)(row_off + n0 + n) * ldwt + kcol_off + k0 + 8 * c) = o; }
    LDS_WAIT(); asm volatile("" ::: "memory");
}

typedef unsigned u32x2_t __attribute__((ext_vector_type(2)));
typedef float f32x2_c __attribute__((ext_vector_type(2))); typedef __bf16 bf16x2_c __attribute__((ext_vector_type(2)));
__device__ __forceinline__ unsigned cvtpk_c(float lo, float hi) { const f32x2_c v = {lo, hi}; const bf16x2_c b = __builtin_convertvector(v, bf16x2_c); return __builtin_bit_cast(unsigned, b); }
__device__ __forceinline__ bf16x8 ldsfrag_perm(const LAS unsigned char* p) { const u32x2_t a = *(const LAS u32x2_t*)p, b = *(const LAS u32x2_t*)(p + 16); return __builtin_bit_cast(bf16x8, (v4u){a.x, a.y, b.x, b.y}); }
struct Args { const float* in[NIN]; float* out; unsigned char* ws; int ph_lo, ph_hi, li, pad; };

#define PTRS const int G = gridDim.x, bx = blockIdx.x; const int vcu = (G % 8 == 0) ? (bx % 8) * (G / 8) + bx / 8 : bx; const int gw = vcu * NWAVES + wave, NGW = G * NWAVES; (void)gw; (void)NGW; const float* x = args.in[I_X]; const float* cin = args.in[I_C]; const float* wada = args.in[I_WADA]; const float* bada = args.in[I_BADA]; const float* gpre = args.in[I_GPRE]; const float* gpost = args.in[I_GPOST]; const float* win = args.in[I_WIN]; const float* mu = args.in[I_MU]; const float* w0 = args.in[I_W0]; const float* wup = args.in[I_WUP]; const float* a0 = args.in[I_A0]; const float* aup = args.in[I_AUP]; const float* k_k = args.in[I_KK]; const float* k_a = args.in[I_KA]; const float* r_k = args.in[I_RK]; const float* gnw = args.in[I_GNW]; const float* gnb = args.in[I_GNB]; const float* sink = args.in[I_SINK]; const float* wbrr = args.in[I_WBRR]; const float* wbra = args.in[I_WBRA]; const float* wout = args.in[I_WOUT]; float* out = args.out; float* ADA = (float*)(ws + WS_ADA); float* BSUM = (float*)(ws + WS_BSUM); float* BP4 = (float*)(ws + WS_BP4); (void)BSUM; bf16* WinT = (bf16*)(ws + WS_WINT); bf16* WbrrT = (bf16*)(ws + WS_WBRR); bf16* WbraT = (bf16*)(ws + WS_WBRA); bf16* WoutT = (bf16*)(ws + WS_WOUT); bf16* WloraT = (bf16*)(ws + WS_WLORA); bf16* Hb = (bf16*)(ws + WS_H); bf16* MG = (bf16*)(ws + WS_MG); bf16* PA = (bf16*)(ws + WS_PA); bf16* PR = (bf16*)(ws + WS_PR); bf16* RAW = (bf16*)(ws + WS_PR); bf16* PGT = (bf16*)(ws + WS_PG); bf16* OUTB = (bf16*)(ws + WS_PR); bf16* KD1 = (bf16*)(ws + WS_KD1); bf16* LA = (bf16*)(ws + WS_LA); bf16* Rb = (bf16*)(ws + WS_R); bf16* Kb = (bf16*)(ws + WS_K); bf16* Vb = (bf16*)(ws + WS_V); bf16* Gb = (bf16*)(ws + WS_G); bf16* KKb = (bf16*)(ws + WS_KK); bf16* KB = (bf16*)(ws + WS_KB); bf16* VB = (bf16*)(ws + WS_VB); bf16* BR = (bf16*)(ws + WS_BR); bf16* BA = (bf16*)(ws + WS_BA);
__global__ void __launch_bounds__(NWAVES * 64, 2) mk_fwd(Args args) {
    extern __shared__ __attribute__((aligned(16))) unsigned char lds_raw[];
    LAS unsigned char* lds = (LAS unsigned char*)lds_raw;
    volatile LAS unsigned* MISC = (volatile LAS unsigned*)(lds + MISC_OFF);
    const int tid = threadIdx.x, lane = tid & 63, wave = __builtin_amdgcn_readfirstlane(tid >> 6);
    unsigned char* ws = args.ws;
    gu32* ctl = (gu32*)(ws + WS_CTL);
    for (int u = tid; u < (LDS_BYTES - LDSCTL_OFF) / 4; u += NWAVES * 64) ((LAS unsigned*)(lds + LDSCTL_OFF))[u] = 0u;
    __syncthreads();
    XcdBarrier bar; bar.bar = (unsigned*)(ctl + CW_BAR); bar.x = 0; bar.st = nullptr;
    const bool use_bar = (args.ph_hi - args.ph_lo) > 1;
    if (use_bar) bar = xcd_barrier_post((unsigned*)(ctl + CW_BAR) + args.li * XCD_BAR_WORDS, MISC + 8);
#define GRID_BAR() do { if (use_bar) xcd_barrier(bar); } while (0)
#define IN(k) (args.ph_lo <= (k) && (k) < args.ph_hi)
#define BOTH(k) (IN(k) && IN((k) + 1))
    if (IN(0)) { PTRS
        LAS float* scr = (LAS float*)(lds + wave * 16384);
        constexpr int I_IN = 16 * 176, I_BRR = 8 * 32, I_OUT = 16 * 32, I_LORA = 64, NT = I_IN + 2 * I_BRR + I_OUT + I_LORA;
        for (int it = gw; it < NT; it += NGW) {
            int r = it;
            if (r < I_IN) { transpose_item(win, 1024, 5632, WinT, 1024, 0, 0, scr, r, lane); continue; } r -= I_IN;
            if (r < I_BRR) { transpose_item(wbrr, 512, 1024, WbrrT, 512, 0, 0, scr, r, lane); continue; } r -= I_BRR;
            if (r < I_BRR) { transpose_item(wbra, 512, 1024, WbraT, 512, 0, 0, scr, r, lane); continue; } r -= I_BRR;
            if (r < I_OUT) { transpose_item(wout, 1024, 1024, WoutT, 1024, 0, 0, scr, r, lane); continue; } r -= I_OUT;
            { const int mat = r >> 4, nb = r & 15; const float* W = (mat < 2 ? wup : aup) + (size_t)(mat & 1) * 64 * 512;
              transpose_item(W, 64, 512, WloraT, 256, mat * 512, mat * 64, scr, nb, lane);
#pragma unroll
              for (int i = 0; i < 12; ++i) { const int q = lane + 64 * i, row = q / 24, cc = q % 24, chunk = cc < mat * 8 ? cc : cc + 8;
                  *(GAS v4u*)(WloraT + (size_t)(mat * 512 + nb * 32 + row) * 256 + chunk * 8) = (v4u){0u, 0u, 0u, 0u}; } }
        }
        for (int it = gw; it < 1536; it += NGW) {
            const int nblk = it % 48, r_ = it / 48, bg = r_ & 7, kq = r_ >> 3, n = nblk * 64 + lane, b0 = bg * 4, kbase = kq * 256;
#pragma unroll
            for (int bb = 0; bb < 4; ++bb)
#pragma unroll
                for (int kk = 0; kk < 4; ++kk) { const int k = lane + 64 * kk; const float cv = cin[(b0 + bb) * 1024 + kbase + k]; scr[k * 4 + bb] = cv * sigmoidf_(cv); }
            LDS_WAIT(); asm volatile("" ::: "memory");
            float acc[4] = {0.f, 0.f, 0.f, 0.f};
#pragma unroll 32
            for (int k = 0; k < 256; ++k) { const float wv = wada[(size_t)(kbase + k) * 3072 + n]; const f32x4 s = *(const LAS f32x4*)(scr + k * 4);
                acc[0] += s[0] * wv; acc[1] += s[1] * wv; acc[2] += s[2] * wv; acc[3] += s[3] * wv; }
            const float bn = kq == 0 ? bada[n] : 0.f;
#pragma unroll
            for (int bb = 0; bb < 4; ++bb) atomicAdd(ADA + (b0 + bb) * 3072 + n, acc[bb] + bn);
            LDS_WAIT(); asm volatile("" ::: "memory");
        }
        if (BOTH(0)) GRID_BAR();
    }
    if (IN(1)) { PTRS
        {
            f32x4 v[4], vn[4];
#define P1_LOAD(mm, V) do { const GAS f32x4* xr_ = (const GAS f32x4*)(x + (size_t)(mm) * DM) + lane; _Pragma("unroll") for (int j = 0; j < 4; ++j) V[j] = xr_[64 * j]; } while (0)
            if (gw < M) P1_LOAD(gw, vn);
            for (int m = gw; m < M; m += NGW) {
                const int b = m >> 11;
#pragma unroll
                for (int j = 0; j < 4; ++j) v[j] = vn[j];
                if (m + NGW < M) P1_LOAD(m + NGW, vn);
                float s = 0.f;
#pragma unroll
                for (int j = 0; j < 4; ++j) s += (v[j].x * v[j].x + v[j].y * v[j].y) + (v[j].z * v[j].z + v[j].w * v[j].w);
                const float rinv = 1.0f / sqrtf(wave_sum(s) * (1.f / DM) + 1e-6f);
                GAS unsigned long long* o8 = (GAS unsigned long long*)(Hb + (size_t)m * DM) + lane;
#pragma unroll
                for (int j = 0; j < 4; ++j) { const int c = 4 * (lane + 64 * j);
                    const f32x4 gp = *(const f32x4*)(gpre + c), sh = *(const f32x4*)(ADA + b * 3072 + c), sc = *(const f32x4*)(ADA + b * 3072 + 1024 + c);
                    const f32x4 hh = v[j] * rinv * gp * (sc + 1.0f) + sh;
                    o8[64 * j] = (unsigned long long)cvtpk_c(hh.x, hh.y) | ((unsigned long long)cvtpk_c(hh.z, hh.w) << 32); }
            }
#undef P1_LOAD
        }
        if (BOTH(1)) GRID_BAR();
    }
    if (IN(2)) { PTRS
        pg8::Gemm g{Hb, WinT, M, 3584, 1024, 1024}; pg8::StaticOrder S; S.init(M, 3584, G, bx);
        pg8::EpiRoute E{PR, PA, RCOLS, ACOLS, 9};
        pg8::gemm_phase<pg8::EpiRoute, pg8::StaticOrder, true, true>(lds, g, S, E);
        if (BOTH(2)) GRID_BAR();
    }
    if (IN(3)) { PTRS
        {
            v4u cu[5], pv[5], nx[5];
            v4u cu2[5], pv2[5], nx2[5];
            const v4u zero4 = (v4u){0u, 0u, 0u, 0u};
            float mm0[5][8], mm1[5][8];
#pragma unroll
            for (int i = 0; i < 5; ++i) { const int c = (i == 4 && lane >= 32) ? 0 : 8 * (lane + 64 * i);
                const f32x4 m0a = *(const f32x4*)(mu + c), m0b = *(const f32x4*)(mu + c + 4), m1a = *(const f32x4*)(mu + RCOLS + c), m1b = *(const f32x4*)(mu + RCOLS + c + 4);
                mm0[i][0] = m0a.x; mm0[i][1] = m0a.y; mm0[i][2] = m0a.z; mm0[i][3] = m0a.w; mm0[i][4] = m0b.x; mm0[i][5] = m0b.y; mm0[i][6] = m0b.z; mm0[i][7] = m0b.w;
                mm1[i][0] = m1a.x; mm1[i][1] = m1a.y; mm1[i][2] = m1a.z; mm1[i][3] = m1a.w; mm1[i][4] = m1b.x; mm1[i][5] = m1b.y; mm1[i][6] = m1b.z; mm1[i][7] = m1b.w; }
#define P3_LOAD(mm, C, P, N) do { const int t_ = (mm) & 2047; const bf16* pc_ = PR + (size_t)(mm) * RCOLS; _Pragma("unroll") for (int i = 0; i < 5; ++i) { if (i == 4 && lane >= 32) break; const int c_ = 8 * (lane + 64 * i); \
                C[i] = *(const v4u*)(pc_ + c_); P[i] = t_ > 0 ? *(const v4u*)(pc_ - RCOLS + c_) : zero4; N[i] = t_ < 2047 ? *(const v4u*)(pc_ + RCOLS + c_) : zero4; } } while (0)
            if (gw < M) P3_LOAD(gw, cu2, pv2, nx2);
            for (int m = gw; m < M; m += NGW) {
#pragma unroll
                for (int i = 0; i < 5; ++i) { cu[i] = cu2[i]; pv[i] = pv2[i]; nx[i] = nx2[i]; }
                if (m + NGW < M) P3_LOAD(m + NGW, cu2, pv2, nx2);
#pragma unroll
                for (int i = 0; i < 5; ++i) {
                    if (i == 4 && lane >= 32) break;
                    const int c = 8 * (lane + 64 * i);
                    float p[8], pp[8], pn[8], o[8];
                    unpack8(cu[i], p); unpack8(pv[i], pp); unpack8(nx[i], pn);
#pragma unroll
                    for (int e = 0; e < 8; ++e) o[e] = p[e] + mm0[i][e] * (pp[e] - p[e]) + mm1[i][e] * (pn[e] - p[e]);
                    if (i == 0) { *(v4u*)(Rb + (size_t)m * RW + c) = pack8(o); }
                    else if (i == 1) { const int cc = c - 512;
                        *(v4u*)(Kb + (size_t)m * RW + cc) = pack8(o);
                        const f32x4 ka_ = *(const f32x4*)(k_k + cc), kb_ = *(const f32x4*)(k_k + cc + 4);
                        const float kkw[8] = {ka_.x, ka_.y, ka_.z, ka_.w, kb_.x, kb_.y, kb_.z, kb_.w};
                        float kr[8]; float ss = 0.f;
#pragma unroll
                        for (int e = 0; e < 8; ++e) { kr[e] = o[e] * kkw[e]; ss += kr[e] * kr[e]; }
                        ss += __shfl_xor(ss, 1); ss += __shfl_xor(ss, 2); ss += __shfl_xor(ss, 4);
                        const float inv = 1.0f / fmaxf(sqrtf(ss), 1e-12f);
#pragma unroll
                        for (int e = 0; e < 8; ++e) kr[e] *= inv;
                        *(v4u*)(KKb + (size_t)m * RW + cc) = pack8(kr); }
                    else if (i == 2) { *(v4u*)(Vb + (size_t)m * RW + (c - 1024)) = pack8(o); }
                    else if (i == 3) { *(v4u*)(Gb + (size_t)m * RW + (c - 1536)) = pack8(o); }
                    else { if (lane < 16) {
#pragma unroll
                            for (int e = 0; e < 8; ++e) o[e] = 1.0f - 2.0f * __builtin_amdgcn_rcpf(1.0f + __expf(2.0f * o[e])); }
                        *(v4u*)(LA + (size_t)m * 256 + (c - 2048)) = pack8(o); }
                }
            }
#undef P3_LOAD
        }
        {
            LAS unsigned char* scr8 = lds + wave * 16384;
            for (int u = gw; u < 2048; u += NGW) {
                const int b = u >> 6, kvh = (u >> 5) & 1, tb = u & 31;
                const bf16* srck = PA + ((size_t)b * SEQ + tb * 64 + lane) * ACOLS + 512 + kvh * 64;
                const size_t tile0 = ((size_t)(b * 2 + kvh) * 64 + 2 * tb);
#pragma unroll
                for (int j8 = 0; j8 < 8; ++j8) *(LAS v4u*)(scr8 + lane * 144 + 16 * j8) = *(const v4u*)(srck + 8 * j8);
                LDS_WAIT(); asm volatile("" ::: "memory");
#pragma unroll
                for (int tt = 0; tt < 2; ++tt)
#pragma unroll
                    for (int ks = 0; ks < 4; ++ks) *(v4u*)(KB + (((tile0 + tt) * 4 + ks) * 64 + lane) * 8) = *(const LAS v4u*)(scr8 + (32 * tt + (lane & 31)) * 144 + (16 * ks + 8 * (lane >> 5)) * 2);
                LDS_WAIT(); asm volatile("" ::: "memory");
                LAS unsigned short* tile = (LAS unsigned short*)scr8;
                const bf16* srcv = srck + 128;
#pragma unroll
                for (int j8 = 0; j8 < 8; ++j8) { const v4u qv = *(const v4u*)(srcv + 8 * j8); LAS unsigned* dst = (LAS unsigned*)(tile + lane * 66 + 8 * j8);
                    dst[0] = qv.x; dst[1] = qv.y; dst[2] = qv.z; dst[3] = qv.w; }
                LDS_WAIT(); asm volatile("" ::: "memory");
#pragma unroll
                for (int tt = 0; tt < 2; ++tt)
#pragma unroll
                    for (int mb = 0; mb < 2; ++mb)
#pragma unroll
                        for (int k2 = 0; k2 < 2; ++k2) { unsigned w[4];
#pragma unroll
                            for (int e = 0; e < 4; ++e) { const int j0 = 2 * e, key0 = 32 * tt + 16 * k2 + 8 * (j0 >> 2) + 4 * (lane >> 5) + (j0 & 3);
                                const unsigned lo16 = tile[key0 * 66 + 32 * mb + (lane & 31)], hi16 = tile[(key0 + 1) * 66 + 32 * mb + (lane & 31)]; w[e] = lo16 | (hi16 << 16); }
                            *(v4u*)(VB + ((((tile0 + tt) * 2 + mb) * 2 + k2) * 64 + lane) * 8) = (v4u){w[0], w[1], w[2], w[3]}; }
                LDS_WAIT(); asm volatile("" ::: "memory");
            }
        }
        if (BOTH(3)) GRID_BAR();
    }
    if (IN(4)) { PTRS
        pg8::Gemm g{LA, WloraT, M, 2048, 256, 256}; pg8::StaticOrder S; S.init(M, 2048, G, bx);
        pg8::EpiLora E{RAW, w0, a0};
        pg8::gemm_phase<pg8::EpiLora, pg8::StaticOrder, true, true>(lds, g, S, E);
        if (BOTH(4)) GRID_BAR();
    }
    if (IN(6)) { PTRS
        typedef float f32x16 __attribute__((ext_vector_type(16)));
#define MF(a, b, c) __builtin_amdgcn_mfma_f32_32x32x16_bf16(a, b, c, 0, 0, 0)
#define ACCF(x, s) __builtin_bit_cast(bf16x8, (v4u){cvtpk_c((x)[8 * (s) + 0], (x)[8 * (s) + 1]), cvtpk_c((x)[8 * (s) + 2], (x)[8 * (s) + 3]), cvtpk_c((x)[8 * (s) + 4], (x)[8 * (s) + 5]), cvtpk_c((x)[8 * (s) + 6], (x)[8 * (s) + 7])})
#define LDN(img, pitch, rowb, k0) (*(const LAS bf16x8*)((img) + ((rowb) + q) * (pitch) + ((k0) + 8 * hh) * 2))
#define LDP(img, pitch, rowb, k0) ldsfrag_perm((img) + ((rowb) + q) * (pitch) + ((k0) + 4 * hh) * 2)
#define ZERO16(x) do { _Pragma("unroll") for (int r_ = 0; r_ < 16; ++r_) (x)[r_] = 0.f; } while (0)
#define MMAA(X, Y, Cacc) do { const bf16x8 xa_ = ACCF(X, 0), xb_ = ACCF(X, 1), ya_ = ACCF(Y, 0), yb_ = ACCF(Y, 1); Cacc = MF(xa_, ya_, Cacc); Cacc = MF(xb_, yb_, Cacc); } while (0)
#define PROGW(k) ((volatile LAS unsigned*)(lds + LDSCTL_OFF + 1024 + (k) * 64))
#define SPIN_UNTIL(cond) do { while (!(cond)) __builtin_amdgcn_s_sleep(1); asm volatile("" ::: "memory"); } while (0)
        constexpr int NCH = SEQ / 32;
        const int q = lane & 31, hh = lane >> 5;
        const bool run_scan = !(args.pad & 1);
        if (wave < 4 && run_scan) {
            const int sl = wave >> 1, ib = wave & 1;
            const int s = 2 * vcu + sl; const int d = s & 1, bh = s >> 1, b = bh >> 3, h = bh & 7;
            LAS unsigned char* sbase = lds + sl * 57856;
            LAS unsigned char* VT0 = lds + 115712 + wave * 5120;
            const LAS unsigned char* FR = lds + 136192 + sl * 8192;
            volatile LAS unsigned* progE = PROGW(wave); volatile LAS unsigned* ptE = PROGW(wave ^ 1); volatile LAS unsigned* progM = PROGW(4 + wave); volatile LAS unsigned* ptM = PROGW(4 + (wave ^ 1));
            volatile LAS unsigned* progF = PROGW(8 + wave); volatile LAS unsigned* progH = PROGW(12 + sl);
            const int cp = lane & 15, tq = lane >> 4;
            bf16* pY = RAW + d * 512 + h * 64 + ib * 32 + q;
            const unsigned tsel = d ? (unsigned)(3 - tq) : (unsigned)tq;
            const unsigned offS = tsel * 8u * 4096u + 64u * ib + 4u * cp, offT = tsel * 8u * 1024u + 64u * ib + 4u * cp;
            const unsigned oS = (unsigned)((d * 512 + h * 64) * 2), oT = (unsigned)(h * 128);
            unsigned pf[5][8];
#define PF_TOK(cc, tl) ((unsigned)(b * SEQ + (d ? (SEQ - 1 - 32 * (cc) - (tl) - 24) : (32 * (cc) + (tl)))))
#define PF_ISSUE(cc, T0, T1) do { unsigned vS_ = offS, vT_ = offT; asm volatile("" : "+v"(vS_), "+v"(vT_));        \
            _Pragma("unroll") for (int tl = (T0); tl < (T1); ++tl) { const unsigned m0 = PF_TOK(cc, tl); \
                pf[0][tl] = *(const unsigned*)((ws + ((unsigned)WS_PR + oS + m0 * 4096u)) + vS_); pf[1][tl] = *(const unsigned*)((ws + ((unsigned)WS_PR + 2048u + oS + m0 * 4096u)) + vS_); pf[2][tl] = *(const unsigned*)((ws + ((unsigned)WS_KK + oT + m0 * 1024u)) + vT_); \
                pf[3][tl] = *(const unsigned*)((ws + ((unsigned)WS_K + oT + m0 * 1024u)) + vT_); pf[4][tl] = *(const unsigned*)((ws + ((unsigned)WS_R + oT + m0 * 1024u)) + vT_); } } while (0)
            PF_ISSUE(0, 0, 8);
            f32x16 H0a, H0b; ZERO16(H0a); ZERO16(H0b);
            for (int it = 0; it <= NCH; ++it) {
                if (it < NCH) {
                    LAS unsigned char* KQ = sbase + (it & 1) * 28928, *RQ = KQ + 4608, *KKI = KQ + 9216, *BKI = KQ + 13824, *KCT = KQ + 18432, *BCT = KQ + 23552; LAS float* GC = (LAS float*)(KQ + 28672);
                    LAS unsigned char* VTI = VT0 + (it & 1) * 2560;
                    if (it >= 2) SPIN_UNTIL(*progH + 1u >= (unsigned)it && *ptM + 1u >= (unsigned)it);
                    {
                    const float ka0 = k_a[h * 64 + 32 * ib + 2 * cp], ka1 = k_a[h * 64 + 32 * ib + 2 * cp + 1];
                    const float rk0 = r_k[h * 64 + 32 * ib + 2 * cp], rk1 = r_k[h * 64 + 32 * ib + 2 * cp + 1];
                    unsigned vq[8];
                    { unsigned vT_ = offT; asm volatile("" : "+v"(vT_));
#pragma unroll
                    for (int tl = 0; tl < 8; ++tl) { const unsigned m0 = PF_TOK(it, tl); vq[tl] = *(const unsigned*)((ws + ((unsigned)WS_V + oT + m0 * 1024u)) + vT_); } }
                    float t0 = 0.f, t1 = 0.f;
#pragma unroll
                    for (int tl = 0; tl < 8; ++tl) { t0 += bflo(pf[0][tl]); t1 += bfhi(pf[0][tl]); }
                    t0 *= -0.6065306597f; t1 *= -0.6065306597f;
                    float o0, o1, tot0, tot1;
                    {   const auto a0_ = __builtin_amdgcn_permlane16_swap(__float_as_uint(t0), __float_as_uint(t0), false, false), a1_ = __builtin_amdgcn_permlane16_swap(__float_as_uint(t1), __float_as_uint(t1), false, false);
                        const float n0 = (tq & 1) ? __uint_as_float(a0_[0]) : __uint_as_float(a0_[1]), n1 = (tq & 1) ? __uint_as_float(a1_[0]) : __uint_as_float(a1_[1]);
                        const float p0 = t0 + n0, p1 = t1 + n1;
                        const auto b0_ = __builtin_amdgcn_permlane32_swap(__float_as_uint(p0), __float_as_uint(p0), false, false), b1_ = __builtin_amdgcn_permlane32_swap(__float_as_uint(p1), __float_as_uint(p1), false, false);
                        const float q0 = (tq & 2) ? __uint_as_float(b0_[0]) : __uint_as_float(b0_[1]), q1 = (tq & 2) ? __uint_as_float(b1_[0]) : __uint_as_float(b1_[1]);
                        o0 = ((tq & 1) ? n0 : 0.f) + ((tq & 2) ? q0 : 0.f); o1 = ((tq & 1) ? n1 : 0.f) + ((tq & 2) ? q1 : 0.f); tot0 = p0 + q0; tot1 = p1 + q1; }
                    const float gC0 = __expf(tot0), gC1 = __expf(tot1);
                    float L0 = o0, L1 = o1; float eLp0 = __expf(L0), eLp1 = __expf(L1);
                    if (tq == 0) { GC[32 * ib + 2 * cp] = gC0; GC[32 * ib + 2 * cp + 1] = gC1; }
                    float bpk = 0.f;
#pragma unroll
                    for (int t2 = 0; t2 < 4; ++t2) {
                        float kc0[2], kc1[2], bc0[2], bc1[2];
#pragma unroll
                        for (int e = 0; e < 2; ++e) { const int tl = 2 * t2 + e, tau = 8 * tq + tl;
                            const float sg0 = bflo(pf[0][tl]), sg1 = bfhi(pf[0][tl]), a0_ = bflo(pf[1][tl]), a1_ = bfhi(pf[1][tl]), kk0 = bflo(pf[2][tl]), kk1 = bfhi(pf[2][tl]);
                            const float k0_ = bflo(pf[3][tl]), k1_ = bfhi(pf[3][tl]), r0_ = bflo(pf[4][tl]), r1_ = bfhi(pf[4][tl]);
                            L0 += -0.6065306597f * sg0; L1 += -0.6065306597f * sg1;
                            const float eL0 = __expf(L0), eL1 = __expf(L1), en0 = __builtin_amdgcn_rcpf(eL0), en1 = __builtin_amdgcn_rcpf(eL1);
                            const float kd0 = k0_ * (1.0f + (a0_ - 1.0f) * ka0), kd1 = k1_ * (1.0f + (a1_ - 1.0f) * ka1);
                            const float kkf0 = kd0 * en0, kkf1 = kd1 * en1, bkf0 = kk0 * a0_ * en0, bkf1 = kk1 * a1_ * en1;
                            {
                                float bp = r0_ * kd0 * rk0 + r1_ * kd1 * rk1;
                                bp += __shfl_xor(bp, 1); bp += __shfl_xor(bp, 2); bp += __shfl_xor(bp, 4); bp += __shfl_xor(bp, 8);
                                bpk = (cp == tl) ? bp : bpk; }
                            ((LAS unsigned*)KQ)[tau * 36 + 16 * ib + cp] = pg8::cvt_pk_bf16(kk0 * eLp0, kk1 * eLp1); ((LAS unsigned*)RQ)[tau * 36 + 16 * ib + cp] = pg8::cvt_pk_bf16(r0_ * eL0, r1_ * eL1);
                            ((LAS unsigned*)KKI)[tau * 36 + 16 * ib + cp] = pg8::cvt_pk_bf16(kkf0, kkf1); ((LAS unsigned*)BKI)[tau * 36 + 16 * ib + cp] = pg8::cvt_pk_bf16(bkf0, bkf1);
                            kc0[e] = kkf0 * gC0; kc1[e] = kkf1 * gC1; bc0[e] = -bkf0 * gC0; bc1[e] = -bkf1 * gC1;
                            eLp0 = eL0; eLp1 = eL1; }
                        const int sp = 4 * tq + t2;
                        const int j0 = 32 * ib + 2 * cp;
                        ((LAS unsigned*)KCT)[j0 * 20 + sp] = pg8::cvt_pk_bf16(kc0[0], kc0[1]); ((LAS unsigned*)KCT)[(j0 + 1) * 20 + sp] = pg8::cvt_pk_bf16(kc1[0], kc1[1]);
                        ((LAS unsigned*)BCT)[j0 * 20 + sp] = pg8::cvt_pk_bf16(bc0[0], bc0[1]); ((LAS unsigned*)BCT)[(j0 + 1) * 20 + sp] = pg8::cvt_pk_bf16(bc1[0], bc1[1]);
                    }
                    if (cp < 8) { const int tt_ = 32 * it + 8 * tq + cp; const size_t mt_ = (size_t)b * SEQ + (d ? (SEQ - 1 - tt_) : tt_); BP4[((size_t)(d * 2 + ib) * M + mt_) * 8 + h] = bpk; }
#pragma unroll
                    for (int t2 = 0; t2 < 4; ++t2) { const int sp = 4 * tq + t2; const unsigned va = vq[2 * t2], vb = vq[2 * t2 + 1];
                        ((LAS unsigned*)VTI)[(2 * cp) * 20 + sp] = (va & 0xffffu) | (vb << 16); ((LAS unsigned*)VTI)[(2 * cp + 1) * 20 + sp] = (va >> 16) | (vb & 0xffff0000u); }
                }
                    asm volatile("s_waitcnt lgkmcnt(0)" ::: "memory");
                    *progE = (unsigned)(it + 1);
                    if (it == 0) PF_ISSUE(1, 0, 8);
                }
                if (it >= 1) {
                    const int c = it - 1;
                    const LAS unsigned char* KQ = sbase + (c & 1) * 28928, *RQ = KQ + 4608, *KCT = KQ + 18432, *BCT = KQ + 23552; const LAS float* GC = (const LAS float*)(KQ + 28672);
                    const LAS unsigned char* VTI = VT0 + (c & 1) * 2560;
                    SPIN_UNTIL(*ptE >= (unsigned)(c + 1));
                    f32x16 Zacc, Yacc, U; ZERO16(Zacc); ZERO16(Yacc); ZERO16(U);
                    const bf16x8 h0f0 = ACCF(H0a, 0), h0f1 = ACCF(H0a, 1), h0f2 = ACCF(H0b, 0), h0f3 = ACCF(H0b, 1);
                    Zacc = MF(LDP(KQ, 144, 0, 0), h0f0, Zacc); Zacc = MF(LDP(KQ, 144, 0, 16), h0f1, Zacc); Zacc = MF(LDP(KQ, 144, 0, 32), h0f2, Zacc); Zacc = MF(LDP(KQ, 144, 0, 48), h0f3, Zacc);
                    Yacc = MF(LDP(RQ, 144, 0, 0), h0f0, Yacc); Yacc = MF(LDP(RQ, 144, 0, 16), h0f1, Yacc); Yacc = MF(LDP(RQ, 144, 0, 32), h0f2, Yacc); Yacc = MF(LDP(RQ, 144, 0, 48), h0f3, Yacc);
#pragma unroll
                    for (int r_ = 0; r_ < 16; ++r_) { const int row_ = (r_ & 3) + 8 * (r_ >> 2) + 4 * hh; H0a[r_] *= GC[row_]; H0b[r_] *= GC[32 + row_]; }
                    H0a = MF(LDN(KCT, 80, 0, 0), LDN(VTI, 80, 0, 0), H0a); H0a = MF(LDN(KCT, 80, 0, 16), LDN(VTI, 80, 0, 16), H0a);
                    H0b = MF(LDN(KCT, 80, 32, 0), LDN(VTI, 80, 0, 0), H0b); H0b = MF(LDN(KCT, 80, 32, 16), LDN(VTI, 80, 0, 16), H0b);
                    SPIN_UNTIL(*progH >= (unsigned)(c + 1));
                    bf16x8 fr[8];
#pragma unroll
                    for (int f = 0; f < 8; ++f) fr[f] = *(const LAS bf16x8*)(FR + f * 1024 + lane * 16);
                    asm volatile("s_waitcnt lgkmcnt(0)" ::: "memory");
                    *progF = (unsigned)(c + 1);
                    Zacc = MF(fr[2], LDP(VTI, 80, 0, 0), Zacc); Zacc = MF(fr[3], LDP(VTI, 80, 0, 16), Zacc);
                    Yacc = MF(fr[4], LDP(VTI, 80, 0, 0), Yacc); Yacc = MF(fr[5], LDP(VTI, 80, 0, 16), Yacc);
                    U = MF(fr[0], ACCF(Zacc, 0), U); U = MF(fr[1], ACCF(Zacc, 1), U);
                    if (it + 1 < NCH) PF_ISSUE(it + 1, 0, 4);
                    { const bf16x8 u0 = ACCF(U, 0), u1 = ACCF(U, 1);
                      Yacc = MF(fr[6], u0, Yacc); Yacc = MF(fr[7], u1, Yacc);
#pragma unroll
                      for (int r_ = 0; r_ < 16; ++r_) { const int tt = 32 * c + (r_ & 3) + 8 * (r_ >> 2) + 4 * hh; const size_t m = (size_t)b * SEQ + (d ? (SEQ - 1 - tt) : tt);
                          pY[m * 2048] = (bf16)(cvtpk_c(Yacc[r_], 0.f) & 0xffffu); }
                      if (it + 1 < NCH) PF_ISSUE(it + 1, 4, 8);
                      H0a = MF(LDP(BCT, 80, 0, 0), u0, H0a); H0a = MF(LDP(BCT, 80, 0, 16), u1, H0a);
                      H0b = MF(LDP(BCT, 80, 32, 0), u0, H0b); H0b = MF(LDP(BCT, 80, 32, 16), u1, H0b); }
                    asm volatile("s_waitcnt lgkmcnt(0)" ::: "memory");
                    *progM = (unsigned)(c + 1);
                }
            }
#undef PF_ISSUE
#undef PF_TOK
        } else if (wave < 6 && run_scan) {
            const int sl = wave - 4;
            const LAS unsigned char* sbase = lds + sl * 57856;
            LAS unsigned char* FR = lds + 136192 + sl * 8192;
            volatile LAS unsigned* pE0 = PROGW(2 * sl), *pE1 = PROGW(2 * sl + 1), *pF0 = PROGW(8 + 2 * sl), *pF1 = PROGW(8 + 2 * sl + 1); volatile LAS unsigned* progH = PROGW(12 + sl);
            for (int c = 0; c < NCH; ++c) {
                const LAS unsigned char* KQ = sbase + (c & 1) * 28928, *RQ = KQ + 4608, *KKI = KQ + 9216, *BKI = KQ + 13824;
                SPIN_UNTIL(*pE0 >= (unsigned)(c + 1) && *pE1 >= (unsigned)(c + 1));
                f32x16 Rm, P, Pt, Rt, Aa, Ar, Ab;
                ZERO16(P); ZERO16(Pt); ZERO16(Aa); ZERO16(Ar); ZERO16(Ab);
#pragma unroll
                for (int ks = 0; ks < 4; ++ks) { const bf16x8 fb = LDN(BKI, 144, 0, 16 * ks), fq = LDN(KQ, 144, 0, 16 * ks), fk = LDN(KKI, 144, 0, 16 * ks), frq = LDN(RQ, 144, 0, 16 * ks);
                    P = MF(fb, fq, P); Pt = MF(fq, fb, Pt); Aa = MF(fk, fq, Aa); Ar = MF(fk, frq, Ar); Ab = MF(fb, frq, Ab); }
#pragma unroll
                for (int r_ = 0; r_ < 16; ++r_) { const int row_ = (r_ & 3) + 8 * (r_ >> 2) + 4 * hh; P[r_] = row_ < q ? -P[r_] : 0.f; Pt[r_] = row_ > q ? -Pt[r_] : 0.f; Rm[r_] = P[r_] + (row_ == q ? 1.0f : 0.f); Rt[r_] = Pt[r_] + (row_ == q ? 1.0f : 0.f);
                    Aa[r_] = row_ < q ? Aa[r_] : 0.f; Ar[r_] = row_ <= q ? Ar[r_] : 0.f; Ab[r_] = row_ <= q ? -Ab[r_] : 0.f; }
                const bf16x8 fa0 = ACCF(Aa, 0), fa1 = ACCF(Aa, 1), fr0 = ACCF(Ar, 0), fr1 = ACCF(Ar, 1), fb0 = ACCF(Ab, 0), fb1 = ACCF(Ab, 1);
#pragma unroll
                for (int k = 0; k < 4; ++k) {
                    f32x16 P2; ZERO16(P2); MMAA(Pt, P, P2);
                    MMAA(Rt, P2, Rm);
                    if (k < 3) { f32x16 P2t; ZERO16(P2t); MMAA(P, Pt, P2t); MMAA(P2, Rt, Rt); Pt = P2t; }
                    P = P2;
                }
                const bf16x8 ft0 = ACCF(Rm, 0), ft1 = ACCF(Rm, 1);
                asm volatile("s_waitcnt lgkmcnt(0)" ::: "memory");
                if (c >= 1) SPIN_UNTIL(*pF0 >= (unsigned)c && *pF1 >= (unsigned)c);
                *(LAS bf16x8*)(FR + 0 * 1024 + lane * 16) = ft0; *(LAS bf16x8*)(FR + 1 * 1024 + lane * 16) = ft1; *(LAS bf16x8*)(FR + 2 * 1024 + lane * 16) = fa0; *(LAS bf16x8*)(FR + 3 * 1024 + lane * 16) = fa1;
                *(LAS bf16x8*)(FR + 4 * 1024 + lane * 16) = fr0; *(LAS bf16x8*)(FR + 5 * 1024 + lane * 16) = fr1; *(LAS bf16x8*)(FR + 6 * 1024 + lane * 16) = fb0; *(LAS bf16x8*)(FR + 7 * 1024 + lane * 16) = fb1;
                asm volatile("s_waitcnt lgkmcnt(0)" ::: "memory");
                *progH = (unsigned)(c + 1);
            }
        }
        if (!(args.pad & 2)) {
            const int b = vcu >> 3, kvh = (vcu >> 2) & 1, qseg = vcu & 3;
            const bf16* kb0 = KB + ((size_t)(b * 2 + kvh) * 64) * 4 * 64 * 8 + lane * 8;
            const bf16* vb0 = VB + ((size_t)(b * 2 + kvh) * 64) * 4 * 64 * 8 + lane * 8;
            LAS unsigned* qctr = (LAS unsigned*)(lds + LDSCTL_OFF + 1024 + 14 * 64);
#define ATT_LOAD(kt_, KF, VF) do { _Pragma("unroll") for (int ks = 0; ks < 4; ++ks) KF[ks] = *(const bf16x8*)(kb0 + (size_t)((kt_) * 4 + ks) * 512); \
                _Pragma("unroll") for (int mb = 0; mb < 2; ++mb) _Pragma("unroll") for (int k2 = 0; k2 < 2; ++k2) VF[mb][k2] = *(const bf16x8*)(vb0 + (size_t)((kt_) * 4 + mb * 2 + k2) * 512); } while (0)
            for (;;) {
                unsigned e_ = 0; if (lane == 0) e_ = __hip_atomic_fetch_add(qctr, 1u, __ATOMIC_RELAXED, __HIP_MEMORY_SCOPE_WORKGROUP);
                const int e = __builtin_amdgcn_readfirstlane((int)e_);
                if (e >= 64) break;
                const int g = e & 3, qb = qseg * 16 + (e >> 2), hq = kvh * 4 + g;
                const int t = 32 * qb + q;
                const float slope = exp2f(-(float)(hq + 1));
                bf16* qrow = PA + ((size_t)b * SEQ + t) * ACOLS + hq * 64;
                bf16x8 qf[4];
#pragma unroll
                for (int ks = 0; ks < 4; ++ks) qf[ks] = *(const bf16x8*)(qrow + 16 * ks + 8 * hh);
                float mrun = sink[hq], lrun = 1.0f;
                f32x16 O0, O1; ZERO16(O0); ZERO16(O1);
                const int kt0 = qb - 4 < 0 ? 0 : qb - 4, kt1 = qb + 4 > 63 ? 63 : qb + 4;
                float nb[16];
#pragma unroll
                for (int r = 0; r < 16; ++r) nb[r] = slope * (float)(q - 4 * hh - ((r & 3) + 8 * (r >> 2)));
                bf16x8 kfA[4], vfA[2][2], kfB[4], vfB[2][2];
#define ATT_TILE(kt_, KF, VF) do { \
                    f32x16 acc; ZERO16(acc); \
                    _Pragma("unroll") for (int ks = 0; ks < 4; ++ks) acc = MF(KF[ks], qf[ks], acc); \
                      \
                    const int dlt = qb - (kt_); float sc[16]; float mx = -1e30f; \
                    if (dlt > 0) { _Pragma("unroll") for (int r = 0; r < 16; ++r) sc[r] = acc[r] * 0.125f - nb[r]; \
                        if (dlt == 4) { _Pragma("unroll") for (int r = 0; r < 16; ++r) sc[r] = nb[r] <= 0.f ? sc[r] : -1e30f; } } \
                    else if (dlt < 0) { _Pragma("unroll") for (int r = 0; r < 16; ++r) sc[r] = acc[r] * 0.125f + nb[r]; \
                        if (dlt == -4) { _Pragma("unroll") for (int r = 0; r < 16; ++r) sc[r] = nb[r] >= 0.f ? sc[r] : -1e30f; } } \
                    else { _Pragma("unroll") for (int r = 0; r < 16; ++r) sc[r] = acc[r] * 0.125f - fabsf(nb[r]); } \
                    const float coff = slope * 32.0f * (float)(dlt < 0 ? -dlt : dlt); \
                    _Pragma("unroll") for (int r = 0; r < 16; ++r) mx = fmaxf(mx, sc[r]); \
                    { const auto rr_ = __builtin_amdgcn_permlane32_swap(__float_as_uint(mx), __float_as_uint(mx), false, false); mx = fmaxf(__uint_as_float(rr_[0]), __uint_as_float(rr_[1])) - coff; }     \
                    const float mn = fmaxf(mrun, mx), alpha = __expf(mrun - mn); mrun = mn; \
                    const float sh = mn + coff; float rs = 0.f; \
                    _Pragma("unroll") for (int r = 0; r < 16; ++r) { sc[r] = __expf(sc[r] - sh); rs += sc[r]; } \
                    lrun = lrun * alpha + rs;                                  \
                    bf16x8 pb[2]; \
                    _Pragma("unroll") for (int k2 = 0; k2 < 2; ++k2) pb[k2] = __builtin_bit_cast(bf16x8, (v4u){cvtpk_c(sc[8 * k2 + 0], sc[8 * k2 + 1]), cvtpk_c(sc[8 * k2 + 2], sc[8 * k2 + 3]), cvtpk_c(sc[8 * k2 + 4], sc[8 * k2 + 5]), cvtpk_c(sc[8 * k2 + 6], sc[8 * k2 + 7])}); \
                    if (__ballot(alpha != 1.0f) != 0ull) { _Pragma("unroll") for (int r = 0; r < 16; ++r) { O0[r] *= alpha; O1[r] *= alpha; } } \
                    _Pragma("unroll") for (int k2 = 0; k2 < 2; ++k2) { O0 = MF(VF[0][k2], pb[k2], O0); O1 = MF(VF[1][k2], pb[k2], O1); } } while (0)
                ATT_LOAD(kt0, kfA, vfA);
                for (int kt = kt0; kt <= kt1; kt += 2) {
                    if (kt + 1 <= kt1) ATT_LOAD(kt + 1, kfB, vfB);
                    ATT_TILE(kt, kfA, vfA);
                    if (kt + 1 <= kt1) {
                        if (kt + 2 <= kt1) ATT_LOAD(kt + 2, kfA, vfA);
                        ATT_TILE(kt + 1, kfB, vfB);
                    }
                }
#undef ATT_TILE
                { const auto rr_ = __builtin_amdgcn_permlane32_swap(__float_as_uint(lrun), __float_as_uint(lrun), false, false); lrun = __uint_as_float(rr_[0]) + __uint_as_float(rr_[1]) - __expf(sink[hq] - mrun); }
                const float inv = __builtin_amdgcn_rcpf(lrun);
                const bf16* grow = PA + ((size_t)b * SEQ + t) * ACOLS + 768 + hq * 64;
#pragma unroll
                for (int mb = 0; mb < 2; ++mb)
#pragma unroll
                    for (int r4 = 0; r4 < 4; ++r4) { const int dd = mb * 32 + 8 * r4 + 4 * hh;
                        const uint2 gq = *(const uint2*)(grow + dd);
                        const float g0 = bflo(gq.x), g1 = bfhi(gq.x), g2 = bflo(gq.y), g3 = bfhi(gq.y);
                        const float o0 = (mb ? O1[4 * r4 + 0] : O0[4 * r4 + 0]) * inv, o1 = (mb ? O1[4 * r4 + 1] : O0[4 * r4 + 1]) * inv, o2 = (mb ? O1[4 * r4 + 2] : O0[4 * r4 + 2]) * inv, o3 = (mb ? O1[4 * r4 + 3] : O0[4 * r4 + 3]) * inv;
                        *(uint2*)(qrow + dd) = make_uint2(cvtpk_c(o0 * g0 * pg8::sigm(g0), o1 * g1 * pg8::sigm(g1)), cvtpk_c(o2 * g2 * pg8::sigm(g2), o3 * g3 * pg8::sigm(g3))); }
            }
#undef ATT_LOAD
        }
#undef MF
#undef ACCF
#undef LDN
#undef LDP
#undef ZERO16
#undef MMAA
#undef PROGW
#undef SPIN_UNTIL
        if (BOTH(6)) GRID_BAR();
    }
    if (IN(7)) { PTRS
        {
            const int c0 = 8 * lane;
            v4u q8[4], q8n[4]; float bsn = 0.f;
#define P7_LOAD(mm, Q, B) do { const bf16* rr_ = RAW + (size_t)(mm) * 2048 + c0; Q[0] = *(const v4u*)(rr_); Q[1] = *(const v4u*)(rr_ + 512); \
                Q[2] = *(const v4u*)(Vb + (size_t)(mm) * RW + c0); Q[3] = *(const v4u*)(Gb + (size_t)(mm) * RW + c0); { const size_t bi_ = (size_t)(mm) * 8 + (lane >> 3); B = (BP4[bi_] + BP4[(size_t)M * 8 + bi_]) + (BP4[(size_t)2 * M * 8 + bi_] + BP4[(size_t)3 * M * 8 + bi_]); } } while (0)
            const f32x4 gwa = *(const f32x4*)(gnw + c0), gwb = *(const f32x4*)(gnw + c0 + 4), gba = *(const f32x4*)(gnb + c0), gbb = *(const f32x4*)(gnb + c0 + 4);
            const float gw8[8] = {gwa.x, gwa.y, gwa.z, gwa.w, gwb.x, gwb.y, gwb.z, gwb.w}, gb8[8] = {gba.x, gba.y, gba.z, gba.w, gbb.x, gbb.y, gbb.z, gbb.w};
            if (gw < M) P7_LOAD(gw, q8n, bsn);
            for (int m = gw; m < M; m += NGW) {
#pragma unroll
                for (int i = 0; i < 4; ++i) q8[i] = q8n[i];
                const float bs = bsn;
                if (m + NGW < M) P7_LOAD(m + NGW, q8n, bsn);
                float y0[8], y1[8], vf[8], gf[8], y[8];
                unpack8(q8[0], y0); unpack8(q8[1], y1); unpack8(q8[2], vf); unpack8(q8[3], gf);
                float s = 0.f;
#pragma unroll
                for (int e = 0; e < 8; ++e) { y[e] = y0[e] + y1[e]; s += y[e]; }
                s += __shfl_xor(s, 1); s += __shfl_xor(s, 2); s += __shfl_xor(s, 4);
                const float mean = s * (1.f / 64.f); float qq = 0.f;
#pragma unroll
                for (int e = 0; e < 8; ++e) { const float dd = y[e] - mean; qq += dd * dd; }
                qq += __shfl_xor(qq, 1); qq += __shfl_xor(qq, 2); qq += __shfl_xor(qq, 4);
                const float rstd = 1.0f / sqrtf(qq * (1.f / 64.f) + 64e-5f);
                float r[8];
#pragma unroll
                for (int e = 0; e < 8; ++e) { const float yn = (y[e] - mean) * rstd * gw8[e] + gb8[e]; r[e] = (yn + bs * vf[e]) * gf[e] * sigmoidf_(gf[e]); }
                *(v4u*)(Vb + (size_t)m * RW + c0) = pack8(r);
            }
#undef P7_LOAD
        }
        if (BOTH(7)) GRID_BAR();
    }
    if (IN(8)) { PTRS
        { pg8::Gemm g{Hb, WinT + (size_t)3584 * 1024, M, 2048, 1024, 1024}; pg8::StaticOrder S; S.init(M, 2048, G, bx);
          pg8::EpiRoute E{PGT, PGT, 2048, 2048, 1 << 20};
          pg8::gemm_phase<pg8::EpiRoute, pg8::StaticOrder, true, true>(lds, g, S, E); }
        if (BOTH(8)) GRID_BAR();
    }
    if (IN(9)) { PTRS
        { pg8::Gemm g{Vb, WbrrT, M, 1024, 512, 512}; pg8::StaticOrder S; S.init(M, 1024, G, bx);
          pg8::EpiGate<0> E{MG, PGT};
          pg8::gemm_phase<pg8::EpiGate<0>, pg8::StaticOrder, true, true>(lds, g, S, E); }
        { pg8::Gemm g{PA, WbraT, M, 1024, 512, ACOLS}; pg8::StaticOrder S; S.init(M, 1024, G, bx);
          pg8::EpiGate<1> E{MG, PGT};
          pg8::gemm_phase<pg8::EpiGate<1>, pg8::StaticOrder, true, true>(lds, g, S, E); }
        if (BOTH(9)) GRID_BAR();
    }
    if (IN(10)) { PTRS
        pg8::Gemm g{MG, WoutT, M, 1024, 1024, 1024}; pg8::StaticOrder S; S.init(M, 1024, G, bx);
        pg8::EpiRoute E{OUTB, OUTB, 1024, 1024, 1 << 20};
        pg8::gemm_phase<pg8::EpiRoute, pg8::StaticOrder, true, true>(lds, g, S, E);
        if (BOTH(10)) GRID_BAR();
    }
    if (IN(11)) { PTRS
        {
            v4u oq[2], oqn[2]; f32x4 xq[4], xqn[4];
#define P11_LOAD(mm, O, X) do { _Pragma("unroll") for (int j = 0; j < 2; ++j) { O[j] = *(const v4u*)(OUTB + (size_t)(mm) * 1024 + 8 * (lane + 64 * j)); \
                X[2 * j] = *(const f32x4*)(x + (size_t)(mm) * DM + 8 * (lane + 64 * j)); X[2 * j + 1] = *(const f32x4*)(x + (size_t)(mm) * DM + 8 * (lane + 64 * j) + 4); } } while (0)
            if (gw < M) P11_LOAD(gw, oqn, xqn);
            for (int m = gw; m < M; m += NGW) {
                const int b = m >> 11;
#pragma unroll
                for (int j = 0; j < 2; ++j) { oq[j] = oqn[j]; xq[2 * j] = xqn[2 * j]; xq[2 * j + 1] = xqn[2 * j + 1]; }
                if (m + NGW < M) P11_LOAD(m + NGW, oqn, xqn);
                float o[2][8]; float s = 0.f;
#pragma unroll
                for (int j = 0; j < 2; ++j) { unpack8(oq[j], o[j]);
#pragma unroll
                    for (int e = 0; e < 8; ++e) s += o[j][e] * o[j][e]; }
                const float rinv = 1.0f / sqrtf(wave_sum(s) * (1.f / DM) + 1e-6f);
#pragma unroll
                for (int j = 0; j < 2; ++j) { const int c = 8 * (lane + 64 * j);
#pragma unroll
                    for (int hlf = 0; hlf < 2; ++hlf) { const int cc = c + 4 * hlf;
                        const f32x4 gp = *(const f32x4*)(gpost + cc), gt = *(const f32x4*)(ADA + b * 3072 + 2048 + cc);
                        f32x4 ov; ov.x = o[j][4 * hlf + 0]; ov.y = o[j][4 * hlf + 1]; ov.z = o[j][4 * hlf + 2]; ov.w = o[j][4 * hlf + 3];
                        *(f32x4*)(out + (size_t)m * DM + cc) = xq[2 * j + hlf] + gt * (ov * rinv * gp); } }
            }
#undef P11_LOAD
        }
    }
#undef IN
#undef BOTH
#undef GRID_BAR
}

extern "C" void kernel_launch(void* const* d_in, const int* in_sizes, int n_in, void* d_out, int out_size, void* d_ws, size_t ws_size, hipStream_t stream) {
    static int grid = 0;
    if (grid == 0) {
        if (n_in != NIN || in_sizes[0] != M * DM || out_size != M * DM || ws_size < WS_END) { fprintf(stderr, "kernel_launch: unexpected shapes: n_in %d in0 %d out %d ws %zu (need %zu)\n", n_in, n_in > 0 ? in_sizes[0] : -1, out_size, ws_size, (size_t)WS_END); grid = -1; return; }
        int dev = 0, cus = 0;
        if (hipGetDevice(&dev) != hipSuccess || hipDeviceGetAttribute(&cus, hipDeviceAttributeMultiprocessorCount, dev) != hipSuccess) { fprintf(stderr, "kernel_launch: device query failed\n"); grid = -1; return; }
        if (hipFuncSetAttribute((const void*)mk_fwd, hipFuncAttributeMaxDynamicSharedMemorySize, LDS_BYTES) != hipSuccess) { fprintf(stderr, "kernel_launch: hipFuncSetAttribute failed\n"); grid = -1; return; }
        (void)hipGetLastError();
        grid = cus;
        if (grid != 256) fprintf(stderr, "kernel_launch: %d CUs (built for 256)\n", grid);
    }
    if (grid < 0) return;
    if (hipMemsetAsync((char*)d_ws + WS_CTL, 0, CTL_ZERO_BYTES, stream) != hipSuccess) { fprintf(stderr, "kernel_launch: memset failed\n"); return; }
    Args a{};
    for (int i = 0; i < NIN; ++i) a.in[i] = (const float*)d_in[i];
    a.out = (float*)d_out; a.ws = (unsigned char*)d_ws;
    static const int plan[][2] = MK_PLAN;
    const int nl = (int)(sizeof(plan) / sizeof(plan[0]));
    for (int li = 0; li < nl; ++li) {
        a.ph_lo = plan[li][0]; a.ph_hi = plan[li][1]; a.li = li; a.pad = (li < nl - 1) ? MK_PROBE_FLAGS : 0;
        hipLaunchKernelGGL(mk_fwd, dim3(grid), dim3(NWAVES * 64), LDS_BYTES, stream, a);
        const hipError_t le = hipPeekAtLastError();
        if (le != hipSuccess) { fprintf(stderr, "kernel_launch: launch %d failed: %s\n", li, hipGetErrorName(le)); break; }
    }
}
```

```cpp
#include <hip/hip_runtime.h>
#include <cstdio>
#include <cstdint>
namespace pg8 {
#define PG8_LAS __attribute__((address_space(3)))
typedef unsigned short bf16_t;
typedef short bf16x8 __attribute__((ext_vector_type(8)));
typedef float f32x4 __attribute__((ext_vector_type(4)));
typedef unsigned u32x4 __attribute__((ext_vector_type(4)));
constexpr int BM = 256, BK = 64, HALF = 128, HTB = HALF * BK * 2  , STAGE_BYTES = 8 * HTB, NXCD = 8, WGM = 8;

__host__ __device__ __forceinline__ int lds_byte(int r, int c) { const int st = (r >> 4) * 2 + (c >> 5), rr = r & 15, cc = c & 31, ob = rr * 64 + cc * 2; return st * 1024 + (ob ^ (((ob >> 9) & 1) << 5)); }
__host__ __device__ __forceinline__ void stage_rc(int b, int& R, int& C) { const int st = b / 1024, sb = b % 1024, swz = sb ^ (((sb >> 9) & 1) << 5); R = (st >> 1) * 16 + swz / 64; C = (st & 1) * 32 + (swz % 64) / 2; }
__host__ __device__ __forceinline__ int perm32(int rho) { const int n = rho >> 4, i = rho & 15; return 8 * (i >> 2) + 4 * n + (i & 3); }

struct Unit { int pm, pn; };
struct Gemm { const bf16_t* A; const bf16_t* Bt; int M, N, K, lda; };

struct StaticOrder {
    int nM, nN, nwg, G, c;
    __host__ __device__ void init(int M, int N, int G_, int c_) { nM = M / BM; nN = N / BM; nwg = nM * nN; G = G_; c = c_; }
    __host__ __device__ bool next(int i, Unit& u) const {
        const long L = (long)i * G + c; if (L >= nwg) return false;
        int wgid = (int)L; { const int q = nwg / NXCD, r = nwg % NXCD, xcd = wgid % NXCD, off = wgid / NXCD; wgid = (xcd < r ? xcd * (q + 1) : r * (q + 1) + (xcd - r) * q) + off; }
        const int nig = WGM * nN, gid = wgid / nig, fm = gid * WGM, gsz = (nM - fm) < WGM ? (nM - fm) : WGM;
        u.pm = fm + ((wgid % nig) % gsz); u.pn = (wgid % nig) / gsz; return true;
    }
    __device__ __forceinline__ void a_ready(const Unit&) const {}
    __device__ __forceinline__ void done(const Unit&) const {}
};

__device__ __forceinline__ unsigned cvt_pk_bf16(float lo, float hi) { unsigned r; asm volatile("v_cvt_pk_bf16_f32 %0, %1, %2" : "=v"(r) : "v"(lo), "v"(hi)); return r; }
typedef float f32x2 __attribute__((ext_vector_type(2)));
__device__ __forceinline__ f32x2 gelu_pk(f32x2 v) {
    const f32x2 av = __builtin_elementwise_abs(v), d = av * 0.2316418882f + 1.0f;
    f32x2 t; t.x = __builtin_amdgcn_rcpf(d.x); t.y = __builtin_amdgcn_rcpf(d.y);
    f32x2 q = t * 0.5307027145f + (-0.7265760135f); q = q * t + 0.7107068705f; q = q * t + (-0.142248368f); q = q * t + 0.127414796f; q = q * t;
    const f32x2 s = (v * v) * (-0.72134752044f);
    f32x2 e; e.x = __builtin_amdgcn_exp2f(s.x); e.y = __builtin_amdgcn_exp2f(s.y);
    const f32x2 m = v * (q * e), r = v - m;
    f32x2 o; o.x = v.x < 0.f ? m.x : r.x; o.y = v.y < 0.f ? m.y : r.y; return o;
}

template <int ACT  > struct EpiBf16 {
    static constexpr bool PERM = true, AFTER_DRAIN = false; static_assert(ACT == 0 || ACT == 1, "EpiBf16: ACT is 0 (none) or 1 (gelu_pk)");
    bf16_t* O; int ldc; const float* bias; int split_cols; size_t split_stride; float scale0;
    __device__ __forceinline__ void operator()(const f32x4 (&acc)[2][2][4][2], const Unit& u, int wr, int wc, int fr, int fq) const {
        const int row0 = u.pm * BM + wr * 64 + fr; int colt = u.pn * BM; bf16_t* base = O;
        float sc = 1.f; if (split_cols) { const int t = colt / split_cols; base += (size_t)t * split_stride; colt -= t * split_cols; if (t == 0) sc = scale0; }
        const int col0 = colt + wc * 32 + 8 * fq, bcol0 = u.pn * BM + wc * 32 + 8 * fq;
        f32x4 bv[2][2];
#pragma unroll
        for (int bj = 0; bj < 2; ++bj)
#pragma unroll
            for (int n = 0; n < 2; ++n) bv[bj][n] = bias ? *(const f32x4*)(bias + bcol0 + bj * HALF + 4 * n) : (f32x4){0.f, 0.f, 0.f, 0.f};
#pragma unroll
        for (int ai = 0; ai < 2; ++ai)
#pragma unroll
            for (int m = 0; m < 4; ++m) { bf16_t* rowp = base + (size_t)(row0 + ai * HALF + m * 16) * ldc + col0;
#pragma unroll
                for (int bj = 0; bj < 2; ++bj) { f32x4 v0 = acc[ai][bj][m][0] + bv[bj][0], v1 = acc[ai][bj][m][1] + bv[bj][1];
                    if (ACT == 1) { f32x2 a = gelu_pk((f32x2){v0[0], v0[1]}), b = gelu_pk((f32x2){v0[2], v0[3]}), c = gelu_pk((f32x2){v1[0], v1[1]}), d = gelu_pk((f32x2){v1[2], v1[3]});
                        v0 = (f32x4){a.x, a.y, b.x, b.y}; v1 = (f32x4){c.x, c.y, d.x, d.y}; }
                    v0 = v0 * sc; v1 = v1 * sc; u32x4 w; w.x = cvt_pk_bf16(v0[0], v0[1]); w.y = cvt_pk_bf16(v0[2], v0[3]); w.z = cvt_pk_bf16(v1[0], v1[1]); w.w = cvt_pk_bf16(v1[2], v1[3]);
                    *(u32x4*)(rowp + bj * HALF) = w; } }
    }
};
template <class Epi, class Sched, bool ALIGN_EPI = false, bool SP2 = false>
__device__ __forceinline__ void gemm_phase(PG8_LAS unsigned char* lds, const Gemm g, const Sched& S, const Epi& E) {
    const int tid = threadIdx.x, wid = __builtin_amdgcn_readfirstlane(tid >> 6), lane = tid & 63, wr = wid >> 2, wc = wid & 3, fr = lane & 15, fq = lane >> 4;
    const int K = g.K, nt = K / BK;
    unsigned voffA[2], voffB[2];
#pragma unroll
    for (int i = 0; i < 2; ++i) { int R, C; stage_rc(tid * 16 + i * 8192, R, C); const int Rb = Epi::PERM ? ((R & ~31) + perm32(R & 31)) : R;
        voffA[i] = (unsigned)(R * g.lda + C) * 2u; voffB[i] = (unsigned)(Rb * K + C) * 2u; }
    const size_t kstep = (size_t)(BK * 2);
    const size_t hstepB = (size_t)HALF * K * 2, hstepA = (size_t)HALF * g.lda * 2;
    const size_t tstepB = 2 * hstepB, tstepA = 2 * hstepA;
    const unsigned ldsw = (unsigned)wid * 1024u;
    const int aoff = lds_byte(wr * 64 + fr, fq * 8), boff = lds_byte(wc * 32 + fr, fq * 8);
#define PG8_SA(b, h) (((b) * 2 + (h)) * HTB)
#define PG8_SB(b, h) ((4 + (b) * 2 + (h)) * HTB)
#define PG8_STAGE(bufoff, gbase, voff) do { _Pragma("unroll") for (int _i = 0; _i < 2; ++_i) \
        __builtin_amdgcn_global_load_lds((const unsigned*)((const char*)(gbase) + (voff)[_i]), (PG8_LAS unsigned*)(lds + (bufoff) + ldsw + _i * 8192), 16, 0, 0); } while (0)
#define PG8_LDA(dst, b, h) do { _Pragma("unroll") for (int m = 0; m < 4; ++m) _Pragma("unroll") for (int k = 0; k < 2; ++k) dst[m][k] = *(const PG8_LAS bf16x8*)(lds + PG8_SA(b, h) + aoff + m * 2048 + k * 1024); } while (0)
#define PG8_LDB(dst, b, h) do { _Pragma("unroll") for (int n = 0; n < 2; ++n) _Pragma("unroll") for (int k = 0; k < 2; ++k) dst[n][k] = *(const PG8_LAS bf16x8*)(lds + PG8_SB(b, h) + boff + n * 2048 + k * 1024); } while (0)
#define PG8_MMA(ai, bj, At, Bt) do { __builtin_amdgcn_s_setprio(1); _Pragma("unroll") for (int m = 0; m < 4; ++m) _Pragma("unroll") for (int n = 0; n < 2; ++n) _Pragma("unroll") for (int k = 0; k < 2; ++k) \
        acc[ai][bj][m][n] = __builtin_amdgcn_mfma_f32_16x16x32_bf16(Bt[n][k], At[m][k], acc[ai][bj][m][n], 0, 0, 0); __builtin_amdgcn_s_setprio(0); } while (0)
#define PG8_WAIT_V(n) asm volatile("s_waitcnt vmcnt(" #n ")" ::: "memory")
#define PG8_WAIT_L(n) asm volatile("s_waitcnt lgkmcnt(" #n ")" ::: "memory")
#define PG8_BAR __builtin_amdgcn_s_barrier()
#define PG8_SCHED __builtin_amdgcn_sched_barrier(0)
    Unit cur, nxt; int ui = 0;
    if (!S.next(0, cur)) return;
    f32x4 acc[2][2][4][2];
#pragma unroll
    for (int a = 0; a < 2; ++a)
#pragma unroll
        for (int b = 0; b < 2; ++b)
#pragma unroll
            for (int m = 0; m < 4; ++m)
#pragma unroll
                for (int n = 0; n < 2; ++n) acc[a][b][m][n] = (f32x4){0.f, 0.f, 0.f, 0.f};
    bf16x8 At[4][2], B0[2][2], B1[2][2];
    const char* cA = (const char*)g.A + (size_t)cur.pm * tstepA; const char* cB = (const char*)g.Bt + (size_t)cur.pn * tstepB;
    S.a_ready(cur);
    if constexpr (SP2) {
        PG8_STAGE(PG8_SB(0, 0), cB, voffB); PG8_STAGE(PG8_SB(0, 1), cB + hstepB, voffB); PG8_STAGE(PG8_SA(0, 0), cA, voffA); PG8_STAGE(PG8_SA(0, 1), cA + hstepA, voffA);
        if (wr == 1) PG8_BAR;
        PG8_WAIT_V(2); PG8_BAR;
        PG8_STAGE(PG8_SB(1, 0), cB + kstep, voffB); PG8_STAGE(PG8_SA(1, 0), cA + kstep, voffA); PG8_STAGE(PG8_SB(1, 1), cB + hstepB + kstep, voffB);
        PG8_WAIT_V(6); PG8_BAR;
    } else {
        PG8_STAGE(PG8_SB(0, 0), cB, voffB); PG8_STAGE(PG8_SA(0, 0), cA, voffA); PG8_STAGE(PG8_SB(0, 1), cB + hstepB, voffB); PG8_STAGE(PG8_SA(0, 1), cA + hstepA, voffA);
        if (wr == 1) PG8_BAR;
        PG8_WAIT_V(4); PG8_BAR;
        PG8_STAGE(PG8_SB(1, 0), cB + kstep, voffB); PG8_STAGE(PG8_SA(1, 0), cA + kstep, voffA); PG8_STAGE(PG8_SB(1, 1), cB + hstepB + kstep, voffB);
        PG8_WAIT_V(6); PG8_BAR;
    }
    for (;;) {
        const bool has_next = S.next(ui + 1, nxt);
        const char* nA = has_next ? (const char*)g.A + (size_t)nxt.pm * tstepA : cA; const char* nB = has_next ? (const char*)g.Bt + (size_t)nxt.pn * tstepB : cB;
        for (int t = 0; t < nt; t += 2) {
            const bool last = (t == nt - 2);
            const char* a1 = cA + (size_t)(t + 1) * kstep;
            const char* a2 = last ? nA : cA + (size_t)(t + 2) * kstep; const char* b2 = last ? nB : cB + (size_t)(t + 2) * kstep;
            const char* a3 = a2 + kstep; const char* b3 = b2 + kstep;
            if (last && has_next) S.a_ready(nxt);
            if constexpr (SP2) {
            PG8_LDB(B0, 0, 0); PG8_LDB(B1, 0, 1); PG8_SCHED; PG8_LDA(At, 0, 0); PG8_STAGE(PG8_SA(1, 1), a1 + hstepA, voffA);
            PG8_WAIT_V(8); PG8_WAIT_L(0); PG8_BAR; PG8_MMA(0, 0, At, B0); PG8_MMA(0, 1, At, B1); PG8_BAR; PG8_SCHED;
            PG8_LDA(At, 0, 1); PG8_STAGE(PG8_SB(0, 0), b2, voffB); PG8_STAGE(PG8_SB(0, 1), b2 + hstepB, voffB); PG8_STAGE(PG8_SA(0, 0), a2, voffA);
            PG8_WAIT_V(8); PG8_WAIT_L(0); PG8_BAR; PG8_MMA(1, 0, At, B0); PG8_MMA(1, 1, At, B1); PG8_BAR; PG8_SCHED;
            PG8_LDB(B0, 1, 0); PG8_LDB(B1, 1, 1); PG8_SCHED; PG8_LDA(At, 1, 0); PG8_STAGE(PG8_SA(0, 1), a2 + hstepA, voffA);
            PG8_WAIT_V(8); PG8_WAIT_L(0); PG8_BAR; PG8_MMA(0, 0, At, B0); PG8_MMA(0, 1, At, B1); PG8_BAR; PG8_SCHED;
            PG8_LDA(At, 1, 1); PG8_STAGE(PG8_SB(1, 0), b3, voffB); PG8_STAGE(PG8_SB(1, 1), b3 + hstepB, voffB); PG8_STAGE(PG8_SA(1, 0), a3, voffA);
            PG8_WAIT_V(8); PG8_WAIT_L(0); PG8_BAR; PG8_MMA(1, 0, At, B0); PG8_MMA(1, 1, At, B1); PG8_BAR; PG8_SCHED;
            } else {
            PG8_LDB(B0, 0, 0); PG8_SCHED; PG8_LDA(At, 0, 0); PG8_STAGE(PG8_SA(1, 1), a1 + hstepA, voffA);
            PG8_WAIT_L(8); PG8_BAR; PG8_WAIT_L(0); PG8_MMA(0, 0, At, B0); PG8_BAR; PG8_SCHED;
            PG8_LDB(B1, 0, 1); PG8_STAGE(PG8_SB(0, 0), b2, voffB);
            PG8_BAR; PG8_WAIT_L(0); PG8_MMA(0, 1, At, B1); PG8_BAR;
            PG8_LDA(At, 0, 1); PG8_STAGE(PG8_SA(0, 0), a2, voffA);
            PG8_BAR; PG8_WAIT_L(0); PG8_MMA(1, 0, At, B0); PG8_BAR; PG8_SCHED;
            PG8_STAGE(PG8_SB(0, 1), b2 + hstepB, voffB);
            PG8_WAIT_V(6); PG8_BAR; PG8_MMA(1, 1, At, B1); PG8_BAR;
            PG8_LDB(B0, 1, 0); PG8_SCHED; PG8_LDA(At, 1, 0); PG8_STAGE(PG8_SA(0, 1), a2 + hstepA, voffA);
            PG8_WAIT_L(8); PG8_BAR; PG8_WAIT_L(0); PG8_MMA(0, 0, At, B0); PG8_BAR; PG8_SCHED;
            PG8_LDB(B1, 1, 1); PG8_STAGE(PG8_SB(1, 0), b3, voffB);
            PG8_BAR; PG8_WAIT_L(0); PG8_MMA(0, 1, At, B1); PG8_BAR;
            PG8_LDA(At, 1, 1); PG8_STAGE(PG8_SA(1, 0), a3, voffA);
            PG8_BAR; PG8_WAIT_L(0); PG8_MMA(1, 0, At, B0); PG8_BAR; PG8_SCHED;
            PG8_STAGE(PG8_SB(1, 1), b3 + hstepB, voffB);
            PG8_WAIT_V(6); PG8_BAR; PG8_MMA(1, 1, At, B1); PG8_BAR;
            }
        }
        if constexpr (ALIGN_EPI) { if (wr == 0) PG8_BAR; }
        if constexpr (!Epi::AFTER_DRAIN) { E(acc, cur, wr, wc, fr, fq); S.done(cur); }
        if (!has_next) break;
#pragma unroll
        for (int a = 0; a < 2; ++a)
#pragma unroll
            for (int b = 0; b < 2; ++b)
#pragma unroll
                for (int m = 0; m < 4; ++m)
#pragma unroll
                    for (int n = 0; n < 2; ++n) acc[a][b][m][n] = (f32x4){0.f, 0.f, 0.f, 0.f};
        cur = nxt; cA = nA; cB = nB; ++ui;
        if constexpr (ALIGN_EPI) { if (wr == 1) PG8_BAR; }
    }
    PG8_WAIT_V(0);
    if constexpr (!ALIGN_EPI) { if (wr == 0) PG8_BAR; }
    PG8_BAR;
    if constexpr (Epi::AFTER_DRAIN) { E.fused(acc, cur, wr, wc, fr, fq, lds, wid, lane); S.done(cur); }
#undef PG8_SA
#undef PG8_SB
#undef PG8_STAGE
#undef PG8_LDA
#undef PG8_LDB
#undef PG8_MMA
#undef PG8_WAIT_V
#undef PG8_WAIT_L
#undef PG8_BAR
#undef PG8_SCHED
}
}
namespace pg8 {
struct EpiRoute {
    static constexpr bool PERM = true, AFTER_DRAIN = false;
    bf16_t* base0; bf16_t* base1; int ldc0, ldc1, tile1;
    __device__ __forceinline__ void operator()(const f32x4 (&acc)[2][2][4][2], const Unit& u, int wr, int wc, int fr, int fq) const {
        const bool second = u.pn >= tile1;
        bf16_t* O = second ? base1 : base0; const int ld = second ? ldc1 : ldc0; const int colt = (second ? u.pn - tile1 : u.pn) * BM;
        const int row0 = u.pm * BM + wr * 64 + fr;
        const int col0 = colt + wc * 32 + 8 * fq;
#pragma unroll
        for (int ai = 0; ai < 2; ++ai)
#pragma unroll
            for (int m = 0; m < 4; ++m) { bf16_t* rowp = O + (size_t)(row0 + ai * HALF + m * 16) * ld + col0;
#pragma unroll
                for (int bj = 0; bj < 2; ++bj) { const f32x4 v0 = acc[ai][bj][m][0], v1 = acc[ai][bj][m][1];
                    u32x4 w; w.x = cvt_pk_bf16(v0[0], v0[1]); w.y = cvt_pk_bf16(v0[2], v0[3]); w.z = cvt_pk_bf16(v1[0], v1[1]); w.w = cvt_pk_bf16(v1[2], v1[3]);
                    *(u32x4*)(rowp + bj * HALF) = w; } }
    }
};
}
namespace pg8 {
__device__ __forceinline__ float sigm(float x) { return __builtin_amdgcn_rcpf(1.0f + __expf(-x)); }
struct EpiLora {
    static constexpr bool PERM = true, AFTER_DRAIN = false;
    bf16_t* O; const float* w0; const float* a0;
    __device__ __forceinline__ void operator()(const f32x4 (&acc)[2][2][4][2], const Unit& u, int wr, int wc, int fr, int fq) const {
        const int row0 = u.pm * BM + wr * 64 + fr, col0 = u.pn * BM + wc * 32 + 8 * fq;
        const float* par = (u.pn >= 4) ? (a0 - 1024) : w0;
#pragma unroll
        for (int ai = 0; ai < 2; ++ai)
#pragma unroll
            for (int m = 0; m < 4; ++m) {
#pragma unroll
                for (int bj = 0; bj < 2; ++bj) { bf16_t* rowp = O + (size_t)(row0 + ai * HALF + m * 16) * 2048 + col0 + bj * HALF;
                    const f32x4 x0 = acc[ai][bj][m][0] + *(const f32x4*)(par + col0 + bj * HALF), x1 = acc[ai][bj][m][1] + *(const f32x4*)(par + col0 + bj * HALF + 4); u32x4 w;
                    w.x = cvt_pk_bf16(sigm(x0[0]), sigm(x0[1])); w.y = cvt_pk_bf16(sigm(x0[2]), sigm(x0[3])); w.z = cvt_pk_bf16(sigm(x1[0]), sigm(x1[1])); w.w = cvt_pk_bf16(sigm(x1[2]), sigm(x1[3]));
                    *(u32x4*)rowp = w; }
                asm volatile("" ::: "memory"); }
    }
};
template <int MODE> struct EpiGate {
    static constexpr bool PERM = true, AFTER_DRAIN = false;
    bf16_t* O; const bf16_t* Gl;
    __device__ __forceinline__ void operator()(const f32x4 (&acc)[2][2][4][2], const Unit& u, int wr, int wc, int fr, int fq) const {
        const int row0 = u.pm * BM + wr * 64 + fr, col0 = u.pn * BM + wc * 32 + 8 * fq;
#pragma unroll
        for (int ai = 0; ai < 2; ++ai) {
            u32x4 gq[4][2], tq[4][2];
#pragma unroll
            for (int m = 0; m < 4; ++m)
#pragma unroll
                for (int bj = 0; bj < 2; ++bj) { const size_t row = (size_t)(row0 + ai * HALF + m * 16); const int col = col0 + bj * HALF;
                    gq[m][bj] = *(const u32x4*)(Gl + row * 2048 + MODE * 1024 + col);
                    if (MODE == 1) tq[m][bj] = *(const u32x4*)(O + row * 1024 + col); }
#pragma unroll
            for (int m = 0; m < 4; ++m)
#pragma unroll
                for (int bj = 0; bj < 2; ++bj) { const size_t row = (size_t)(row0 + ai * HALF + m * 16); const int col = col0 + bj * HALF;
                    const unsigned gw[4] = {gq[m][bj].x, gq[m][bj].y, gq[m][bj].z, gq[m][bj].w}; float g[8];
#pragma unroll
                    for (int e = 0; e < 4; ++e) { g[2 * e] = sigm(__builtin_bit_cast(float, gw[e] << 16)); g[2 * e + 1] = sigm(__builtin_bit_cast(float, gw[e] & 0xffff0000u)); }
                    const f32x4 v0 = acc[ai][bj][m][0], v1 = acc[ai][bj][m][1];
                    float r[8] = {g[0] * v0[0], g[1] * v0[1], g[2] * v0[2], g[3] * v0[3], g[4] * v1[0], g[5] * v1[1], g[6] * v1[2], g[7] * v1[3]};
                    if (MODE == 1) { const unsigned tw[4] = {tq[m][bj].x, tq[m][bj].y, tq[m][bj].z, tq[m][bj].w};
#pragma unroll
                        for (int e = 0; e < 4; ++e) { r[2 * e] += __builtin_bit_cast(float, tw[e] << 16); r[2 * e + 1] += __builtin_bit_cast(float, tw[e] & 0xffff0000u); } }
                    u32x4 w; w.x = cvt_pk_bf16(r[0], r[1]); w.y = cvt_pk_bf16(r[2], r[3]); w.z = cvt_pk_bf16(r[4], r[5]); w.w = cvt_pk_bf16(r[6], r[7]);
                    *(u32x4*)(O + row * 1024 + col) = w; }
        }
    }
};
}
namespace pg8 {
struct EpiGateCat {
    static constexpr bool PERM = true, AFTER_DRAIN = false;
    bf16_t* O; const bf16_t* Gl;
    __device__ __forceinline__ void mid(f32x4 (&acc)[2][2][4][2], const Unit& u, int wr, int wc, int fr, int fq) const {
        const int row0 = u.pm * BM + wr * 64 + fr, col0 = u.pn * BM + wc * 32 + 8 * fq;
#pragma unroll
        for (int ai = 0; ai < 2; ++ai) {
            u32x4 gr[4][2], ga[4][2];
#pragma unroll
            for (int m = 0; m < 4; ++m)
#pragma unroll
                for (int bj = 0; bj < 2; ++bj) { const size_t row = (size_t)(row0 + ai * HALF + m * 16); const int col = col0 + bj * HALF;
                    gr[m][bj] = *(const u32x4*)(Gl + row * 2048 + col); ga[m][bj] = *(const u32x4*)(Gl + row * 2048 + 1024 + col); }
#pragma unroll
            for (int m = 0; m < 4; ++m)
#pragma unroll
                for (int bj = 0; bj < 2; ++bj) { const unsigned wr_[4] = {gr[m][bj].x, gr[m][bj].y, gr[m][bj].z, gr[m][bj].w}, wa_[4] = {ga[m][bj].x, ga[m][bj].y, ga[m][bj].z, ga[m][bj].w}; float rt[8];
#pragma unroll
                    for (int e = 0; e < 4; ++e) {
                        const float r0 = __builtin_bit_cast(float, wr_[e] << 16), r1 = __builtin_bit_cast(float, wr_[e] & 0xffff0000u), a0 = __builtin_bit_cast(float, wa_[e] << 16), a1 = __builtin_bit_cast(float, wa_[e] & 0xffff0000u);
                        rt[2 * e] = (1.0f + __expf(-a0)) * __builtin_amdgcn_rcpf(1.0f + __expf(-r0)); rt[2 * e + 1] = (1.0f + __expf(-a1)) * __builtin_amdgcn_rcpf(1.0f + __expf(-r1)); }
                    acc[ai][bj][m][0] = acc[ai][bj][m][0] * (f32x4){rt[0], rt[1], rt[2], rt[3]}; acc[ai][bj][m][1] = acc[ai][bj][m][1] * (f32x4){rt[4], rt[5], rt[6], rt[7]}; }
        }
    }
    __device__ __forceinline__ void operator()(const f32x4 (&acc)[2][2][4][2], const Unit& u, int wr, int wc, int fr, int fq) const {
        const int row0 = u.pm * BM + wr * 64 + fr, col0 = u.pn * BM + wc * 32 + 8 * fq;
#pragma unroll
        for (int ai = 0; ai < 2; ++ai) {
            u32x4 ga[4][2];
#pragma unroll
            for (int m = 0; m < 4; ++m)
#pragma unroll
                for (int bj = 0; bj < 2; ++bj) { const size_t row = (size_t)(row0 + ai * HALF + m * 16); const int col = col0 + bj * HALF; ga[m][bj] = *(const u32x4*)(Gl + row * 2048 + 1024 + col); }
#pragma unroll
            for (int m = 0; m < 4; ++m)
#pragma unroll
                for (int bj = 0; bj < 2; ++bj) { const size_t row = (size_t)(row0 + ai * HALF + m * 16); const int col = col0 + bj * HALF;
                    const unsigned wa_[4] = {ga[m][bj].x, ga[m][bj].y, ga[m][bj].z, ga[m][bj].w}; float g[8];
#pragma unroll
                    for (int e = 0; e < 4; ++e) { g[2 * e] = sigm(__builtin_bit_cast(float, wa_[e] << 16)); g[2 * e + 1] = sigm(__builtin_bit_cast(float, wa_[e] & 0xffff0000u)); }
                    const f32x4 v0 = acc[ai][bj][m][0], v1 = acc[ai][bj][m][1];
                    u32x4 w; w.x = cvt_pk_bf16(g[0] * v0[0], g[1] * v0[1]); w.y = cvt_pk_bf16(g[2] * v0[2], g[3] * v0[3]); w.z = cvt_pk_bf16(g[4] * v1[0], g[5] * v1[1]); w.w = cvt_pk_bf16(g[6] * v1[2], g[7] * v1[3]);
                    *(u32x4*)(O + row * 1024 + col) = w; }
        }
    }
};
}
#define GAS __attribute__((address_space(1)))
#define LAS __attribute__((address_space(3)))
typedef unsigned short bf16;
typedef unsigned v4u __attribute__((ext_vector_type(4)));
typedef float f32x4 __attribute__((ext_vector_type(4)));
typedef short bf16x8 __attribute__((ext_vector_type(8)));
typedef GAS unsigned gu32;
typedef GAS unsigned long long gu64;
#define RLX_AGENT __ATOMIC_RELAXED, __HIP_MEMORY_SCOPE_AGENT
#define LDS_WAIT() asm volatile("s_waitcnt lgkmcnt(0)" ::: "memory")
#define VM_WAIT() asm volatile("s_waitcnt vmcnt(0)" ::: "memory")
__device__ __forceinline__ unsigned long long rt() { return __builtin_amdgcn_s_memrealtime(); }
__device__ __forceinline__ unsigned f2bf(float f) { unsigned u = __builtin_bit_cast(unsigned, f); return (u + 0x7fffu + ((u >> 16) & 1u)) >> 16; }
__device__ __forceinline__ unsigned pk2(float lo, float hi) { return f2bf(lo) | (f2bf(hi) << 16); }
#define XB_TMO      128
#define XB_XCNT(j)  (256  + 64 * (j))
#define XB_XSUB(j)  (1280 + 64 * (j))
#define XB_XGEN(j)  (2304 + 64 * (j))
#define XB_TOP      3328
#define XB_TOPGEN   3392
#define XCD_BAR_WORDS 3456
#define XB_SPIN_CAP (1u << 18)

__device__ __forceinline__ unsigned xb_ld(unsigned* p)              { return __hip_atomic_load(p, __ATOMIC_RELAXED, __HIP_MEMORY_SCOPE_AGENT); }
__device__ __forceinline__ unsigned xb_add(unsigned* p, unsigned v) { return __hip_atomic_fetch_add(p, v, __ATOMIC_RELAXED, __HIP_MEMORY_SCOPE_AGENT); }
__device__ __forceinline__ unsigned xb_xcc_id() { return (unsigned)__builtin_amdgcn_s_getreg((3 << 11) | 20) & 0xFu; }
#define XB_SPIN(cond, bar) do { unsigned _sp = 0; while (cond) { __builtin_amdgcn_s_sleep(1); \
    if ((++_sp & 255u) == 0u) { if (xb_ld(&(bar)[XB_TMO])) break; if (_sp > XB_SPIN_CAP) { atomicAdd(&(bar)[XB_TMO], 1u); break; } } } } while (0)

struct XcdBarrier {
    unsigned* bar; unsigned x;
    volatile LAS unsigned* st;
};

__device__ __forceinline__ XcdBarrier xcd_barrier_post(unsigned* bar, volatile LAS unsigned* st) {
    XcdBarrier b; b.bar = bar; b.x = xb_xcc_id(); b.st = st;
    if (threadIdx.x == 0) (void)xb_add(&bar[XB_XCNT(b.x)], 1u);
    return b;
}
__device__ __forceinline__ void xcd_barrier_complete(unsigned* bar, unsigned x, unsigned& nloc, unsigned& nx) {
    const unsigned G = gridDim.x * gridDim.y * gridDim.z;
    unsigned sum, cnt, mine, sp = 0u;
    for (;;) {
        sum = 0u; cnt = 0u; mine = 0u;
#pragma unroll
        for (unsigned j = 0; j < 16; ++j) { const unsigned c = xb_ld(&bar[XB_XCNT(j)]); sum += c; cnt += (c > 0u) ? 1u : 0u; mine = (j == x) ? c : mine; }
        if (sum == G) break;
        __builtin_amdgcn_s_sleep(1);
        if ((++sp & 255u) == 0u) { if (xb_ld(&bar[XB_TMO])) break; if (sp > XB_SPIN_CAP) { atomicAdd(&bar[XB_TMO], 1u); break; } }
    }
    nloc = mine > 0u ? mine : 1u; nx = cnt > 0u ? cnt : 1u;
}

__device__ __forceinline__ void xcd_barrier(const XcdBarrier& b) {
    asm volatile("s_waitcnt vmcnt(0)" ::: "memory");
    __syncthreads();
    if (threadIdx.x == 0) {
        unsigned* bar = b.bar;
        __builtin_amdgcn_s_waitcnt(0);
        unsigned nloc = b.st[0], nx = b.st[1];
        if (nloc == 0u) { xcd_barrier_complete(bar, b.x, nloc, nx); b.st[0] = nloc; b.st[1] = nx; }
        const unsigned old = xb_add(&bar[XB_XSUB(b.x)], 1u);
        const unsigned gen = old / nloc;
        if (old + 1u == (gen + 1u) * nloc) {
            __builtin_amdgcn_fence(__ATOMIC_RELEASE, "agent");
            asm volatile("s_waitcnt vmcnt(0)" ::: "memory");
            const unsigned og = xb_add(&bar[XB_TOP], 1u);
            const unsigned tg = og / nx;
            if (og + 1u == (tg + 1u) * nx) xb_add(&bar[XB_TOPGEN], 1u);
            else XB_SPIN(xb_ld(&bar[XB_TOPGEN]) == tg, bar);
            __builtin_amdgcn_fence(__ATOMIC_ACQUIRE, "agent");
            xb_add(&bar[XB_XGEN(b.x)], 1u);
            asm volatile("s_waitcnt vmcnt(0)" ::: "memory");
        } else {
            XB_SPIN(xb_ld(&bar[XB_XGEN(b.x)]) == gen, bar);
            __builtin_amdgcn_fence(__ATOMIC_ACQUIRE, "agent");
            asm volatile("s_waitcnt vmcnt(0)" ::: "memory");
        }
    }
    __syncthreads();
}
constexpr int NWAVES = 8;
constexpr int BATCH = 32, SEQ = 2048, DM = 1024, M = BATCH * SEQ;
constexpr int RW = 512, RCOLS = 2304, ACOLS = 1280, GCOLS = 2048;
enum { I_X = 0, I_C, I_WADA, I_BADA, I_GPRE, I_GPOST, I_WIN, I_MU, I_W0, I_WUP, I_A0, I_AUP, I_KK, I_KA, I_RK, I_GNW, I_GNB, I_SINK, I_WBRR, I_WBRA, I_WOUT, NIN };
#ifndef MK_N_LAUNCHES
#define MK_N_LAUNCHES 1
#endif
constexpr int N_PHASES = 12;
#ifndef MK_PLAN
#define MK_PLAN {{0, N_PHASES}}
#endif
#ifndef MK_PROBE_FLAGS
#define MK_PROBE_FLAGS 0
#endif
constexpr int N_LAUNCHES = MK_N_LAUNCHES;
constexpr size_t MiB = 1u << 20;
constexpr size_t WS_CTL = 0, CTL_ZERO_BYTES = 1 * MiB;
constexpr size_t WS_ADA = 512 * 1024;
constexpr size_t WS_BSUM = 2 * MiB;
constexpr size_t WS_BP4 = 984 * MiB;
constexpr size_t WS_WINT = 4 * MiB;
constexpr size_t WS_WBRR = 15 * MiB, WS_WBRA = 16 * MiB, WS_WOUT = 17 * MiB, WS_WLORA = 19 * MiB;
constexpr size_t WS_H = 24 * MiB;
constexpr size_t WS_PA = 152 * MiB;
constexpr size_t WS_PR = 312 * MiB;
constexpr size_t WS_KD1 = 568 * MiB;
constexpr size_t WS_LA = 600 * MiB;
constexpr size_t WS_R = 632 * MiB, WS_K = 696 * MiB, WS_V = 760 * MiB, WS_G = 824 * MiB, WS_KK = 888 * MiB;
constexpr size_t WS_MG = 568 * MiB;
constexpr size_t WS_PG = 312 * MiB;
constexpr size_t WS_BR = 568 * MiB;
constexpr size_t WS_BA = 824 * MiB;
constexpr size_t WS_KB = 952 * MiB, WS_VB = 968 * MiB;
constexpr size_t WS_END = 1024 * MiB;
constexpr int CW_BAR = 4096;
constexpr int RING_BYTES = 155648, LDSCTL_OFF = RING_BYTES, MISC_OFF = LDSCTL_OFF + 320, LDS_BYTES = 163840;

__device__ __forceinline__ float bflo(unsigned w) { return __builtin_bit_cast(float, w << 16); }
__device__ __forceinline__ float bfhi(unsigned w) { return __builtin_bit_cast(float, w & 0xffff0000u); }
__device__ __forceinline__ float bf2f(bf16 u) { return __builtin_bit_cast(float, (unsigned)u << 16); }
__device__ __forceinline__ void unpack8(const v4u q, float* f) { f[0] = bflo(q.x); f[1] = bfhi(q.x); f[2] = bflo(q.y); f[3] = bfhi(q.y); f[4] = bflo(q.z); f[5] = bfhi(q.z); f[6] = bflo(q.w); f[7] = bfhi(q.w); }
__device__ __forceinline__ unsigned cvtpk_c(float lo, float hi);
__device__ __forceinline__ v4u pack8(const float* f) { v4u o; o.x = cvtpk_c(f[0], f[1]); o.y = cvtpk_c(f[2], f[3]); o.z = cvtpk_c(f[4], f[5]); o.w = cvtpk_c(f[6], f[7]); return o; }
__device__ __forceinline__ float sigmoidf_(float x) { return __builtin_amdgcn_rcpf(1.0f + __expf(-x)); }
__device__ __forceinline__ float wave_sum(float v) {
#pragma unroll
    for (int o = 1; o < 64; o <<= 1) v += __shfl_xor(v, o);
    return v;
}
__device__ __forceinline__ void transpose_item(const float* W, int K, int N, bf16* WT, int ldwt, int row_off, int kcol_off, LAS float* scr, int item, int lane) {
    const int nblk = N / 32, kb = item / nblk, nb = item % nblk, k0 = 64 * kb, n0 = 32 * nb;
#pragma unroll 8
    for (int i = 0; i < 32; ++i) { const int kk = 2 * i + (lane >> 5); scr[kk * 33 + (lane & 31)] = W[(size_t)(k0 + kk) * N + n0 + (lane & 31)]; }
    LDS_WAIT(); asm volatile("" ::: "memory");
    const int c = lane & 7;
#pragma unroll
    for (int j = 0; j < 4; ++j) { const int n = (lane >> 3) + 8 * j; const LAS float* s = scr + (8 * c) * 33 + n;
        v4u o; o.x = pk2(s[0 * 33], s[1 * 33]); o.y = pk2(s[2 * 33], s[3 * 33]); o.z = pk2(s[4 * 33], s[5 * 33]); o.w = pk2(s[6 * 33], s[7 * 33]);
        *(GAS v4u*)(WT + (size_t)(row_off + n0 + n) * ldwt + kcol_off + k0 + 8 * c) = o; }
    LDS_WAIT(); asm volatile("" ::: "memory");
}

typedef unsigned u32x2_t __attribute__((ext_vector_type(2)));
typedef float f32x2_c __attribute__((ext_vector_type(2))); typedef __bf16 bf16x2_c __attribute__((ext_vector_type(2)));
__device__ __forceinline__ unsigned cvtpk_c(float lo, float hi) { const f32x2_c v = {lo, hi}; const bf16x2_c b = __builtin_convertvector(v, bf16x2_c); return __builtin_bit_cast(unsigned, b); }
__device__ __forceinline__ bf16x8 ldsfrag_perm(const LAS unsigned char* p) { const u32x2_t a = *(const LAS u32x2_t*)p, b = *(const LAS u32x2_t*)(p + 16); return __builtin_bit_cast(bf16x8, (v4u){a.x, a.y, b.x, b.y}); }
struct Args { const float* in[NIN]; float* out; unsigned char* ws; int ph_lo, ph_hi, li, pad; };

#define PTRS const int G = gridDim.x, bx = blockIdx.x; const int vcu = (G % 8 == 0) ? (bx % 8) * (G / 8) + bx / 8 : bx; const int gw = vcu * NWAVES + wave, NGW = G * NWAVES; (void)gw; (void)NGW; const float* x = args.in[I_X]; const float* cin = args.in[I_C]; const float* wada = args.in[I_WADA]; const float* bada = args.in[I_BADA]; const float* gpre = args.in[I_GPRE]; const float* gpost = args.in[I_GPOST]; const float* win = args.in[I_WIN]; const float* mu = args.in[I_MU]; const float* w0 = args.in[I_W0]; const float* wup = args.in[I_WUP]; const float* a0 = args.in[I_A0]; const float* aup = args.in[I_AUP]; const float* k_k = args.in[I_KK]; const float* k_a = args.in[I_KA]; const float* r_k = args.in[I_RK]; const float* gnw = args.in[I_GNW]; const float* gnb = args.in[I_GNB]; const float* sink = args.in[I_SINK]; const float* wbrr = args.in[I_WBRR]; const float* wbra = args.in[I_WBRA]; const float* wout = args.in[I_WOUT]; float* out = args.out; float* ADA = (float*)(ws + WS_ADA); float* BSUM = (float*)(ws + WS_BSUM); float* BP4 = (float*)(ws + WS_BP4); (void)BSUM; bf16* WinT = (bf16*)(ws + WS_WINT); bf16* WbrrT = (bf16*)(ws + WS_WBRR); bf16* WbraT = (bf16*)(ws + WS_WBRA); bf16* WoutT = (bf16*)(ws + WS_WOUT); bf16* WloraT = (bf16*)(ws + WS_WLORA); bf16* Hb = (bf16*)(ws + WS_H); bf16* MG = (bf16*)(ws + WS_MG); bf16* PA = (bf16*)(ws + WS_PA); bf16* PR = (bf16*)(ws + WS_PR); bf16* RAW = (bf16*)(ws + WS_PR); bf16* PGT = (bf16*)(ws + WS_PG); bf16* OUTB = (bf16*)(ws + WS_PR); bf16* KD1 = (bf16*)(ws + WS_KD1); bf16* LA = (bf16*)(ws + WS_LA); bf16* Rb = (bf16*)(ws + WS_R); bf16* Kb = (bf16*)(ws + WS_K); bf16* Vb = (bf16*)(ws + WS_V); bf16* Gb = (bf16*)(ws + WS_G); bf16* KKb = (bf16*)(ws + WS_KK); bf16* KB = (bf16*)(ws + WS_KB); bf16* VB = (bf16*)(ws + WS_VB); bf16* BR = (bf16*)(ws + WS_BR); bf16* BA = (bf16*)(ws + WS_BA);
__global__ void __launch_bounds__(NWAVES * 64, 2) mk_fwd(Args args) {
    extern __shared__ __attribute__((aligned(16))) unsigned char lds_raw[];
    LAS unsigned char* lds = (LAS unsigned char*)lds_raw;
    volatile LAS unsigned* MISC = (volatile LAS unsigned*)(lds + MISC_OFF);
    const int tid = threadIdx.x, lane = tid & 63, wave = __builtin_amdgcn_readfirstlane(tid >> 6);
    unsigned char* ws = args.ws;
    gu32* ctl = (gu32*)(ws + WS_CTL);
    for (int u = tid; u < (LDS_BYTES - LDSCTL_OFF) / 4; u += NWAVES * 64) ((LAS unsigned*)(lds + LDSCTL_OFF))[u] = 0u;
    __syncthreads();
    XcdBarrier bar; bar.bar = (unsigned*)(ctl + CW_BAR); bar.x = 0; bar.st = nullptr;
    const bool use_bar = (args.ph_hi - args.ph_lo) > 1;
    if (use_bar) bar = xcd_barrier_post((unsigned*)(ctl + CW_BAR) + args.li * XCD_BAR_WORDS, MISC + 8);
#define GRID_BAR() do { if (use_bar) xcd_barrier(bar); } while (0)
#define IN(k) (args.ph_lo <= (k) && (k) < args.ph_hi)
#define BOTH(k) (IN(k) && IN((k) + 1))
    if (IN(0)) { PTRS
        LAS float* scr = (LAS float*)(lds + wave * 16384);
        constexpr int I_IN = 16 * 176, I_BRR = 8 * 32, I_OUT = 16 * 32, I_LORA = 64, NT = I_IN + 2 * I_BRR + I_OUT + I_LORA;
        for (int it = gw; it < NT; it += NGW) {
            int r = it;
            if (r < I_IN) { transpose_item(win, 1024, 5632, WinT, 1024, 0, 0, scr, r, lane); continue; } r -= I_IN;
            if (r < I_BRR) { transpose_item(wbrr, 512, 1024, WbrrT, 512, 0, 0, scr, r, lane); continue; } r -= I_BRR;
            if (r < I_BRR) { transpose_item(wbra, 512, 1024, WbraT, 512, 0, 0, scr, r, lane); continue; } r -= I_BRR;
            if (r < I_OUT) { transpose_item(wout, 1024, 1024, WoutT, 1024, 0, 0, scr, r, lane); continue; } r -= I_OUT;
            { const int mat = r >> 4, nb = r & 15; const float* W = (mat < 2 ? wup : aup) + (size_t)(mat & 1) * 64 * 512;
              transpose_item(W, 64, 512, WloraT, 256, mat * 512, mat * 64, scr, nb, lane);
#pragma unroll
              for (int i = 0; i < 12; ++i) { const int q = lane + 64 * i, row = q / 24, cc = q % 24, chunk = cc < mat * 8 ? cc : cc + 8;
                  *(GAS v4u*)(WloraT + (size_t)(mat * 512 + nb * 32 + row) * 256 + chunk * 8) = (v4u){0u, 0u, 0u, 0u}; } }
        }
        for (int it = gw; it < 1536; it += NGW) {
            const int nblk = it % 48, r_ = it / 48, bg = r_ & 7, kq = r_ >> 3, n = nblk * 64 + lane, b0 = bg * 4, kbase = kq * 256;
#pragma unroll
            for (int bb = 0; bb < 4; ++bb)
#pragma unroll
                for (int kk = 0; kk < 4; ++kk) { const int k = lane + 64 * kk; const float cv = cin[(b0 + bb) * 1024 + kbase + k]; scr[k * 4 + bb] = cv * sigmoidf_(cv); }
            LDS_WAIT(); asm volatile("" ::: "memory");
            float acc[4] = {0.f, 0.f, 0.f, 0.f};
#pragma unroll 32
            for (int k = 0; k < 256; ++k) { const float wv = wada[(size_t)(kbase + k) * 3072 + n]; const f32x4 s = *(const LAS f32x4*)(scr + k * 4);
                acc[0] += s[0] * wv; acc[1] += s[1] * wv; acc[2] += s[2] * wv; acc[3] += s[3] * wv; }
            const float bn = kq == 0 ? bada[n] : 0.f;
#pragma unroll
            for (int bb = 0; bb < 4; ++bb) atomicAdd(ADA + (b0 + bb) * 3072 + n, acc[bb] + bn);
            LDS_WAIT(); asm volatile("" ::: "memory");
        }
        if (BOTH(0)) GRID_BAR();
    }
    if (IN(1)) { PTRS
        {
            f32x4 v[4], vn[4];
#define P1_LOAD(mm, V) do { const GAS f32x4* xr_ = (const GAS f32x4*)(x + (size_t)(mm) * DM) + lane; _Pragma("unroll") for (int j = 0; j < 4; ++j) V[j] = xr_[64 * j]; } while (0)
            if (gw < M) P1_LOAD(gw, vn);
            for (int m = gw; m < M; m += NGW) {
                const int b = m >> 11;
#pragma unroll
                for (int j = 0; j < 4; ++j) v[j] = vn[j];
                if (m + NGW < M) P1_LOAD(m + NGW, vn);
                float s = 0.f;
#pragma unroll
                for (int j = 0; j < 4; ++j) s += (v[j].x * v[j].x + v[j].y * v[j].y) + (v[j].z * v[j].z + v[j].w * v[j].w);
                const float rinv = 1.0f / sqrtf(wave_sum(s) * (1.f / DM) + 1e-6f);
                GAS unsigned long long* o8 = (GAS unsigned long long*)(Hb + (size_t)m * DM) + lane;
#pragma unroll
                for (int j = 0; j < 4; ++j) { const int c = 4 * (lane + 64 * j);
                    const f32x4 gp = *(const f32x4*)(gpre + c), sh = *(const f32x4*)(ADA + b * 3072 + c), sc = *(const f32x4*)(ADA + b * 3072 + 1024 + c);
                    const f32x4 hh = v[j] * rinv * gp * (sc + 1.0f) + sh;
                    o8[64 * j] = (unsigned long long)cvtpk_c(hh.x, hh.y) | ((unsigned long long)cvtpk_c(hh.z, hh.w) << 32); }
            }
#undef P1_LOAD
        }
        if (BOTH(1)) GRID_BAR();
    }
    if (IN(2)) { PTRS
        pg8::Gemm g{Hb, WinT, M, 3584, 1024, 1024}; pg8::StaticOrder S; S.init(M, 3584, G, bx);
        pg8::EpiRoute E{PR, PA, RCOLS, ACOLS, 9};
        pg8::gemm_phase<pg8::EpiRoute, pg8::StaticOrder, true, true>(lds, g, S, E);
        if (BOTH(2)) GRID_BAR();
    }
    if (IN(3)) { PTRS
        {
            v4u cu[5], pv[5], nx[5];
            v4u cu2[5], pv2[5], nx2[5];
            const v4u zero4 = (v4u){0u, 0u, 0u, 0u};
            float mm0[5][8], mm1[5][8];
#pragma unroll
            for (int i = 0; i < 5; ++i) { const int c = (i == 4 && lane >= 32) ? 0 : 8 * (lane + 64 * i);
                const f32x4 m0a = *(const f32x4*)(mu + c), m0b = *(const f32x4*)(mu + c + 4), m1a = *(const f32x4*)(mu + RCOLS + c), m1b = *(const f32x4*)(mu + RCOLS + c + 4);
                mm0[i][0] = m0a.x; mm0[i][1] = m0a.y; mm0[i][2] = m0a.z; mm0[i][3] = m0a.w; mm0[i][4] = m0b.x; mm0[i][5] = m0b.y; mm0[i][6] = m0b.z; mm0[i][7] = m0b.w;
                mm1[i][0] = m1a.x; mm1[i][1] = m1a.y; mm1[i][2] = m1a.z; mm1[i][3] = m1a.w; mm1[i][4] = m1b.x; mm1[i][5] = m1b.y; mm1[i][6] = m1b.z; mm1[i][7] = m1b.w; }
#define P3_LOAD(mm, C, P, N) do { const int t_ = (mm) & 2047; const bf16* pc_ = PR + (size_t)(mm) * RCOLS; _Pragma("unroll") for (int i = 0; i < 5; ++i) { if (i == 4 && lane >= 32) break; const int c_ = 8 * (lane + 64 * i); \
                C[i] = *(const v4u*)(pc_ + c_); P[i] = t_ > 0 ? *(const v4u*)(pc_ - RCOLS + c_) : zero4; N[i] = t_ < 2047 ? *(const v4u*)(pc_ + RCOLS + c_) : zero4; } } while (0)
            if (gw < M) P3_LOAD(gw, cu2, pv2, nx2);
            for (int m = gw; m < M; m += NGW) {
#pragma unroll
                for (int i = 0; i < 5; ++i) { cu[i] = cu2[i]; pv[i] = pv2[i]; nx[i] = nx2[i]; }
                if (m + NGW < M) P3_LOAD(m + NGW, cu2, pv2, nx2);
#pragma unroll
                for (int i = 0; i < 5; ++i) {
                    if (i == 4 && lane >= 32) break;
                    const int c = 8 * (lane + 64 * i);
                    float p[8], pp[8], pn[8], o[8];
                    unpack8(cu[i], p); unpack8(pv[i], pp); unpack8(nx[i], pn);
#pragma unroll
                    for (int e = 0; e < 8; ++e) o[e] = p[e] + mm0[i][e] * (pp[e] - p[e]) + mm1[i][e] * (pn[e] - p[e]);
                    if (i == 0) { *(v4u*)(Rb + (size_t)m * RW + c) = pack8(o); }
                    else if (i == 1) { const int cc = c - 512;
                        *(v4u*)(Kb + (size_t)m * RW + cc) = pack8(o);
                        const f32x4 ka_ = *(const f32x4*)(k_k + cc), kb_ = *(const f32x4*)(k_k + cc + 4);
                        const float kkw[8] = {ka_.x, ka_.y, ka_.z, ka_.w, kb_.x, kb_.y, kb_.z, kb_.w};
                        float kr[8]; float ss = 0.f;
#pragma unroll
                        for (int e = 0; e < 8; ++e) { kr[e] = o[e] * kkw[e]; ss += kr[e] * kr[e]; }
                        ss += __shfl_xor(ss, 1); ss += __shfl_xor(ss, 2); ss += __shfl_xor(ss, 4);
                        const float inv = 1.0f / fmaxf(sqrtf(ss), 1e-12f);
#pragma unroll
                        for (int e = 0; e < 8; ++e) kr[e] *= inv;
                        *(v4u*)(KKb + (size_t)m * RW + cc) = pack8(kr); }
                    else if (i == 2) { *(v4u*)(Vb + (size_t)m * RW + (c - 1024)) = pack8(o); }
                    else if (i == 3) { *(v4u*)(Gb + (size_t)m * RW + (c - 1536)) = pack8(o); }
                    else { if (lane < 16) {
#pragma unroll
                            for (int e = 0; e < 8; ++e) o[e] = 1.0f - 2.0f * __builtin_amdgcn_rcpf(1.0f + __expf(2.0f * o[e])); }
                        *(v4u*)(LA + (size_t)m * 256 + (c - 2048)) = pack8(o); }
                }
            }
#undef P3_LOAD
        }
        {
            LAS unsigned char* scr8 = lds + wave * 16384;
            for (int u = gw; u < 2048; u += NGW) {
                const int b = u >> 6, kvh = (u >> 5) & 1, tb = u & 31;
                const bf16* srck = PA + ((size_t)b * SEQ + tb * 64 + lane) * ACOLS + 512 + kvh * 64;
                const size_t tile0 = ((size_t)(b * 2 + kvh) * 64 + 2 * tb);
#pragma unroll
                for (int j8 = 0; j8 < 8; ++j8) *(LAS v4u*)(scr8 + lane * 144 + 16 * j8) = *(const v4u*)(srck + 8 * j8);
                LDS_WAIT(); asm volatile("" ::: "memory");
#pragma unroll
                for (int tt = 0; tt < 2; ++tt)
#pragma unroll
                    for (int ks = 0; ks < 4; ++ks) *(v4u*)(KB + (((tile0 + tt) * 4 + ks) * 64 + lane) * 8) = *(const LAS v4u*)(scr8 + (32 * tt + (lane & 31)) * 144 + (16 * ks + 8 * (lane >> 5)) * 2);
                LDS_WAIT(); asm volatile("" ::: "memory");
                LAS unsigned short* tile = (LAS unsigned short*)scr8;
                const bf16* srcv = srck + 128;
#pragma unroll
                for (int j8 = 0; j8 < 8; ++j8) { const v4u qv = *(const v4u*)(srcv + 8 * j8); LAS unsigned* dst = (LAS unsigned*)(tile + lane * 66 + 8 * j8);
                    dst[0] = qv.x; dst[1] = qv.y; dst[2] = qv.z; dst[3] = qv.w; }
                LDS_WAIT(); asm volatile("" ::: "memory");
#pragma unroll
                for (int tt = 0; tt < 2; ++tt)
#pragma unroll
                    for (int mb = 0; mb < 2; ++mb)
#pragma unroll
                        for (int k2 = 0; k2 < 2; ++k2) { unsigned w[4];
#pragma unroll
                            for (int e = 0; e < 4; ++e) { const int j0 = 2 * e, key0 = 32 * tt + 16 * k2 + 8 * (j0 >> 2) + 4 * (lane >> 5) + (j0 & 3);
                                const unsigned lo16 = tile[key0 * 66 + 32 * mb + (lane & 31)], hi16 = tile[(key0 + 1) * 66 + 32 * mb + (lane & 31)]; w[e] = lo16 | (hi16 << 16); }
                            *(v4u*)(VB + ((((tile0 + tt) * 2 + mb) * 2 + k2) * 64 + lane) * 8) = (v4u){w[0], w[1], w[2], w[3]}; }
                LDS_WAIT(); asm volatile("" ::: "memory");
            }
        }
        if (BOTH(3)) GRID_BAR();
    }
    if (IN(4)) { PTRS
        pg8::Gemm g{LA, WloraT, M, 2048, 256, 256}; pg8::StaticOrder S; S.init(M, 2048, G, bx);
        pg8::EpiLora E{RAW, w0, a0};
        pg8::gemm_phase<pg8::EpiLora, pg8::StaticOrder, true, true>(lds, g, S, E);
        if (BOTH(4)) GRID_BAR();
    }
    if (IN(6)) { PTRS
        typedef float f32x16 __attribute__((ext_vector_type(16)));
#define MF(a, b, c) __builtin_amdgcn_mfma_f32_32x32x16_bf16(a, b, c, 0, 0, 0)
#define ACCF(x, s) __builtin_bit_cast(bf16x8, (v4u){cvtpk_c((x)[8 * (s) + 0], (x)[8 * (s) + 1]), cvtpk_c((x)[8 * (s) + 2], (x)[8 * (s) + 3]), cvtpk_c((x)[8 * (s) + 4], (x)[8 * (s) + 5]), cvtpk_c((x)[8 * (s) + 6], (x)[8 * (s) + 7])})
#define LDN(img, pitch, rowb, k0) (*(const LAS bf16x8*)((img) + ((rowb) + q) * (pitch) + ((k0) + 8 * hh) * 2))
#define LDP(img, pitch, rowb, k0) ldsfrag_perm((img) + ((rowb) + q) * (pitch) + ((k0) + 4 * hh) * 2)
#define ZERO16(x) do { _Pragma("unroll") for (int r_ = 0; r_ < 16; ++r_) (x)[r_] = 0.f; } while (0)
#define MMAA(X, Y, Cacc) do { const bf16x8 xa_ = ACCF(X, 0), xb_ = ACCF(X, 1), ya_ = ACCF(Y, 0), yb_ = ACCF(Y, 1); Cacc = MF(xa_, ya_, Cacc); Cacc = MF(xb_, yb_, Cacc); } while (0)
#define PROGW(k) ((volatile LAS unsigned*)(lds + LDSCTL_OFF + 1024 + (k) * 64))
#define SPIN_UNTIL(cond) do { while (!(cond)) __builtin_amdgcn_s_sleep(1); asm volatile("" ::: "memory"); } while (0)
        constexpr int NCH = SEQ / 32;
        const int q = lane & 31, hh = lane >> 5;
        const bool run_scan = !(args.pad & 1);
        if (wave < 4 && run_scan) {
            const int sl = wave >> 1, ib = wave & 1;
            const int s = 2 * vcu + sl; const int d = s & 1, bh = s >> 1, b = bh >> 3, h = bh & 7;
            LAS unsigned char* sbase = lds + sl * 57856;
            LAS unsigned char* VT0 = lds + 115712 + wave * 5120;
            const LAS unsigned char* FR = lds + 136192 + sl * 8192;
            volatile LAS unsigned* progE = PROGW(wave); volatile LAS unsigned* ptE = PROGW(wave ^ 1); volatile LAS unsigned* progM = PROGW(4 + wave); volatile LAS unsigned* ptM = PROGW(4 + (wave ^ 1));
            volatile LAS unsigned* progF = PROGW(8 + wave); volatile LAS unsigned* progH = PROGW(12 + sl);
            const int cp = lane & 15, tq = lane >> 4;
            bf16* pY = RAW + d * 512 + h * 64 + ib * 32 + q;
            const unsigned tsel = d ? (unsigned)(3 - tq) : (unsigned)tq;
            const unsigned offS = tsel * 8u * 4096u + 64u * ib + 4u * cp, offT = tsel * 8u * 1024u + 64u * ib + 4u * cp;
            const unsigned oS = (unsigned)((d * 512 + h * 64) * 2), oT = (unsigned)(h * 128);
            unsigned pf[5][8], vq[8];
#define PF_TOK(cc, tl) ((unsigned)(b * SEQ + (d ? (SEQ - 1 - 32 * (cc) - (tl) - 24) : (32 * (cc) + (tl)))))
#define PF_ISSUE(cc, T0, T1) do { unsigned vS_ = offS, vT_ = offT; asm volatile("" : "+v"(vS_), "+v"(vT_));        \
            _Pragma("unroll") for (int tl = (T0); tl < (T1); ++tl) { const unsigned m0 = PF_TOK(cc, tl); \
                pf[0][tl] = *(const unsigned*)((ws + ((unsigned)WS_PR + oS + m0 * 4096u)) + vS_); pf[1][tl] = *(const unsigned*)((ws + ((unsigned)WS_PR + 2048u + oS + m0 * 4096u)) + vS_); pf[2][tl] = *(const unsigned*)((ws + ((unsigned)WS_KK + oT + m0 * 1024u)) + vT_); \
                pf[3][tl] = *(const unsigned*)((ws + ((unsigned)WS_K + oT + m0 * 1024u)) + vT_); pf[4][tl] = *(const unsigned*)((ws + ((unsigned)WS_R + oT + m0 * 1024u)) + vT_); } } while (0)
            PF_ISSUE(0, 0, 8);
            { unsigned vT_ = offT; asm volatile("" : "+v"(vT_));
#pragma unroll
              for (int tl = 0; tl < 8; ++tl) { const unsigned m0 = PF_TOK(0, tl); vq[tl] = *(const unsigned*)((ws + ((unsigned)WS_V + oT + m0 * 1024u)) + vT_); } }
            f32x16 H0a, H0b; ZERO16(H0a); ZERO16(H0b);
            for (int it = 0; it <= NCH; ++it) {
                if (it < NCH) {
                    LAS unsigned char* KQ = sbase + (it & 1) * 28928, *RQ = KQ + 4608, *KKI = KQ + 9216, *BKI = KQ + 13824, *KCT = KQ + 18432, *BCT = KQ + 23552; LAS float* GC = (LAS float*)(KQ + 28672);
                    LAS unsigned char* VTI = VT0 + (it & 1) * 2560;
                    if (it >= 2) SPIN_UNTIL(*progH + 1u >= (unsigned)it && *ptM + 1u >= (unsigned)it);
                    {
                    const float ka0 = k_a[h * 64 + 32 * ib + 2 * cp], ka1 = k_a[h * 64 + 32 * ib + 2 * cp + 1];
                    const float rk0 = r_k[h * 64 + 32 * ib + 2 * cp], rk1 = r_k[h * 64 + 32 * ib + 2 * cp + 1];
                    const int cn = it + 1 < NCH ? it + 1 : it;
                    unsigned nS_ = offS, nT_ = offT; asm volatile("" : "+v"(nS_), "+v"(nT_));
                    float t0 = 0.f, t1 = 0.f;
#pragma unroll
                    for (int tl = 0; tl < 8; ++tl) { t0 += bflo(pf[0][tl]); t1 += bfhi(pf[0][tl]); }
                    t0 *= -0.6065306597f; t1 *= -0.6065306597f;
                    float o0, o1, tot0, tot1;
                    {   const auto a0_ = __builtin_amdgcn_permlane16_swap(__float_as_uint(t0), __float_as_uint(t0), false, false), a1_ = __builtin_amdgcn_permlane16_swap(__float_as_uint(t1), __float_as_uint(t1), false, false);
                        const float n0 = (tq & 1) ? __uint_as_float(a0_[0]) : __uint_as_float(a0_[1]), n1 = (tq & 1) ? __uint_as_float(a1_[0]) : __uint_as_float(a1_[1]);
                        const float p0 = t0 + n0, p1 = t1 + n1;
                        const auto b0_ = __builtin_amdgcn_permlane32_swap(__float_as_uint(p0), __float_as_uint(p0), false, false), b1_ = __builtin_amdgcn_permlane32_swap(__float_as_uint(p1), __float_as_uint(p1), false, false);
                        const float q0 = (tq & 2) ? __uint_as_float(b0_[0]) : __uint_as_float(b0_[1]), q1 = (tq & 2) ? __uint_as_float(b1_[0]) : __uint_as_float(b1_[1]);
                        o0 = ((tq & 1) ? n0 : 0.f) + ((tq & 2) ? q0 : 0.f); o1 = ((tq & 1) ? n1 : 0.f) + ((tq & 2) ? q1 : 0.f); tot0 = p0 + q0; tot1 = p1 + q1; }
                    const float gC0 = __expf(tot0), gC1 = __expf(tot1);
                    float L0 = o0, L1 = o1; float eLp0 = __expf(L0), eLp1 = __expf(L1);
                    if (tq == 0) { GC[32 * ib + 2 * cp] = gC0; GC[32 * ib + 2 * cp + 1] = gC1; }
                    float bpk = 0.f;
#pragma unroll
                    for (int t2 = 0; t2 < 4; ++t2) {
                        float kc0[2], kc1[2], bc0[2], bc1[2];
#pragma unroll
                        for (int e = 0; e < 2; ++e) { const int tl = 2 * t2 + e, tau = 8 * tq + tl;
                            const float sg0 = bflo(pf[0][tl]), sg1 = bfhi(pf[0][tl]), a0_ = bflo(pf[1][tl]), a1_ = bfhi(pf[1][tl]), kk0 = bflo(pf[2][tl]), kk1 = bfhi(pf[2][tl]);
                            const float k0_ = bflo(pf[3][tl]), k1_ = bfhi(pf[3][tl]), r0_ = bflo(pf[4][tl]), r1_ = bfhi(pf[4][tl]);
                            L0 += -0.6065306597f * sg0; L1 += -0.6065306597f * sg1;
                            const float eL0 = __expf(L0), eL1 = __expf(L1), en0 = __builtin_amdgcn_rcpf(eL0), en1 = __builtin_amdgcn_rcpf(eL1);
                            const float kd0 = k0_ * (1.0f + (a0_ - 1.0f) * ka0), kd1 = k1_ * (1.0f + (a1_ - 1.0f) * ka1);
                            const float kkf0 = kd0 * en0, kkf1 = kd1 * en1, bkf0 = kk0 * a0_ * en0, bkf1 = kk1 * a1_ * en1;
                            {
                                float bp = r0_ * kd0 * rk0 + r1_ * kd1 * rk1;
                                bp += __shfl_xor(bp, 1); bp += __shfl_xor(bp, 2); bp += __shfl_xor(bp, 4); bp += __shfl_xor(bp, 8);
                                bpk = (cp == tl) ? bp : bpk; }
                            ((LAS unsigned*)KQ)[tau * 36 + 16 * ib + cp] = pg8::cvt_pk_bf16(kk0 * eLp0, kk1 * eLp1); ((LAS unsigned*)RQ)[tau * 36 + 16 * ib + cp] = pg8::cvt_pk_bf16(r0_ * eL0, r1_ * eL1);
                            ((LAS unsigned*)KKI)[tau * 36 + 16 * ib + cp] = pg8::cvt_pk_bf16(kkf0, kkf1); ((LAS unsigned*)BKI)[tau * 36 + 16 * ib + cp] = pg8::cvt_pk_bf16(bkf0, bkf1);
                            kc0[e] = kkf0 * gC0; kc1[e] = kkf1 * gC1; bc0[e] = -bkf0 * gC0; bc1[e] = -bkf1 * gC1;
                            eLp0 = eL0; eLp1 = eL1;
                            { const unsigned m0 = PF_TOK(cn, tl);
                              pf[0][tl] = *(const unsigned*)((ws + ((unsigned)WS_PR + oS + m0 * 4096u)) + nS_); pf[1][tl] = *(const unsigned*)((ws + ((unsigned)WS_PR + 2048u + oS + m0 * 4096u)) + nS_); pf[2][tl] = *(const unsigned*)((ws + ((unsigned)WS_KK + oT + m0 * 1024u)) + nT_);
                              pf[3][tl] = *(const unsigned*)((ws + ((unsigned)WS_K + oT + m0 * 1024u)) + nT_); pf[4][tl] = *(const unsigned*)((ws + ((unsigned)WS_R + oT + m0 * 1024u)) + nT_); } }
                        const int sp = 4 * tq + t2;
                        const int j0 = 32 * ib + 2 * cp;
                        ((LAS unsigned*)KCT)[j0 * 20 + sp] = pg8::cvt_pk_bf16(kc0[0], kc0[1]); ((LAS unsigned*)KCT)[(j0 + 1) * 20 + sp] = pg8::cvt_pk_bf16(kc1[0], kc1[1]);
                        ((LAS unsigned*)BCT)[j0 * 20 + sp] = pg8::cvt_pk_bf16(bc0[0], bc0[1]); ((LAS unsigned*)BCT)[(j0 + 1) * 20 + sp] = pg8::cvt_pk_bf16(bc1[0], bc1[1]);
                    }
                    if (cp < 8) { const int tt_ = 32 * it + 8 * tq + cp; const size_t mt_ = (size_t)b * SEQ + (d ? (SEQ - 1 - tt_) : tt_); BP4[((size_t)(d * 2 + ib) * M + mt_) * 8 + h] = bpk; }
#pragma unroll
                    for (int t2 = 0; t2 < 4; ++t2) { const int sp = 4 * tq + t2; const unsigned va = vq[2 * t2], vb = vq[2 * t2 + 1];
                        ((LAS unsigned*)VTI)[(2 * cp) * 20 + sp] = (va & 0xffffu) | (vb << 16); ((LAS unsigned*)VTI)[(2 * cp + 1) * 20 + sp] = (va >> 16) | (vb & 0xffff0000u); }
#pragma unroll
                    for (int tl = 0; tl < 8; ++tl) { const unsigned m0 = PF_TOK(cn, tl); vq[tl] = *(const unsigned*)((ws + ((unsigned)WS_V + oT + m0 * 1024u)) + nT_); }
                }
                    asm volatile("s_waitcnt lgkmcnt(0)" ::: "memory");
                    *progE = (unsigned)(it + 1);
                }
                if (it >= 1) {
                    const int c = it - 1;
                    const LAS unsigned char* KQ = sbase + (c & 1) * 28928, *RQ = KQ + 4608, *KCT = KQ + 18432, *BCT = KQ + 23552; const LAS float* GC = (const LAS float*)(KQ + 28672);
                    const LAS unsigned char* VTI = VT0 + (c & 1) * 2560;
                    SPIN_UNTIL(*ptE >= (unsigned)(c + 1));
                    f32x16 Zacc, Yacc, U; ZERO16(Zacc); ZERO16(Yacc); ZERO16(U);
                    const bf16x8 h0f0 = ACCF(H0a, 0), h0f1 = ACCF(H0a, 1), h0f2 = ACCF(H0b, 0), h0f3 = ACCF(H0b, 1);
                    Zacc = MF(LDP(KQ, 144, 0, 0), h0f0, Zacc); Zacc = MF(LDP(KQ, 144, 0, 16), h0f1, Zacc); Zacc = MF(LDP(KQ, 144, 0, 32), h0f2, Zacc); Zacc = MF(LDP(KQ, 144, 0, 48), h0f3, Zacc);
                    Yacc = MF(LDP(RQ, 144, 0, 0), h0f0, Yacc); Yacc = MF(LDP(RQ, 144, 0, 16), h0f1, Yacc); Yacc = MF(LDP(RQ, 144, 0, 32), h0f2, Yacc); Yacc = MF(LDP(RQ, 144, 0, 48), h0f3, Yacc);
#pragma unroll
                    for (int r_ = 0; r_ < 16; ++r_) { const int row_ = (r_ & 3) + 8 * (r_ >> 2) + 4 * hh; H0a[r_] *= GC[row_]; H0b[r_] *= GC[32 + row_]; }
                    H0a = MF(LDN(KCT, 80, 0, 0), LDN(VTI, 80, 0, 0), H0a); H0a = MF(LDN(KCT, 80, 0, 16), LDN(VTI, 80, 0, 16), H0a);
                    H0b = MF(LDN(KCT, 80, 32, 0), LDN(VTI, 80, 0, 0), H0b); H0b = MF(LDN(KCT, 80, 32, 16), LDN(VTI, 80, 0, 16), H0b);
                    SPIN_UNTIL(*progH >= (unsigned)(c + 1));
                    bf16x8 fr[8];
#pragma unroll
                    for (int f = 0; f < 8; ++f) fr[f] = *(const LAS bf16x8*)(FR + f * 1024 + lane * 16);
                    asm volatile("s_waitcnt lgkmcnt(0)" ::: "memory");
                    *progF = (unsigned)(c + 1);
                    Zacc = MF(fr[2], LDP(VTI, 80, 0, 0), Zacc); Zacc = MF(fr[3], LDP(VTI, 80, 0, 16), Zacc);
                    Yacc = MF(fr[4], LDP(VTI, 80, 0, 0), Yacc); Yacc = MF(fr[5], LDP(VTI, 80, 0, 16), Yacc);
                    U = MF(fr[0], ACCF(Zacc, 0), U); U = MF(fr[1], ACCF(Zacc, 1), U);
                    { const bf16x8 u0 = ACCF(U, 0), u1 = ACCF(U, 1);
                      Yacc = MF(fr[6], u0, Yacc); Yacc = MF(fr[7], u1, Yacc);
#pragma unroll
                      for (int r_ = 0; r_ < 16; ++r_) { const int tt = 32 * c + (r_ & 3) + 8 * (r_ >> 2) + 4 * hh; const size_t m = (size_t)b * SEQ + (d ? (SEQ - 1 - tt) : tt);
                          pY[m * 2048] = (bf16)(cvtpk_c(Yacc[r_], 0.f) & 0xffffu); }
                      H0a = MF(LDP(BCT, 80, 0, 0), u0, H0a); H0a = MF(LDP(BCT, 80, 0, 16), u1, H0a);
                      H0b = MF(LDP(BCT, 80, 32, 0), u0, H0b); H0b = MF(LDP(BCT, 80, 32, 16), u1, H0b); }
                    asm volatile("s_waitcnt lgkmcnt(0)" ::: "memory");
                    *progM = (unsigned)(c + 1);
                }
            }
#undef PF_ISSUE
#undef PF_TOK
        } else if (wave < 6 && run_scan) {
            const int sl = wave - 4;
            const LAS unsigned char* sbase = lds + sl * 57856;
            LAS unsigned char* FR = lds + 136192 + sl * 8192;
            volatile LAS unsigned* pE0 = PROGW(2 * sl), *pE1 = PROGW(2 * sl + 1), *pF0 = PROGW(8 + 2 * sl), *pF1 = PROGW(8 + 2 * sl + 1); volatile LAS unsigned* progH = PROGW(12 + sl);
            for (int c = 0; c < NCH; ++c) {
                const LAS unsigned char* KQ = sbase + (c & 1) * 28928, *RQ = KQ + 4608, *KKI = KQ + 9216, *BKI = KQ + 13824;
                SPIN_UNTIL(*pE0 >= (unsigned)(c + 1) && *pE1 >= (unsigned)(c + 1));
                f32x16 Rm, P, Pt, Rt, Aa, Ar, Ab;
                ZERO16(P); ZERO16(Pt); ZERO16(Aa); ZERO16(Ar); ZERO16(Ab);
#pragma unroll
                for (int ks = 0; ks < 4; ++ks) { const bf16x8 fb = LDN(BKI, 144, 0, 16 * ks), fq = LDN(KQ, 144, 0, 16 * ks), fk = LDN(KKI, 144, 0, 16 * ks), frq = LDN(RQ, 144, 0, 16 * ks);
                    P = MF(fb, fq, P); Pt = MF(fq, fb, Pt); Aa = MF(fk, fq, Aa); Ar = MF(fk, frq, Ar); Ab = MF(fb, frq, Ab); }
#pragma unroll
                for (int r_ = 0; r_ < 16; ++r_) { const int row_ = (r_ & 3) + 8 * (r_ >> 2) + 4 * hh; P[r_] = row_ < q ? -P[r_] : 0.f; Pt[r_] = row_ > q ? -Pt[r_] : 0.f; Rm[r_] = P[r_] + (row_ == q ? 1.0f : 0.f); Rt[r_] = Pt[r_] + (row_ == q ? 1.0f : 0.f);
                    Aa[r_] = row_ < q ? Aa[r_] : 0.f; Ar[r_] = row_ <= q ? Ar[r_] : 0.f; Ab[r_] = row_ <= q ? -Ab[r_] : 0.f; }
                const bf16x8 fa0 = ACCF(Aa, 0), fa1 = ACCF(Aa, 1), fr0 = ACCF(Ar, 0), fr1 = ACCF(Ar, 1), fb0 = ACCF(Ab, 0), fb1 = ACCF(Ab, 1);
#pragma unroll
                for (int k = 0; k < 4; ++k) {
                    f32x16 P2; ZERO16(P2); MMAA(Pt, P, P2);
                    MMAA(Rt, P2, Rm);
                    if (k < 3) { f32x16 P2t; ZERO16(P2t); MMAA(P, Pt, P2t); MMAA(P2, Rt, Rt); Pt = P2t; }
                    P = P2;
                }
                const bf16x8 ft0 = ACCF(Rm, 0), ft1 = ACCF(Rm, 1);
                asm volatile("s_waitcnt lgkmcnt(0)" ::: "memory");
                if (c >= 1) SPIN_UNTIL(*pF0 >= (unsigned)c && *pF1 >= (unsigned)c);
                *(LAS bf16x8*)(FR + 0 * 1024 + lane * 16) = ft0; *(LAS bf16x8*)(FR + 1 * 1024 + lane * 16) = ft1; *(LAS bf16x8*)(FR + 2 * 1024 + lane * 16) = fa0; *(LAS bf16x8*)(FR + 3 * 1024 + lane * 16) = fa1;
                *(LAS bf16x8*)(FR + 4 * 1024 + lane * 16) = fr0; *(LAS bf16x8*)(FR + 5 * 1024 + lane * 16) = fr1; *(LAS bf16x8*)(FR + 6 * 1024 + lane * 16) = fb0; *(LAS bf16x8*)(FR + 7 * 1024 + lane * 16) = fb1;
                asm volatile("s_waitcnt lgkmcnt(0)" ::: "memory");
                *progH = (unsigned)(c + 1);
            }
        }
        if (!(args.pad & 2)) {
            const int b = vcu >> 3, kvh = (vcu >> 2) & 1, qseg = vcu & 3;
            const bf16* kb0 = KB + ((size_t)(b * 2 + kvh) * 64) * 4 * 64 * 8 + lane * 8;
            const bf16* vb0 = VB + ((size_t)(b * 2 + kvh) * 64) * 4 * 64 * 8 + lane * 8;
            LAS unsigned* qctr = (LAS unsigned*)(lds + LDSCTL_OFF + 1024 + 14 * 64);
#define ATT_LOAD(kt_, KF, VF) do { _Pragma("unroll") for (int ks = 0; ks < 4; ++ks) KF[ks] = *(const bf16x8*)(kb0 + (size_t)((kt_) * 4 + ks) * 512); \
                _Pragma("unroll") for (int mb = 0; mb < 2; ++mb) _Pragma("unroll") for (int k2 = 0; k2 < 2; ++k2) VF[mb][k2] = *(const bf16x8*)(vb0 + (size_t)((kt_) * 4 + mb * 2 + k2) * 512); } while (0)
            for (;;) {
                unsigned e_ = 0; if (lane == 0) e_ = __hip_atomic_fetch_add(qctr, 1u, __ATOMIC_RELAXED, __HIP_MEMORY_SCOPE_WORKGROUP);
                const int e = __builtin_amdgcn_readfirstlane((int)e_);
                if (e >= 64) break;
                const int g = e & 3, qb = qseg * 16 + (e >> 2), hq = kvh * 4 + g;
                const int t = 32 * qb + q;
                const float slope = exp2f(-(float)(hq + 1));
                bf16* qrow = PA + ((size_t)b * SEQ + t) * ACOLS + hq * 64;
                bf16x8 qf[4];
#pragma unroll
                for (int ks = 0; ks < 4; ++ks) qf[ks] = *(const bf16x8*)(qrow + 16 * ks + 8 * hh);
                float mrun = sink[hq], lrun = 1.0f;
                f32x16 O0, O1; ZERO16(O0); ZERO16(O1);
                const int kt0 = qb - 4 < 0 ? 0 : qb - 4, kt1 = qb + 4 > 63 ? 63 : qb + 4;
                float nb[16];
#pragma unroll
                for (int r = 0; r < 16; ++r) nb[r] = slope * (float)(q - 4 * hh - ((r & 3) + 8 * (r >> 2)));
                bf16x8 kfA[4], vfA[2][2], kfB[4], vfB[2][2];
#define ATT_TILE(kt_, KF, VF) do { \
                    f32x16 acc; ZERO16(acc); \
                    _Pragma("unroll") for (int ks = 0; ks < 4; ++ks) acc = MF(KF[ks], qf[ks], acc); \
                      \
                    const int dlt = qb - (kt_); float sc[16]; float mx = -1e30f; \
                    if (dlt > 0) { _Pragma("unroll") for (int r = 0; r < 16; ++r) sc[r] = acc[r] * 0.125f - nb[r]; \
                        if (dlt == 4) { _Pragma("unroll") for (int r = 0; r < 16; ++r) sc[r] = nb[r] <= 0.f ? sc[r] : -1e30f; } } \
                    else if (dlt < 0) { _Pragma("unroll") for (int r = 0; r < 16; ++r) sc[r] = acc[r] * 0.125f + nb[r]; \
                        if (dlt == -4) { _Pragma("unroll") for (int r = 0; r < 16; ++r) sc[r] = nb[r] >= 0.f ? sc[r] : -1e30f; } } \
                    else { _Pragma("unroll") for (int r = 0; r < 16; ++r) sc[r] = acc[r] * 0.125f - fabsf(nb[r]); } \
                    const float coff = slope * 32.0f * (float)(dlt < 0 ? -dlt : dlt); \
                    _Pragma("unroll") for (int r = 0; r < 16; ++r) mx = fmaxf(mx, sc[r]); \
                    { const auto rr_ = __builtin_amdgcn_permlane32_swap(__float_as_uint(mx), __float_as_uint(mx), false, false); mx = fmaxf(__uint_as_float(rr_[0]), __uint_as_float(rr_[1])) - coff; }     \
                    const float mn = fmaxf(mrun, mx), alpha = __expf(mrun - mn); mrun = mn; \
                    const float sh = mn + coff; float rs = 0.f; \
                    _Pragma("unroll") for (int r = 0; r < 16; ++r) { sc[r] = __expf(sc[r] - sh); rs += sc[r]; } \
                    lrun = lrun * alpha + rs;                                  \
                    bf16x8 pb[2]; \
                    _Pragma("unroll") for (int k2 = 0; k2 < 2; ++k2) pb[k2] = __builtin_bit_cast(bf16x8, (v4u){cvtpk_c(sc[8 * k2 + 0], sc[8 * k2 + 1]), cvtpk_c(sc[8 * k2 + 2], sc[8 * k2 + 3]), cvtpk_c(sc[8 * k2 + 4], sc[8 * k2 + 5]), cvtpk_c(sc[8 * k2 + 6], sc[8 * k2 + 7])}); \
                    if (__ballot(alpha != 1.0f) != 0ull) { _Pragma("unroll") for (int r = 0; r < 16; ++r) { O0[r] *= alpha; O1[r] *= alpha; } } \
                    _Pragma("unroll") for (int k2 = 0; k2 < 2; ++k2) { O0 = MF(VF[0][k2], pb[k2], O0); O1 = MF(VF[1][k2], pb[k2], O1); } } while (0)
                ATT_LOAD(kt0, kfA, vfA);
                for (int kt = kt0; kt <= kt1; kt += 2) {
                    if (kt + 1 <= kt1) ATT_LOAD(kt + 1, kfB, vfB);
                    ATT_TILE(kt, kfA, vfA);
                    if (kt + 1 <= kt1) {
                        if (kt + 2 <= kt1) ATT_LOAD(kt + 2, kfA, vfA);
                        ATT_TILE(kt + 1, kfB, vfB);
                    }
                }
#undef ATT_TILE
                { const auto rr_ = __builtin_amdgcn_permlane32_swap(__float_as_uint(lrun), __float_as_uint(lrun), false, false); lrun = __uint_as_float(rr_[0]) + __uint_as_float(rr_[1]) - __expf(sink[hq] - mrun); }
                const float inv = __builtin_amdgcn_rcpf(lrun);
                const bf16* grow = PA + ((size_t)b * SEQ + t) * ACOLS + 768 + hq * 64;
#pragma unroll
                for (int mb = 0; mb < 2; ++mb)
#pragma unroll
                    for (int r4 = 0; r4 < 4; ++r4) { const int dd = mb * 32 + 8 * r4 + 4 * hh;
                        const uint2 gq = *(const uint2*)(grow + dd);
                        const float g0 = bflo(gq.x), g1 = bfhi(gq.x), g2 = bflo(gq.y), g3 = bfhi(gq.y);
                        const float o0 = (mb ? O1[4 * r4 + 0] : O0[4 * r4 + 0]) * inv, o1 = (mb ? O1[4 * r4 + 1] : O0[4 * r4 + 1]) * inv, o2 = (mb ? O1[4 * r4 + 2] : O0[4 * r4 + 2]) * inv, o3 = (mb ? O1[4 * r4 + 3] : O0[4 * r4 + 3]) * inv;
                        *(uint2*)(qrow + dd) = make_uint2(cvtpk_c(o0 * g0 * pg8::sigm(g0), o1 * g1 * pg8::sigm(g1)), cvtpk_c(o2 * g2 * pg8::sigm(g2), o3 * g3 * pg8::sigm(g3))); }
            }
#undef ATT_LOAD
        }
#undef MF
#undef ACCF
#undef LDN
#undef LDP
#undef ZERO16
#undef MMAA
#undef PROGW
#undef SPIN_UNTIL
        if (BOTH(6)) GRID_BAR();
    }
    if (IN(7)) { PTRS
        {
            const int c0 = 8 * lane;
            v4u q8[4], q8n[4]; float bsn = 0.f;
#define P7_LOAD(mm, Q, B) do { const bf16* rr_ = RAW + (size_t)(mm) * 2048 + c0; Q[0] = *(const v4u*)(rr_); Q[1] = *(const v4u*)(rr_ + 512); \
                Q[2] = *(const v4u*)(Vb + (size_t)(mm) * RW + c0); Q[3] = *(const v4u*)(Gb + (size_t)(mm) * RW + c0); { const size_t bi_ = (size_t)(mm) * 8 + (lane >> 3); B = (BP4[bi_] + BP4[(size_t)M * 8 + bi_]) + (BP4[(size_t)2 * M * 8 + bi_] + BP4[(size_t)3 * M * 8 + bi_]); } } while (0)
            const f32x4 gwa = *(const f32x4*)(gnw + c0), gwb = *(const f32x4*)(gnw + c0 + 4), gba = *(const f32x4*)(gnb + c0), gbb = *(const f32x4*)(gnb + c0 + 4);
            const float gw8[8] = {gwa.x, gwa.y, gwa.z, gwa.w, gwb.x, gwb.y, gwb.z, gwb.w}, gb8[8] = {gba.x, gba.y, gba.z, gba.w, gbb.x, gbb.y, gbb.z, gbb.w};
            if (gw < M) P7_LOAD(gw, q8n, bsn);
            for (int m = gw; m < M; m += NGW) {
#pragma unroll
                for (int i = 0; i < 4; ++i) q8[i] = q8n[i];
                const float bs = bsn;
                if (m + NGW < M) P7_LOAD(m + NGW, q8n, bsn);
                float y0[8], y1[8], vf[8], gf[8], y[8];
                unpack8(q8[0], y0); unpack8(q8[1], y1); unpack8(q8[2], vf); unpack8(q8[3], gf);
                float s = 0.f;
#pragma unroll
                for (int e = 0; e < 8; ++e) { y[e] = y0[e] + y1[e]; s += y[e]; }
                s += __shfl_xor(s, 1); s += __shfl_xor(s, 2); s += __shfl_xor(s, 4);
                const float mean = s * (1.f / 64.f); float qq = 0.f;
#pragma unroll
                for (int e = 0; e < 8; ++e) { const float dd = y[e] - mean; qq += dd * dd; }
                qq += __shfl_xor(qq, 1); qq += __shfl_xor(qq, 2); qq += __shfl_xor(qq, 4);
                const float rstd = 1.0f / sqrtf(qq * (1.f / 64.f) + 64e-5f);
                float r[8];
#pragma unroll
                for (int e = 0; e < 8; ++e) { const float yn = (y[e] - mean) * rstd * gw8[e] + gb8[e]; r[e] = (yn + bs * vf[e]) * gf[e] * sigmoidf_(gf[e]); }
                *(v4u*)(Vb + (size_t)m * RW + c0) = pack8(r);
            }
#undef P7_LOAD
        }
        if (BOTH(7)) GRID_BAR();
    }
    if (IN(8)) { PTRS
        { pg8::Gemm g{Hb, WinT + (size_t)3584 * 1024, M, 2048, 1024, 1024}; pg8::StaticOrder S; S.init(M, 2048, G, bx);
          pg8::EpiRoute E{PGT, PGT, 2048, 2048, 1 << 20};
          pg8::gemm_phase<pg8::EpiRoute, pg8::StaticOrder, true, true>(lds, g, S, E); }
        if (BOTH(8)) GRID_BAR();
    }
    if (IN(9)) { PTRS
        { pg8::Gemm g{Vb, WbrrT, M, 1024, 512, 512}; pg8::StaticOrder S; S.init(M, 1024, G, bx);
          pg8::EpiGate<0> E{MG, PGT};
          pg8::gemm_phase<pg8::EpiGate<0>, pg8::StaticOrder, true, true>(lds, g, S, E); }
        { pg8::Gemm g{PA, WbraT, M, 1024, 512, ACOLS}; pg8::StaticOrder S; S.init(M, 1024, G, bx);
          pg8::EpiGate<1> E{MG, PGT};
          pg8::gemm_phase<pg8::EpiGate<1>, pg8::StaticOrder, true, true>(lds, g, S, E); }
        if (BOTH(9)) GRID_BAR();
    }
    if (IN(10)) { PTRS
        pg8::Gemm g{MG, WoutT, M, 1024, 1024, 1024}; pg8::StaticOrder S; S.init(M, 1024, G, bx);
        pg8::EpiRoute E{OUTB, OUTB, 1024, 1024, 1 << 20};
        pg8::gemm_phase<pg8::EpiRoute, pg8::StaticOrder, true, true>(lds, g, S, E);
        if (BOTH(10)) GRID_BAR();
    }
    if (IN(11)) { PTRS
        {
            v4u oq[2], oqn[2]; f32x4 xq[4], xqn[4];
#define P11_LOAD(mm, O, X) do { _Pragma("unroll") for (int j = 0; j < 2; ++j) { O[j] = *(const v4u*)(OUTB + (size_t)(mm) * 1024 + 8 * (lane + 64 * j)); \
                X[2 * j] = *(const f32x4*)(x + (size_t)(mm) * DM + 8 * (lane + 64 * j)); X[2 * j + 1] = *(const f32x4*)(x + (size_t)(mm) * DM + 8 * (lane + 64 * j) + 4); } } while (0)
            if (gw < M) P11_LOAD(gw, oqn, xqn);
            for (int m = gw; m < M; m += NGW) {
                const int b = m >> 11;
#pragma unroll
                for (int j = 0; j < 2; ++j) { oq[j] = oqn[j]; xq[2 * j] = xqn[2 * j]; xq[2 * j + 1] = xqn[2 * j + 1]; }
                if (m + NGW < M) P11_LOAD(m + NGW, oqn, xqn);
                float o[2][8]; float s = 0.f;
#pragma unroll
                for (int j = 0; j < 2; ++j) { unpack8(oq[j], o[j]);
#pragma unroll
                    for (int e = 0; e < 8; ++e) s += o[j][e] * o[j][e]; }
                const float rinv = 1.0f / sqrtf(wave_sum(s) * (1.f / DM) + 1e-6f);
#pragma unroll
                for (int j = 0; j < 2; ++j) { const int c = 8 * (lane + 64 * j);
#pragma unroll
                    for (int hlf = 0; hlf < 2; ++hlf) { const int cc = c + 4 * hlf;
                        const f32x4 gp = *(const f32x4*)(gpost + cc), gt = *(const f32x4*)(ADA + b * 3072 + 2048 + cc);
                        f32x4 ov; ov.x = o[j][4 * hlf + 0]; ov.y = o[j][4 * hlf + 1]; ov.z = o[j][4 * hlf + 2]; ov.w = o[j][4 * hlf + 3];
                        *(f32x4*)(out + (size_t)m * DM + cc) = xq[2 * j + hlf] + gt * (ov * rinv * gp); } }
            }
#undef P11_LOAD
        }
    }
#undef IN
#undef BOTH
#undef GRID_BAR
}

extern "C" void kernel_launch(void* const* d_in, const int* in_sizes, int n_in, void* d_out, int out_size, void* d_ws, size_t ws_size, hipStream_t stream) {
    static int grid = 0;
    if (grid == 0) {
        if (n_in != NIN || in_sizes[0] != M * DM || out_size != M * DM || ws_size < WS_END) { fprintf(stderr, "kernel_launch: unexpected shapes: n_in %d in0 %d out %d ws %zu (need %zu)\n", n_in, n_in > 0 ? in_sizes[0] : -1, out_size, ws_size, (size_t)WS_END); grid = -1; return; }
        int dev = 0, cus = 0;
        if (hipGetDevice(&dev) != hipSuccess || hipDeviceGetAttribute(&cus, hipDeviceAttributeMultiprocessorCount, dev) != hipSuccess) { fprintf(stderr, "kernel_launch: device query failed\n"); grid = -1; return; }
        if (hipFuncSetAttribute((const void*)mk_fwd, hipFuncAttributeMaxDynamicSharedMemorySize, LDS_BYTES) != hipSuccess) { fprintf(stderr, "kernel_launch: hipFuncSetAttribute failed\n"); grid = -1; return; }
        (void)hipGetLastError();
        grid = cus;
        if (grid != 256) fprintf(stderr, "kernel_launch: %d CUs (built for 256)\n", grid);
    }
    if (grid < 0) return;
    if (hipMemsetAsync((char*)d_ws + WS_CTL, 0, CTL_ZERO_BYTES, stream) != hipSuccess) { fprintf(stderr, "kernel_launch: memset failed\n"); return; }
    Args a{};
    for (int i = 0; i < NIN; ++i) a.in[i] = (const float*)d_in[i];
    a.out = (float*)d_out; a.ws = (unsigned char*)d_ws;
    static const int plan[][2] = MK_PLAN;
    const int nl = (int)(sizeof(plan) / sizeof(plan[0]));
    for (int li = 0; li < nl; ++li) {
        a.ph_lo = plan[li][0]; a.ph_hi = plan[li][1]; a.li = li; a.pad = (li < nl - 1) ? MK_PROBE_FLAGS : 0;
        hipLaunchKernelGGL(mk_fwd, dim3(grid), dim3(NWAVES * 64), LDS_BYTES, stream, a);
        const hipError_t le = hipPeekAtLastError();
        if (le != hipSuccess) { fprintf(stderr, "kernel_launch: launch %d failed: %s\n", li, hipGetErrorName(le)); break; }
    }
}
```

```cpp
#include <hip/hip_runtime.h>
#include <cstdio>
#include <cstdint>
namespace pg8 {
#define PG8_LAS __attribute__((address_space(3)))
typedef unsigned short bf16_t;
typedef short bf16x8 __attribute__((ext_vector_type(8)));
typedef float f32x4 __attribute__((ext_vector_type(4)));
typedef unsigned u32x4 __attribute__((ext_vector_type(4)));
constexpr int BM = 256, BK = 64, HALF = 128, HTB = HALF * BK * 2  , STAGE_BYTES = 8 * HTB, NXCD = 8, WGM = 8;

__host__ __device__ __forceinline__ int lds_byte(int r, int c) { const int st = (r >> 4) * 2 + (c >> 5), rr = r & 15, cc = c & 31, ob = rr * 64 + cc * 2; return st * 1024 + (ob ^ (((ob >> 9) & 1) << 5)); }
__host__ __device__ __forceinline__ void stage_rc(int b, int& R, int& C) { const int st = b / 1024, sb = b % 1024, swz = sb ^ (((sb >> 9) & 1) << 5); R = (st >> 1) * 16 + swz / 64; C = (st & 1) * 32 + (swz % 64) / 2; }
__host__ __device__ __forceinline__ int perm32(int rho) { const int n = rho >> 4, i = rho & 15; return 8 * (i >> 2) + 4 * n + (i & 3); }

struct Unit { int pm, pn; };
struct Gemm { const bf16_t* A; const bf16_t* Bt; int M, N, K, lda; };

struct StaticOrder {
    int nM, nN, nwg, G, c;
    __host__ __device__ void init(int M, int N, int G_, int c_) { nM = M / BM; nN = N / BM; nwg = nM * nN; G = G_; c = c_; }
    __host__ __device__ bool next(int i, Unit& u) const {
        const long L = (long)i * G + c; if (L >= nwg) return false;
        int wgid = (int)L; { const int q = nwg / NXCD, r = nwg % NXCD, xcd = wgid % NXCD, off = wgid / NXCD; wgid = (xcd < r ? xcd * (q + 1) : r * (q + 1) + (xcd - r) * q) + off; }
        const int nig = WGM * nN, gid = wgid / nig, fm = gid * WGM, gsz = (nM - fm) < WGM ? (nM - fm) : WGM;
        u.pm = fm + ((wgid % nig) % gsz); u.pn = (wgid % nig) / gsz; return true;
    }
    __device__ __forceinline__ void a_ready(const Unit&) const {}
    __device__ __forceinline__ void done(const Unit&) const {}
};

__device__ __forceinline__ unsigned cvt_pk_bf16(float lo, float hi) { unsigned r; asm volatile("v_cvt_pk_bf16_f32 %0, %1, %2" : "=v"(r) : "v"(lo), "v"(hi)); return r; }
typedef float f32x2 __attribute__((ext_vector_type(2)));
__device__ __forceinline__ f32x2 gelu_pk(f32x2 v) {
    const f32x2 av = __builtin_elementwise_abs(v), d = av * 0.2316418882f + 1.0f;
    f32x2 t; t.x = __builtin_amdgcn_rcpf(d.x); t.y = __builtin_amdgcn_rcpf(d.y);
    f32x2 q = t * 0.5307027145f + (-0.7265760135f); q = q * t + 0.7107068705f; q = q * t + (-0.142248368f); q = q * t + 0.127414796f; q = q * t;
    const f32x2 s = (v * v) * (-0.72134752044f);
    f32x2 e; e.x = __builtin_amdgcn_exp2f(s.x); e.y = __builtin_amdgcn_exp2f(s.y);
    const f32x2 m = v * (q * e), r = v - m;
    f32x2 o; o.x = v.x < 0.f ? m.x : r.x; o.y = v.y < 0.f ? m.y : r.y; return o;
}

template <int ACT  > struct EpiBf16 {
    static constexpr bool PERM = true, AFTER_DRAIN = false; static_assert(ACT == 0 || ACT == 1, "EpiBf16: ACT is 0 (none) or 1 (gelu_pk)");
    bf16_t* O; int ldc; const float* bias; int split_cols; size_t split_stride; float scale0;
    __device__ __forceinline__ void operator()(const f32x4 (&acc)[2][2][4][2], const Unit& u, int wr, int wc, int fr, int fq) const {
        const int row0 = u.pm * BM + wr * 64 + fr; int colt = u.pn * BM; bf16_t* base = O;
        float sc = 1.f; if (split_cols) { const int t = colt / split_cols; base += (size_t)t * split_stride; colt -= t * split_cols; if (t == 0) sc = scale0; }
        const int col0 = colt + wc * 32 + 8 * fq, bcol0 = u.pn * BM + wc * 32 + 8 * fq;
        f32x4 bv[2][2];
#pragma unroll
        for (int bj = 0; bj < 2; ++bj)
#pragma unroll
            for (int n = 0; n < 2; ++n) bv[bj][n] = bias ? *(const f32x4*)(bias + bcol0 + bj * HALF + 4 * n) : (f32x4){0.f, 0.f, 0.f, 0.f};
#pragma unroll
        for (int ai = 0; ai < 2; ++ai)
#pragma unroll
            for (int m = 0; m < 4; ++m) { bf16_t* rowp = base + (size_t)(row0 + ai * HALF + m * 16) * ldc + col0;
#pragma unroll
                for (int bj = 0; bj < 2; ++bj) { f32x4 v0 = acc[ai][bj][m][0] + bv[bj][0], v1 = acc[ai][bj][m][1] + bv[bj][1];
                    if (ACT == 1) { f32x2 a = gelu_pk((f32x2){v0[0], v0[1]}), b = gelu_pk((f32x2){v0[2], v0[3]}), c = gelu_pk((f32x2){v1[0], v1[1]}), d = gelu_pk((f32x2){v1[2], v1[3]});
                        v0 = (f32x4){a.x, a.y, b.x, b.y}; v1 = (f32x4){c.x, c.y, d.x, d.y}; }
                    v0 = v0 * sc; v1 = v1 * sc; u32x4 w; w.x = cvt_pk_bf16(v0[0], v0[1]); w.y = cvt_pk_bf16(v0[2], v0[3]); w.z = cvt_pk_bf16(v1[0], v1[1]); w.w = cvt_pk_bf16(v1[2], v1[3]);
                    *(u32x4*)(rowp + bj * HALF) = w; } }
    }
};
template <class Epi, class Sched, bool ALIGN_EPI = false, bool SP2 = false>
__device__ __forceinline__ void gemm_phase(PG8_LAS unsigned char* lds, const Gemm g, const Sched& S, const Epi& E) {
    const int tid = threadIdx.x, wid = __builtin_amdgcn_readfirstlane(tid >> 6), lane = tid & 63, wr = wid >> 2, wc = wid & 3, fr = lane & 15, fq = lane >> 4;
    const int K = g.K, nt = K / BK;
    unsigned voffA[2], voffB[2];
#pragma unroll
    for (int i = 0; i < 2; ++i) { int R, C; stage_rc(tid * 16 + i * 8192, R, C); const int Rb = Epi::PERM ? ((R & ~31) + perm32(R & 31)) : R;
        voffA[i] = (unsigned)(R * g.lda + C) * 2u; voffB[i] = (unsigned)(Rb * K + C) * 2u; }
    const size_t kstep = (size_t)(BK * 2);
    const size_t hstepB = (size_t)HALF * K * 2, hstepA = (size_t)HALF * g.lda * 2;
    const size_t tstepB = 2 * hstepB, tstepA = 2 * hstepA;
    const unsigned ldsw = (unsigned)wid * 1024u;
    const int aoff = lds_byte(wr * 64 + fr, fq * 8), boff = lds_byte(wc * 32 + fr, fq * 8);
#define PG8_SA(b, h) (((b) * 2 + (h)) * HTB)
#define PG8_SB(b, h) ((4 + (b) * 2 + (h)) * HTB)
#define PG8_STAGE(bufoff, gbase, voff) do { _Pragma("unroll") for (int _i = 0; _i < 2; ++_i) \
        __builtin_amdgcn_global_load_lds((const unsigned*)((const char*)(gbase) + (voff)[_i]), (PG8_LAS unsigned*)(lds + (bufoff) + ldsw + _i * 8192), 16, 0, 0); } while (0)
#define PG8_LDA(dst, b, h) do { _Pragma("unroll") for (int m = 0; m < 4; ++m) _Pragma("unroll") for (int k = 0; k < 2; ++k) dst[m][k] = *(const PG8_LAS bf16x8*)(lds + PG8_SA(b, h) + aoff + m * 2048 + k * 1024); } while (0)
#define PG8_LDB(dst, b, h) do { _Pragma("unroll") for (int n = 0; n < 2; ++n) _Pragma("unroll") for (int k = 0; k < 2; ++k) dst[n][k] = *(const PG8_LAS bf16x8*)(lds + PG8_SB(b, h) + boff + n * 2048 + k * 1024); } while (0)
#define PG8_MMA(ai, bj, At, Bt) do { __builtin_amdgcn_s_setprio(1); _Pragma("unroll") for (int m = 0; m < 4; ++m) _Pragma("unroll") for (int n = 0; n < 2; ++n) _Pragma("unroll") for (int k = 0; k < 2; ++k) \
        acc[ai][bj][m][n] = __builtin_amdgcn_mfma_f32_16x16x32_bf16(Bt[n][k], At[m][k], acc[ai][bj][m][n], 0, 0, 0); __builtin_amdgcn_s_setprio(0); } while (0)
#define PG8_WAIT_V(n) asm volatile("s_waitcnt vmcnt(" #n ")" ::: "memory")
#define PG8_WAIT_L(n) asm volatile("s_waitcnt lgkmcnt(" #n ")" ::: "memory")
#define PG8_BAR __builtin_amdgcn_s_barrier()
#define PG8_SCHED __builtin_amdgcn_sched_barrier(0)
    Unit cur, nxt; int ui = 0;
    if (!S.next(0, cur)) return;
    f32x4 acc[2][2][4][2];
#pragma unroll
    for (int a = 0; a < 2; ++a)
#pragma unroll
        for (int b = 0; b < 2; ++b)
#pragma unroll
            for (int m = 0; m < 4; ++m)
#pragma unroll
                for (int n = 0; n < 2; ++n) acc[a][b][m][n] = (f32x4){0.f, 0.f, 0.f, 0.f};
    bf16x8 At[4][2], B0[2][2], B1[2][2];
    const char* cA = (const char*)g.A + (size_t)cur.pm * tstepA; const char* cB = (const char*)g.Bt + (size_t)cur.pn * tstepB;
    S.a_ready(cur);
    if constexpr (SP2) {
        PG8_STAGE(PG8_SB(0, 0), cB, voffB); PG8_STAGE(PG8_SB(0, 1), cB + hstepB, voffB); PG8_STAGE(PG8_SA(0, 0), cA, voffA); PG8_STAGE(PG8_SA(0, 1), cA + hstepA, voffA);
        if (wr == 1) PG8_BAR;
        PG8_WAIT_V(2); PG8_BAR;
        PG8_STAGE(PG8_SB(1, 0), cB + kstep, voffB); PG8_STAGE(PG8_SA(1, 0), cA + kstep, voffA); PG8_STAGE(PG8_SB(1, 1), cB + hstepB + kstep, voffB);
        PG8_WAIT_V(6); PG8_BAR;
    } else {
        PG8_STAGE(PG8_SB(0, 0), cB, voffB); PG8_STAGE(PG8_SA(0, 0), cA, voffA); PG8_STAGE(PG8_SB(0, 1), cB + hstepB, voffB); PG8_STAGE(PG8_SA(0, 1), cA + hstepA, voffA);
        if (wr == 1) PG8_BAR;
        PG8_WAIT_V(4); PG8_BAR;
        PG8_STAGE(PG8_SB(1, 0), cB + kstep, voffB); PG8_STAGE(PG8_SA(1, 0), cA + kstep, voffA); PG8_STAGE(PG8_SB(1, 1), cB + hstepB + kstep, voffB);
        PG8_WAIT_V(6); PG8_BAR;
    }
    for (;;) {
        const bool has_next = S.next(ui + 1, nxt);
        const char* nA = has_next ? (const char*)g.A + (size_t)nxt.pm * tstepA : cA; const char* nB = has_next ? (const char*)g.Bt + (size_t)nxt.pn * tstepB : cB;
        for (int t = 0; t < nt; t += 2) {
            const bool last = (t == nt - 2);
            const char* a1 = cA + (size_t)(t + 1) * kstep;
            const char* a2 = last ? nA : cA + (size_t)(t + 2) * kstep; const char* b2 = last ? nB : cB + (size_t)(t + 2) * kstep;
            const char* a3 = a2 + kstep; const char* b3 = b2 + kstep;
            if (last && has_next) S.a_ready(nxt);
            if constexpr (SP2) {
            PG8_LDB(B0, 0, 0); PG8_LDB(B1, 0, 1); PG8_SCHED; PG8_LDA(At, 0, 0); PG8_STAGE(PG8_SA(1, 1), a1 + hstepA, voffA);
            PG8_WAIT_V(8); PG8_WAIT_L(0); PG8_BAR; PG8_MMA(0, 0, At, B0); PG8_MMA(0, 1, At, B1); PG8_BAR; PG8_SCHED;
            PG8_LDA(At, 0, 1); PG8_STAGE(PG8_SB(0, 0), b2, voffB); PG8_STAGE(PG8_SB(0, 1), b2 + hstepB, voffB); PG8_STAGE(PG8_SA(0, 0), a2, voffA);
            PG8_WAIT_V(8); PG8_WAIT_L(0); PG8_BAR; PG8_MMA(1, 0, At, B0); PG8_MMA(1, 1, At, B1); PG8_BAR; PG8_SCHED;
            PG8_LDB(B0, 1, 0); PG8_LDB(B1, 1, 1); PG8_SCHED; PG8_LDA(At, 1, 0); PG8_STAGE(PG8_SA(0, 1), a2 + hstepA, voffA);
            PG8_WAIT_V(8); PG8_WAIT_L(0); PG8_BAR; PG8_MMA(0, 0, At, B0); PG8_MMA(0, 1, At, B1); PG8_BAR; PG8_SCHED;
            PG8_LDA(At, 1, 1); PG8_STAGE(PG8_SB(1, 0), b3, voffB); PG8_STAGE(PG8_SB(1, 1), b3 + hstepB, voffB); PG8_STAGE(PG8_SA(1, 0), a3, voffA);
            PG8_WAIT_V(8); PG8_WAIT_L(0); PG8_BAR; PG8_MMA(1, 0, At, B0); PG8_MMA(1, 1, At, B1); PG8_BAR; PG8_SCHED;
            } else {
            PG8_LDB(B0, 0, 0); PG8_SCHED; PG8_LDA(At, 0, 0); PG8_STAGE(PG8_SA(1, 1), a1 + hstepA, voffA);
            PG8_WAIT_L(8); PG8_BAR; PG8_WAIT_L(0); PG8_MMA(0, 0, At, B0); PG8_BAR; PG8_SCHED;
            PG8_LDB(B1, 0, 1); PG8_STAGE(PG8_SB(0, 0), b2, voffB);
            PG8_BAR; PG8_WAIT_L(0); PG8_MMA(0, 1, At, B1); PG8_BAR;
            PG8_LDA(At, 0, 1); PG8_STAGE(PG8_SA(0, 0), a2, voffA);
            PG8_BAR; PG8_WAIT_L(0); PG8_MMA(1, 0, At, B0); PG8_BAR; PG8_SCHED;
            PG8_STAGE(PG8_SB(0, 1), b2 + hstepB, voffB);
            PG8_WAIT_V(6); PG8_BAR; PG8_MMA(1, 1, At, B1); PG8_BAR;
            PG8_LDB(B0, 1, 0); PG8_SCHED; PG8_LDA(At, 1, 0); PG8_STAGE(PG8_SA(0, 1), a2 + hstepA, voffA);
            PG8_WAIT_L(8); PG8_BAR; PG8_WAIT_L(0); PG8_MMA(0, 0, At, B0); PG8_BAR; PG8_SCHED;
            PG8_LDB(B1, 1, 1); PG8_STAGE(PG8_SB(1, 0), b3, voffB);
            PG8_BAR; PG8_WAIT_L(0); PG8_MMA(0, 1, At, B1); PG8_BAR;
            PG8_LDA(At, 1, 1); PG8_STAGE(PG8_SA(1, 0), a3, voffA);
            PG8_BAR; PG8_WAIT_L(0); PG8_MMA(1, 0, At, B0); PG8_BAR; PG8_SCHED;
            PG8_STAGE(PG8_SB(1, 1), b3 + hstepB, voffB);
            PG8_WAIT_V(6); PG8_BAR; PG8_MMA(1, 1, At, B1); PG8_BAR;
            }
        }
        if constexpr (ALIGN_EPI) { if (wr == 0) PG8_BAR; }
        if constexpr (!Epi::AFTER_DRAIN) { E(acc, cur, wr, wc, fr, fq); S.done(cur); }
        if (!has_next) break;
#pragma unroll
        for (int a = 0; a < 2; ++a)
#pragma unroll
            for (int b = 0; b < 2; ++b)
#pragma unroll
                for (int m = 0; m < 4; ++m)
#pragma unroll
                    for (int n = 0; n < 2; ++n) acc[a][b][m][n] = (f32x4){0.f, 0.f, 0.f, 0.f};
        cur = nxt; cA = nA; cB = nB; ++ui;
        if constexpr (ALIGN_EPI) { if (wr == 1) PG8_BAR; }
    }
    PG8_WAIT_V(0);
    if constexpr (!ALIGN_EPI) { if (wr == 0) PG8_BAR; }
    PG8_BAR;
    if constexpr (Epi::AFTER_DRAIN) { E.fused(acc, cur, wr, wc, fr, fq, lds, wid, lane); S.done(cur); }
#undef PG8_SA
#undef PG8_SB
#undef PG8_STAGE
#undef PG8_LDA
#undef PG8_LDB
#undef PG8_MMA
#undef PG8_WAIT_V
#undef PG8_WAIT_L
#undef PG8_BAR
#undef PG8_SCHED
}
}
namespace pg8 {
struct EpiRoute {
    static constexpr bool PERM = true, AFTER_DRAIN = false;
    bf16_t* base0; bf16_t* base1; int ldc0, ldc1, tile1;
    __device__ __forceinline__ void operator()(const f32x4 (&acc)[2][2][4][2], const Unit& u, int wr, int wc, int fr, int fq) const {
        const bool second = u.pn >= tile1;
        bf16_t* O = second ? base1 : base0; const int ld = second ? ldc1 : ldc0; const int colt = (second ? u.pn - tile1 : u.pn) * BM;
        const int row0 = u.pm * BM + wr * 64 + fr;
        const int col0 = colt + wc * 32 + 8 * fq;
#pragma unroll
        for (int ai = 0; ai < 2; ++ai)
#pragma unroll
            for (int m = 0; m < 4; ++m) { bf16_t* rowp = O + (size_t)(row0 + ai * HALF + m * 16) * ld + col0;
#pragma unroll
                for (int bj = 0; bj < 2; ++bj) { const f32x4 v0 = acc[ai][bj][m][0], v1 = acc[ai][bj][m][1];
                    u32x4 w; w.x = cvt_pk_bf16(v0[0], v0[1]); w.y = cvt_pk_bf16(v0[2], v0[3]); w.z = cvt_pk_bf16(v1[0], v1[1]); w.w = cvt_pk_bf16(v1[2], v1[3]);
                    *(u32x4*)(rowp + bj * HALF) = w; } }
    }
};
}
namespace pg8 {
__device__ __forceinline__ float sigm(float x) { return __builtin_amdgcn_rcpf(1.0f + __expf(-x)); }
struct EpiLora {
    static constexpr bool PERM = true, AFTER_DRAIN = false;
    bf16_t* O; const float* w0; const float* a0;
    __device__ __forceinline__ void operator()(const f32x4 (&acc)[2][2][4][2], const Unit& u, int wr, int wc, int fr, int fq) const {
        const int row0 = u.pm * BM + wr * 64 + fr, col0 = u.pn * BM + wc * 32 + 8 * fq;
        const float* par = (u.pn >= 4) ? (a0 - 1024) : w0;
#pragma unroll
        for (int ai = 0; ai < 2; ++ai)
#pragma unroll
            for (int m = 0; m < 4; ++m) {
#pragma unroll
                for (int bj = 0; bj < 2; ++bj) { bf16_t* rowp = O + (size_t)(row0 + ai * HALF + m * 16) * 2048 + col0 + bj * HALF;
                    const f32x4 x0 = acc[ai][bj][m][0] + *(const f32x4*)(par + col0 + bj * HALF), x1 = acc[ai][bj][m][1] + *(const f32x4*)(par + col0 + bj * HALF + 4); u32x4 w;
                    w.x = cvt_pk_bf16(sigm(x0[0]), sigm(x0[1])); w.y = cvt_pk_bf16(sigm(x0[2]), sigm(x0[3])); w.z = cvt_pk_bf16(sigm(x1[0]), sigm(x1[1])); w.w = cvt_pk_bf16(sigm(x1[2]), sigm(x1[3]));
                    *(u32x4*)rowp = w; }
                asm volatile("" ::: "memory"); }
    }
};
template <int MODE> struct EpiGate {
    static constexpr bool PERM = true, AFTER_DRAIN = false;
    bf16_t* O; const bf16_t* Gl;
    __device__ __forceinline__ void operator()(const f32x4 (&acc)[2][2][4][2], const Unit& u, int wr, int wc, int fr, int fq) const {
        const int row0 = u.pm * BM + wr * 64 + fr, col0 = u.pn * BM + wc * 32 + 8 * fq;
#pragma unroll
        for (int ai = 0; ai < 2; ++ai) {
            u32x4 gq[4][2], tq[4][2];
#pragma unroll
            for (int m = 0; m < 4; ++m)
#pragma unroll
                for (int bj = 0; bj < 2; ++bj) { const size_t row = (size_t)(row0 + ai * HALF + m * 16); const int col = col0 + bj * HALF;
                    gq[m][bj] = *(const u32x4*)(Gl + row * 2048 + MODE * 1024 + col);
                    if (MODE == 1) tq[m][bj] = *(const u32x4*)(O + row * 1024 + col); }
#pragma unroll
            for (int m = 0; m < 4; ++m)
#pragma unroll
                for (int bj = 0; bj < 2; ++bj) { const size_t row = (size_t)(row0 + ai * HALF + m * 16); const int col = col0 + bj * HALF;
                    const unsigned gw[4] = {gq[m][bj].x, gq[m][bj].y, gq[m][bj].z, gq[m][bj].w}; float g[8];
#pragma unroll
                    for (int e = 0; e < 4; ++e) { g[2 * e] = sigm(__builtin_bit_cast(float, gw[e] << 16)); g[2 * e + 1] = sigm(__builtin_bit_cast(float, gw[e] & 0xffff0000u)); }
                    const f32x4 v0 = acc[ai][bj][m][0], v1 = acc[ai][bj][m][1];
                    float r[8] = {g[0] * v0[0], g[1] * v0[1], g[2] * v0[2], g[3] * v0[3], g[4] * v1[0], g[5] * v1[1], g[6] * v1[2], g[7] * v1[3]};
                    if (MODE == 1) { const unsigned tw[4] = {tq[m][bj].x, tq[m][bj].y, tq[m][bj].z, tq[m][bj].w};
#pragma unroll
                        for (int e = 0; e < 4; ++e) { r[2 * e] += __builtin_bit_cast(float, tw[e] << 16); r[2 * e + 1] += __builtin_bit_cast(float, tw[e] & 0xffff0000u); } }
                    u32x4 w; w.x = cvt_pk_bf16(r[0], r[1]); w.y = cvt_pk_bf16(r[2], r[3]); w.z = cvt_pk_bf16(r[4], r[5]); w.w = cvt_pk_bf16(r[6], r[7]);
                    *(u32x4*)(O + row * 1024 + col) = w; }
        }
    }
};
}
namespace pg8 {
struct EpiGateCat {
    static constexpr bool PERM = true, AFTER_DRAIN = false;
    bf16_t* O; const bf16_t* Gl;
    __device__ __forceinline__ void mid(f32x4 (&acc)[2][2][4][2], const Unit& u, int wr, int wc, int fr, int fq) const {
        const int row0 = u.pm * BM + wr * 64 + fr, col0 = u.pn * BM + wc * 32 + 8 * fq;
#pragma unroll
        for (int ai = 0; ai < 2; ++ai) {
            u32x4 gr[4][2], ga[4][2];
#pragma unroll
            for (int m = 0; m < 4; ++m)
#pragma unroll
                for (int bj = 0; bj < 2; ++bj) { const size_t row = (size_t)(row0 + ai * HALF + m * 16); const int col = col0 + bj * HALF;
                    gr[m][bj] = *(const u32x4*)(Gl + row * 2048 + col); ga[m][bj] = *(const u32x4*)(Gl + row * 2048 + 1024 + col); }
#pragma unroll
            for (int m = 0; m < 4; ++m)
#pragma unroll
                for (int bj = 0; bj < 2; ++bj) { const unsigned wr_[4] = {gr[m][bj].x, gr[m][bj].y, gr[m][bj].z, gr[m][bj].w}, wa_[4] = {ga[m][bj].x, ga[m][bj].y, ga[m][bj].z, ga[m][bj].w}; float rt[8];
#pragma unroll
                    for (int e = 0; e < 4; ++e) {
                        const float r0 = __builtin_bit_cast(float, wr_[e] << 16), r1 = __builtin_bit_cast(float, wr_[e] & 0xffff0000u), a0 = __builtin_bit_cast(float, wa_[e] << 16), a1 = __builtin_bit_cast(float, wa_[e] & 0xffff0000u);
                        rt[2 * e] = (1.0f + __expf(-a0)) * __builtin_amdgcn_rcpf(1.0f + __expf(-r0)); rt[2 * e + 1] = (1.0f + __expf(-a1)) * __builtin_amdgcn_rcpf(1.0f + __expf(-r1)); }
                    acc[ai][bj][m][0] = acc[ai][bj][m][0] * (f32x4){rt[0], rt[1], rt[2], rt[3]}; acc[ai][bj][m][1] = acc[ai][bj][m][1] * (f32x4){rt[4], rt[5], rt[6], rt[7]}; }
        }
    }
    __device__ __forceinline__ void operator()(const f32x4 (&acc)[2][2][4][2], const Unit& u, int wr, int wc, int fr, int fq) const {
        const int row0 = u.pm * BM + wr * 64 + fr, col0 = u.pn * BM + wc * 32 + 8 * fq;
#pragma unroll
        for (int ai = 0; ai < 2; ++ai) {
            u32x4 ga[4][2];
#pragma unroll
            for (int m = 0; m < 4; ++m)
#pragma unroll
                for (int bj = 0; bj < 2; ++bj) { const size_t row = (size_t)(row0 + ai * HALF + m * 16); const int col = col0 + bj * HALF; ga[m][bj] = *(const u32x4*)(Gl + row * 2048 + 1024 + col); }
#pragma unroll
            for (int m = 0; m < 4; ++m)
#pragma unroll
                for (int bj = 0; bj < 2; ++bj) { const size_t row = (size_t)(row0 + ai * HALF + m * 16); const int col = col0 + bj * HALF;
                    const unsigned wa_[4] = {ga[m][bj].x, ga[m][bj].y, ga[m][bj].z, ga[m][bj].w}; float g[8];
#pragma unroll
                    for (int e = 0; e < 4; ++e) { g[2 * e] = sigm(__builtin_bit_cast(float, wa_[e] << 16)); g[2 * e + 1] = sigm(__builtin_bit_cast(float, wa_[e] & 0xffff0000u)); }
                    const f32x4 v0 = acc[ai][bj][m][0], v1 = acc[ai][bj][m][1];
                    u32x4 w; w.x = cvt_pk_bf16(g[0] * v0[0], g[1] * v0[1]); w.y = cvt_pk_bf16(g[2] * v0[2], g[3] * v0[3]); w.z = cvt_pk_bf16(g[4] * v1[0], g[5] * v1[1]); w.w = cvt_pk_bf16(g[6] * v1[2], g[7] * v1[3]);
                    *(u32x4*)(O + row * 1024 + col) = w; }
        }
    }
};
}
namespace pg8 {
template <int CTRL> __device__ __forceinline__ float dppz(float v) { return __builtin_bit_cast(float, __builtin_amdgcn_update_dpp(0, __builtin_bit_cast(int, v), CTRL, 0xf, 0xf, true)); }
struct EpiShift {
    static constexpr bool PERM = true, AFTER_DRAIN = false;
    bf16_t* R4;
    bf16_t* LAo;
    bf16_t* PAo;
    bf16_t* EDGE;
    const float* mu;
    PG8_LAS unsigned char* halo;
    int Mrows;
    __device__ __forceinline__ static int hidx(int wr, int wc, int ai, int edge, int bj, int n, int fq) { return ((((((wr * 4 + wc) * 2 + ai) * 2 + edge) * 2 + bj) * 2 + n) * 4 + fq) * 16; }
    __device__ __forceinline__ void operator()(const f32x4 (&acc)[2][2][4][2], const Unit& u, int wr, int wc, int fr, int fq) const {
        const int row0 = u.pm * BM + wr * 64 + fr, colL = wc * 32 + 8 * fq;
        if (u.pn >= 9) {
            const int col0 = (u.pn - 9) * BM + colL;
#pragma unroll
            for (int ai = 0; ai < 2; ++ai)
#pragma unroll
                for (int m = 0; m < 4; ++m) { bf16_t* rowp = PAo + (size_t)(row0 + ai * HALF + m * 16) * 1280 + col0;
#pragma unroll
                    for (int bj = 0; bj < 2; ++bj) { const f32x4 v0 = acc[ai][bj][m][0], v1 = acc[ai][bj][m][1];
                        u32x4 w; w.x = cvt_pk_bf16(v0[0], v0[1]); w.y = cvt_pk_bf16(v0[2], v0[3]); w.z = cvt_pk_bf16(v1[0], v1[1]); w.w = cvt_pk_bf16(v1[2], v1[3]);
                        *(u32x4*)(rowp + bj * HALF) = w; } }
            return;
        }
        if (fr == 0 || fr == 15) { const int edge = fr == 15, mm = edge ? 3 : 0;
#pragma unroll
            for (int ai = 0; ai < 2; ++ai)
#pragma unroll
                for (int bj = 0; bj < 2; ++bj)
#pragma unroll
                    for (int n = 0; n < 2; ++n) *(PG8_LAS f32x4*)(halo + hidx(wr, wc, ai, edge, bj, n, fq)) = edge ? acc[ai][bj][3][n] : acc[ai][bj][0][n];
            (void)mm; }
        if ((wr == 0 && fr < 2) || (wr == 1 && fr >= 14)) { const int slot = wr == 0 ? fr : fr - 12;
            bf16_t* ep = EDGE + ((size_t)u.pm * 4 + slot) * 2304 + u.pn * BM + colL;
#pragma unroll
            for (int bj = 0; bj < 2; ++bj) { const f32x4 v0 = wr == 0 ? acc[0][bj][0][0] : acc[1][bj][3][0], v1 = wr == 0 ? acc[0][bj][0][1] : acc[1][bj][3][1];
                u32x4 w; w.x = cvt_pk_bf16(v0[0], v0[1]); w.y = cvt_pk_bf16(v0[2], v0[3]); w.z = cvt_pk_bf16(v1[0], v1[1]); w.w = cvt_pk_bf16(v1[2], v1[3]);
                *(u32x4*)(ep + bj * HALF) = w; } }
        asm volatile("s_waitcnt lgkmcnt(0)" ::: "memory");
        __builtin_amdgcn_s_barrier();
        asm volatile("" ::: "memory");
        const bool isla = u.pn == 8;
        bf16_t* obase = isla ? LAo : R4 + (size_t)(u.pn >> 1) * Mrows * 512 + (u.pn & 1) * 256;
        const int ld = isla ? 256 : 512;
#pragma unroll
        for (int bj = 0; bj < 2; ++bj) {
            const float* mup = mu + u.pn * BM + bj * HALF + colL;
            f32x4 m0[2], m1[2], c0[2];
#pragma unroll
            for (int n = 0; n < 2; ++n) { m0[n] = *(const f32x4*)(mup + 4 * n); m1[n] = *(const f32x4*)(mup + 2304 + 4 * n); c0[n] = 1.0f - m0[n] - m1[n]; }
#pragma unroll
            for (int ai = 0; ai < 2; ++ai) {
                f32x4 hp[2], hn[2];
                const bool hasp = (wr == 1) || (ai == 1), hasn = (wr == 0) || (ai == 0);
                const int pw = wr ^ 1, pai = (wr == 1) ? ai : 0, nai = (wr == 0) ? ai : 1;
#pragma unroll
                for (int n = 0; n < 2; ++n) { hp[n] = hasp ? *(const PG8_LAS f32x4*)(halo + hidx(pw, wc, pai, 1, bj, n, fq)) : (f32x4){0.f, 0.f, 0.f, 0.f};
                                              hn[n] = hasn ? *(const PG8_LAS f32x4*)(halo + hidx(pw, wc, nai, 0, bj, n, fq)) : (f32x4){0.f, 0.f, 0.f, 0.f}; }
                unsigned wq[4][4];
#pragma unroll
                for (int n = 0; n < 2; ++n) {
                    f32x4 A[4], B[4];
#pragma unroll
                    for (int m = 0; m < 4; ++m) { A[m] = acc[ai][bj][m][n] * m0[n]; B[m] = acc[ai][bj][m][n] * m1[n]; }
                    const f32x4 Ah = hp[n] * m0[n], Bh = hn[n] * m1[n];
#pragma unroll
                    for (int m = 0; m < 4; ++m) { const f32x4 p = acc[ai][bj][m][n], Am = m > 0 ? A[m > 0 ? m - 1 : 0] : Ah, Bp = m < 3 ? B[m < 3 ? m + 1 : 3] : Bh; float o[4];
#pragma unroll
                        for (int k = 0; k < 4; ++k) { float v = c0[n][k] * p[k];
                            v += dppz<0x111>(A[m][k]); v += dppz<0x10F>(Am[k]);
                            v += dppz<0x101>(B[m][k]); v += dppz<0x11F>(Bp[k]);
                            o[k] = v; }
                        if (isla && bj == 0) {
#pragma unroll
                            for (int e = 0; e < 4; ++e) o[e] = 1.0f - 2.0f * __builtin_amdgcn_rcpf(1.0f + __expf(2.0f * o[e])); }
                        wq[m][2 * n] = cvt_pk_bf16(o[0], o[1]); wq[m][2 * n + 1] = cvt_pk_bf16(o[2], o[3]); }
                }
#pragma unroll
                for (int m = 0; m < 4; ++m) { u32x4 w; w.x = wq[m][0]; w.y = wq[m][1]; w.z = wq[m][2]; w.w = wq[m][3];
                    *(u32x4*)(obase + (size_t)(row0 + ai * HALF + m * 16) * ld + bj * HALF + colL) = w; }
            }
        }
    }
};
}
#define GAS __attribute__((address_space(1)))
#define LAS __attribute__((address_space(3)))
typedef unsigned short bf16;
typedef unsigned v4u __attribute__((ext_vector_type(4)));
typedef float f32x4 __attribute__((ext_vector_type(4)));
typedef short bf16x8 __attribute__((ext_vector_type(8)));
typedef GAS unsigned gu32;
typedef GAS unsigned long long gu64;
#define RLX_AGENT __ATOMIC_RELAXED, __HIP_MEMORY_SCOPE_AGENT
#define LDS_WAIT() asm volatile("s_waitcnt lgkmcnt(0)" ::: "memory")
#define VM_WAIT() asm volatile("s_waitcnt vmcnt(0)" ::: "memory")
__device__ __forceinline__ unsigned long long rt() { return __builtin_amdgcn_s_memrealtime(); }
__device__ __forceinline__ unsigned f2bf(float f) { unsigned u = __builtin_bit_cast(unsigned, f); return (u + 0x7fffu + ((u >> 16) & 1u)) >> 16; }
__device__ __forceinline__ unsigned pk2(float lo, float hi) { return f2bf(lo) | (f2bf(hi) << 16); }
#define XB_TMO      128
#define XB_XCNT(j)  (256  + 64 * (j))
#define XB_XSUB(j)  (1280 + 64 * (j))
#define XB_XGEN(j)  (2304 + 64 * (j))
#define XB_TOP      3328
#define XB_TOPGEN   3392
#define XCD_BAR_WORDS 3456
#define XB_SPIN_CAP (1u << 18)

__device__ __forceinline__ unsigned xb_ld(unsigned* p)              { return __hip_atomic_load(p, __ATOMIC_RELAXED, __HIP_MEMORY_SCOPE_AGENT); }
__device__ __forceinline__ unsigned xb_add(unsigned* p, unsigned v) { return __hip_atomic_fetch_add(p, v, __ATOMIC_RELAXED, __HIP_MEMORY_SCOPE_AGENT); }
__device__ __forceinline__ unsigned xb_xcc_id() { return (unsigned)__builtin_amdgcn_s_getreg((3 << 11) | 20) & 0xFu; }
#define XB_SPIN(cond, bar) do { unsigned _sp = 0; while (cond) { __builtin_amdgcn_s_sleep(1); \
    if ((++_sp & 255u) == 0u) { if (xb_ld(&(bar)[XB_TMO])) break; if (_sp > XB_SPIN_CAP) { atomicAdd(&(bar)[XB_TMO], 1u); break; } } } } while (0)

struct XcdBarrier {
    unsigned* bar; unsigned x;
    volatile LAS unsigned* st;
};

__device__ __forceinline__ XcdBarrier xcd_barrier_post(unsigned* bar, volatile LAS unsigned* st) {
    XcdBarrier b; b.bar = bar; b.x = xb_xcc_id(); b.st = st;
    if (threadIdx.x == 0) (void)xb_add(&bar[XB_XCNT(b.x)], 1u);
    return b;
}
__device__ __forceinline__ void xcd_barrier_complete(unsigned* bar, unsigned x, unsigned& nloc, unsigned& nx) {
    const unsigned G = gridDim.x * gridDim.y * gridDim.z;
    unsigned sum, cnt, mine, sp = 0u;
    for (;;) {
        sum = 0u; cnt = 0u; mine = 0u;
#pragma unroll
        for (unsigned j = 0; j < 16; ++j) { const unsigned c = xb_ld(&bar[XB_XCNT(j)]); sum += c; cnt += (c > 0u) ? 1u : 0u; mine = (j == x) ? c : mine; }
        if (sum == G) break;
        __builtin_amdgcn_s_sleep(1);
        if ((++sp & 255u) == 0u) { if (xb_ld(&bar[XB_TMO])) break; if (sp > XB_SPIN_CAP) { atomicAdd(&bar[XB_TMO], 1u); break; } }
    }
    nloc = mine > 0u ? mine : 1u; nx = cnt > 0u ? cnt : 1u;
}

__device__ __forceinline__ void xcd_barrier(const XcdBarrier& b) {
    asm volatile("s_waitcnt vmcnt(0)" ::: "memory");
    __syncthreads();
    if (threadIdx.x == 0) {
        unsigned* bar = b.bar;
        __builtin_amdgcn_s_waitcnt(0);
        unsigned nloc = b.st[0], nx = b.st[1];
        if (nloc == 0u) { xcd_barrier_complete(bar, b.x, nloc, nx); b.st[0] = nloc; b.st[1] = nx; }
        const unsigned old = xb_add(&bar[XB_XSUB(b.x)], 1u);
        const unsigned gen = old / nloc;
        if (old + 1u == (gen + 1u) * nloc) {
            __builtin_amdgcn_fence(__ATOMIC_RELEASE, "agent");
            asm volatile("s_waitcnt vmcnt(0)" ::: "memory");
            const unsigned og = xb_add(&bar[XB_TOP], 1u);
            const unsigned tg = og / nx;
            if (og + 1u == (tg + 1u) * nx) xb_add(&bar[XB_TOPGEN], 1u);
            else XB_SPIN(xb_ld(&bar[XB_TOPGEN]) == tg, bar);
            __builtin_amdgcn_fence(__ATOMIC_ACQUIRE, "agent");
            xb_add(&bar[XB_XGEN(b.x)], 1u);
            asm volatile("s_waitcnt vmcnt(0)" ::: "memory");
        } else {
            XB_SPIN(xb_ld(&bar[XB_XGEN(b.x)]) == gen, bar);
            __builtin_amdgcn_fence(__ATOMIC_ACQUIRE, "agent");
            asm volatile("s_waitcnt vmcnt(0)" ::: "memory");
        }
    }
    __syncthreads();
}
constexpr int NWAVES = 8;
constexpr int BATCH = 32, SEQ = 2048, DM = 1024, M = BATCH * SEQ;
constexpr int RW = 512, RCOLS = 2304, ACOLS = 1280, GCOLS = 2048;
enum { I_X = 0, I_C, I_WADA, I_BADA, I_GPRE, I_GPOST, I_WIN, I_MU, I_W0, I_WUP, I_A0, I_AUP, I_KK, I_KA, I_RK, I_GNW, I_GNB, I_SINK, I_WBRR, I_WBRA, I_WOUT, NIN };
#ifndef MK_N_LAUNCHES
#define MK_N_LAUNCHES 1
#endif
constexpr int N_PHASES = 12;
#ifndef MK_PLAN
#define MK_PLAN {{0, N_PHASES}}
#endif
#ifndef MK_PROBE_FLAGS
#define MK_PROBE_FLAGS 0
#endif
constexpr int N_LAUNCHES = MK_N_LAUNCHES;
constexpr size_t MiB = 1u << 20;
constexpr size_t WS_CTL = 0, CTL_ZERO_BYTES = 1 * MiB;
constexpr size_t WS_ADA = 512 * 1024;
constexpr size_t WS_BSUM = 2 * MiB;
constexpr size_t WS_BP4 = 984 * MiB;
constexpr size_t WS_WINT = 4 * MiB;
constexpr size_t WS_WBRR = 15 * MiB, WS_WBRA = 16 * MiB, WS_WOUT = 17 * MiB, WS_WLORA = 19 * MiB;
constexpr size_t WS_H = 24 * MiB;
constexpr size_t WS_PA = 152 * MiB;
constexpr size_t WS_PR = 312 * MiB;
constexpr size_t WS_KD1 = 568 * MiB;
constexpr size_t WS_LA = 600 * MiB;
constexpr size_t WS_R = 632 * MiB, WS_K = 696 * MiB, WS_V = 760 * MiB, WS_G = 824 * MiB, WS_KK = 888 * MiB;
constexpr size_t WS_MG = 568 * MiB;
constexpr size_t WS_PG = 312 * MiB;
constexpr size_t WS_BR = 568 * MiB;
constexpr size_t WS_BA = 824 * MiB;
constexpr size_t WS_KB = 952 * MiB, WS_VB = 968 * MiB;
constexpr size_t WS_EDGE = 992 * MiB;
constexpr size_t WS_END = 1024 * MiB;
constexpr int CW_BAR = 4096;
constexpr int RING_BYTES = 155648, LDSCTL_OFF = RING_BYTES, MISC_OFF = LDSCTL_OFF + 320, LDS_BYTES = 163840;

__device__ __forceinline__ float bflo(unsigned w) { return __builtin_bit_cast(float, w << 16); }
__device__ __forceinline__ float bfhi(unsigned w) { return __builtin_bit_cast(float, w & 0xffff0000u); }
__device__ __forceinline__ float bf2f(bf16 u) { return __builtin_bit_cast(float, (unsigned)u << 16); }
__device__ __forceinline__ void unpack8(const v4u q, float* f) { f[0] = bflo(q.x); f[1] = bfhi(q.x); f[2] = bflo(q.y); f[3] = bfhi(q.y); f[4] = bflo(q.z); f[5] = bfhi(q.z); f[6] = bflo(q.w); f[7] = bfhi(q.w); }
__device__ __forceinline__ unsigned cvtpk_c(float lo, float hi);
__device__ __forceinline__ v4u pack8(const float* f) { v4u o; o.x = cvtpk_c(f[0], f[1]); o.y = cvtpk_c(f[2], f[3]); o.z = cvtpk_c(f[4], f[5]); o.w = cvtpk_c(f[6], f[7]); return o; }
__device__ __forceinline__ float sigmoidf_(float x) { return __builtin_amdgcn_rcpf(1.0f + __expf(-x)); }
__device__ __forceinline__ float wave_sum(float v) {
#pragma unroll
    for (int o = 1; o < 64; o <<= 1) v += __shfl_xor(v, o);
    return v;
}
__device__ __forceinline__ void transpose_item(const float* W, int K, int N, bf16* WT, int ldwt, int row_off, int kcol_off, LAS float* scr, int item, int lane) {
    const int nblk = N / 32, kb = item / nblk, nb = item % nblk, k0 = 64 * kb, n0 = 32 * nb;
#pragma unroll 8
    for (int i = 0; i < 32; ++i) { const int kk = 2 * i + (lane >> 5); scr[kk * 33 + (lane & 31)] = W[(size_t)(k0 + kk) * N + n0 + (lane & 31)]; }
    LDS_WAIT(); asm volatile("" ::: "memory");
    const int c = lane & 7;
#pragma unroll
    for (int j = 0; j < 4; ++j) { const int n = (lane >> 3) + 8 * j; const LAS float* s = scr + (8 * c) * 33 + n;
        v4u o; o.x = pk2(s[0 * 33], s[1 * 33]); o.y = pk2(s[2 * 33], s[3 * 33]); o.z = pk2(s[4 * 33], s[5 * 33]); o.w = pk2(s[6 * 33], s[7 * 33]);
        *(GAS v4u*)(WT + (size_t)(row_off + n0 + n) * ldwt + kcol_off + k0 + 8 * c) = o; }
    LDS_WAIT(); asm volatile("" ::: "memory");
}

typedef unsigned u32x2_t __attribute__((ext_vector_type(2)));
typedef float f32x2_c __attribute__((ext_vector_type(2))); typedef __bf16 bf16x2_c __attribute__((ext_vector_type(2)));
__device__ __forceinline__ unsigned cvtpk_c(float lo, float hi) { const f32x2_c v = {lo, hi}; const bf16x2_c b = __builtin_convertvector(v, bf16x2_c); return __builtin_bit_cast(unsigned, b); }
__device__ __forceinline__ bf16x8 ldsfrag_perm(const LAS unsigned char* p) { const u32x2_t a = *(const LAS u32x2_t*)p, b = *(const LAS u32x2_t*)(p + 16); return __builtin_bit_cast(bf16x8, (v4u){a.x, a.y, b.x, b.y}); }
template <int CTRL> __device__ __forceinline__ float dppf(float v) { return __builtin_bit_cast(float, __builtin_amdgcn_update_dpp(0, __builtin_bit_cast(int, v), CTRL, 0xf, 0xf, true)); }
struct Args { const float* in[NIN]; float* out; unsigned char* ws; int ph_lo, ph_hi, li, pad; };

#define PTRS const int G = gridDim.x, bx = blockIdx.x; const int vcu = (G % 8 == 0) ? (bx % 8) * (G / 8) + bx / 8 : bx; const int gw = vcu * NWAVES + wave, NGW = G * NWAVES; (void)gw; (void)NGW; const float* x = args.in[I_X]; const float* cin = args.in[I_C]; const float* wada = args.in[I_WADA]; const float* bada = args.in[I_BADA]; const float* gpre = args.in[I_GPRE]; const float* gpost = args.in[I_GPOST]; const float* win = args.in[I_WIN]; const float* mu = args.in[I_MU]; const float* w0 = args.in[I_W0]; const float* wup = args.in[I_WUP]; const float* a0 = args.in[I_A0]; const float* aup = args.in[I_AUP]; const float* k_k = args.in[I_KK]; const float* k_a = args.in[I_KA]; const float* r_k = args.in[I_RK]; const float* gnw = args.in[I_GNW]; const float* gnb = args.in[I_GNB]; const float* sink = args.in[I_SINK]; const float* wbrr = args.in[I_WBRR]; const float* wbra = args.in[I_WBRA]; const float* wout = args.in[I_WOUT]; float* out = args.out; float* ADA = (float*)(ws + WS_ADA); float* BSUM = (float*)(ws + WS_BSUM); float* BP4 = (float*)(ws + WS_BP4); (void)BSUM; bf16* WinT = (bf16*)(ws + WS_WINT); bf16* WbrrT = (bf16*)(ws + WS_WBRR); bf16* WbraT = (bf16*)(ws + WS_WBRA); bf16* WoutT = (bf16*)(ws + WS_WOUT); bf16* WloraT = (bf16*)(ws + WS_WLORA); bf16* Hb = (bf16*)(ws + WS_H); bf16* MG = (bf16*)(ws + WS_MG); bf16* PA = (bf16*)(ws + WS_PA); bf16* PR = (bf16*)(ws + WS_PR); bf16* RAW = (bf16*)(ws + WS_PR); bf16* PGT = (bf16*)(ws + WS_PG); bf16* OUTB = (bf16*)(ws + WS_PR); bf16* KD1 = (bf16*)(ws + WS_KD1); bf16* LA = (bf16*)(ws + WS_LA); bf16* Rb = (bf16*)(ws + WS_R); bf16* Kb = (bf16*)(ws + WS_K); bf16* Vb = (bf16*)(ws + WS_V); bf16* Gb = (bf16*)(ws + WS_G); bf16* KKb = (bf16*)(ws + WS_KK); bf16* KB = (bf16*)(ws + WS_KB); bf16* VB = (bf16*)(ws + WS_VB); bf16* EDGE = (bf16*)(ws + WS_EDGE); bf16* BR = (bf16*)(ws + WS_BR); bf16* BA = (bf16*)(ws + WS_BA);
__global__ void __launch_bounds__(NWAVES * 64, 2) mk_fwd(Args args) {
    extern __shared__ __attribute__((aligned(16))) unsigned char lds_raw[];
    LAS unsigned char* lds = (LAS unsigned char*)lds_raw;
    volatile LAS unsigned* MISC = (volatile LAS unsigned*)(lds + MISC_OFF);
    const int tid = threadIdx.x, lane = tid & 63, wave = __builtin_amdgcn_readfirstlane(tid >> 6);
    unsigned char* ws = args.ws;
    gu32* ctl = (gu32*)(ws + WS_CTL);
    for (int u = tid; u < (LDS_BYTES - LDSCTL_OFF) / 4; u += NWAVES * 64) ((LAS unsigned*)(lds + LDSCTL_OFF))[u] = 0u;
    __syncthreads();
    XcdBarrier bar; bar.bar = (unsigned*)(ctl + CW_BAR); bar.x = 0; bar.st = nullptr;
    const bool use_bar = (args.ph_hi - args.ph_lo) > 1;
    if (use_bar) bar = xcd_barrier_post((unsigned*)(ctl + CW_BAR) + args.li * XCD_BAR_WORDS, MISC + 8);
#define GRID_BAR() do { if (use_bar) xcd_barrier(bar); } while (0)
#define IN(k) (args.ph_lo <= (k) && (k) < args.ph_hi)
#define BOTH(k) (IN(k) && IN((k) + 1))
    if (IN(0)) { PTRS
        LAS float* scr = (LAS float*)(lds + wave * 16384);
        constexpr int I_IN = 16 * 176, I_BRR = 8 * 32, I_OUT = 16 * 32, I_LORA = 64, NT = I_IN + 2 * I_BRR + I_OUT + I_LORA;
        for (int it = gw; it < NT; it += NGW) {
            int r = it;
            if (r < I_IN) { transpose_item(win, 1024, 5632, WinT, 1024, 0, 0, scr, r, lane); continue; } r -= I_IN;
            if (r < I_BRR) { transpose_item(wbrr, 512, 1024, WbrrT, 512, 0, 0, scr, r, lane); continue; } r -= I_BRR;
            if (r < I_BRR) { transpose_item(wbra, 512, 1024, WbraT, 512, 0, 0, scr, r, lane); continue; } r -= I_BRR;
            if (r < I_OUT) { transpose_item(wout, 1024, 1024, WoutT, 1024, 0, 0, scr, r, lane); continue; } r -= I_OUT;
            { const int mat = r >> 4, nb = r & 15; const float* W = (mat < 2 ? wup : aup) + (size_t)(mat & 1) * 64 * 512;
              transpose_item(W, 64, 512, WloraT, 256, mat * 512, mat * 64, scr, nb, lane);
#pragma unroll
              for (int i = 0; i < 12; ++i) { const int q = lane + 64 * i, row = q / 24, cc = q % 24, chunk = cc < mat * 8 ? cc : cc + 8;
                  *(GAS v4u*)(WloraT + (size_t)(mat * 512 + nb * 32 + row) * 256 + chunk * 8) = (v4u){0u, 0u, 0u, 0u}; } }
        }
        for (int it = gw; it < 1536; it += NGW) {
            const int nblk = it % 48, r_ = it / 48, bg = r_ & 7, kq = r_ >> 3, n = nblk * 64 + lane, b0 = bg * 4, kbase = kq * 256;
#pragma unroll
            for (int bb = 0; bb < 4; ++bb)
#pragma unroll
                for (int kk = 0; kk < 4; ++kk) { const int k = lane + 64 * kk; const float cv = cin[(b0 + bb) * 1024 + kbase + k]; scr[k * 4 + bb] = cv * sigmoidf_(cv); }
            LDS_WAIT(); asm volatile("" ::: "memory");
            float acc[4] = {0.f, 0.f, 0.f, 0.f};
#pragma unroll 32
            for (int k = 0; k < 256; ++k) { const float wv = wada[(size_t)(kbase + k) * 3072 + n]; const f32x4 s = *(const LAS f32x4*)(scr + k * 4);
                acc[0] += s[0] * wv; acc[1] += s[1] * wv; acc[2] += s[2] * wv; acc[3] += s[3] * wv; }
            const float bn = kq == 0 ? bada[n] : 0.f;
#pragma unroll
            for (int bb = 0; bb < 4; ++bb) atomicAdd(ADA + (b0 + bb) * 3072 + n, acc[bb] + bn);
            LDS_WAIT(); asm volatile("" ::: "memory");
        }
        if (BOTH(0)) GRID_BAR();
    }
    if (IN(1)) { PTRS
        {
            f32x4 v[4], vn[4];
#define P1_LOAD(mm, V) do { const GAS f32x4* xr_ = (const GAS f32x4*)(x + (size_t)(mm) * DM) + lane; _Pragma("unroll") for (int j = 0; j < 4; ++j) V[j] = xr_[64 * j]; } while (0)
            if (gw < M) P1_LOAD(gw, vn);
            for (int m = gw; m < M; m += NGW) {
                const int b = m >> 11;
#pragma unroll
                for (int j = 0; j < 4; ++j) v[j] = vn[j];
                if (m + NGW < M) P1_LOAD(m + NGW, vn);
                float s = 0.f;
#pragma unroll
                for (int j = 0; j < 4; ++j) s += (v[j].x * v[j].x + v[j].y * v[j].y) + (v[j].z * v[j].z + v[j].w * v[j].w);
                const float rinv = 1.0f / sqrtf(wave_sum(s) * (1.f / DM) + 1e-6f);
                GAS unsigned long long* o8 = (GAS unsigned long long*)(Hb + (size_t)m * DM) + lane;
#pragma unroll
                for (int j = 0; j < 4; ++j) { const int c = 4 * (lane + 64 * j);
                    const f32x4 gp = *(const f32x4*)(gpre + c), sh = *(const f32x4*)(ADA + b * 3072 + c), sc = *(const f32x4*)(ADA + b * 3072 + 1024 + c);
                    const f32x4 hh = v[j] * rinv * gp * (sc + 1.0f) + sh;
                    o8[64 * j] = (unsigned long long)cvtpk_c(hh.x, hh.y) | ((unsigned long long)cvtpk_c(hh.z, hh.w) << 32); }
            }
#undef P1_LOAD
        }
        if (BOTH(1)) GRID_BAR();
    }
    if (IN(2)) { PTRS
        pg8::Gemm g{Hb, WinT, M, 3584, 1024, 1024}; pg8::StaticOrder S; S.init(M, 3584, G, bx);
        pg8::EpiShift E{Rb, LA, PA, EDGE, mu, lds + pg8::STAGE_BYTES, M};
        pg8::gemm_phase<pg8::EpiShift, pg8::StaticOrder, true, true>(lds, g, S, E);
        if (BOTH(2)) GRID_BAR();
    }
    if (IN(3)) { PTRS
        {
            const v4u zero4 = (v4u){0u, 0u, 0u, 0u};
            for (int it = gw; it < 2 * (M / 256); it += NGW) {
                const int pm = it >> 1, e = it & 1, m = pm * 256 + (e ? 255 : 0), tseg = pm & 7;
                const bf16* ec = EDGE + ((size_t)pm * 4 + (e ? 3 : 0)) * RCOLS;
                const bf16* ep = e ? EDGE + ((size_t)pm * 4 + 2) * RCOLS : EDGE + ((size_t)(pm - 1) * 4 + 3) * RCOLS;
                const bf16* en = e ? EDGE + ((size_t)(pm + 1) * 4 + 0) * RCOLS : EDGE + ((size_t)pm * 4 + 1) * RCOLS;
                const bool hasp = e || tseg > 0, hasn = !e || tseg < 7;
#pragma unroll
                for (int i = 0; i < 5; ++i) {
                    if (i == 4 && lane >= 32) break;
                    const int c = 8 * (lane + 64 * i);
                    const v4u cu = *(const v4u*)(ec + c), pv = hasp ? *(const v4u*)(ep + c) : zero4, nx = hasn ? *(const v4u*)(en + c) : zero4;
                    const f32x4 m0a = *(const f32x4*)(mu + c), m0b = *(const f32x4*)(mu + c + 4), m1a = *(const f32x4*)(mu + RCOLS + c), m1b = *(const f32x4*)(mu + RCOLS + c + 4);
                    const float mm0[8] = {m0a.x, m0a.y, m0a.z, m0a.w, m0b.x, m0b.y, m0b.z, m0b.w}, mm1[8] = {m1a.x, m1a.y, m1a.z, m1a.w, m1b.x, m1b.y, m1b.z, m1b.w};
                    float p[8], pp[8], pn[8], o[8];
                    unpack8(cu, p); unpack8(pv, pp); unpack8(nx, pn);
#pragma unroll
                    for (int e8 = 0; e8 < 8; ++e8) o[e8] = p[e8] + mm0[e8] * (pp[e8] - p[e8]) + mm1[e8] * (pn[e8] - p[e8]);
                    if (i == 0) { *(v4u*)(Rb + (size_t)m * RW + c) = pack8(o); }
                    else if (i == 1) { const int cc = c - 512;
                        *(v4u*)(Kb + (size_t)m * RW + cc) = pack8(o);
                        const f32x4 ka_ = *(const f32x4*)(k_k + cc), kb_ = *(const f32x4*)(k_k + cc + 4);
                        const float kkw[8] = {ka_.x, ka_.y, ka_.z, ka_.w, kb_.x, kb_.y, kb_.z, kb_.w};
                        float kr[8]; float ss = 0.f;
#pragma unroll
                        for (int e8 = 0; e8 < 8; ++e8) { kr[e8] = o[e8] * kkw[e8]; ss += kr[e8] * kr[e8]; }
                        ss += __shfl_xor(ss, 1); ss += __shfl_xor(ss, 2); ss += __shfl_xor(ss, 4);
                        const float inv = 1.0f / fmaxf(sqrtf(ss), 1e-12f);
#pragma unroll
                        for (int e8 = 0; e8 < 8; ++e8) kr[e8] *= inv;
                        *(v4u*)(KKb + (size_t)m * RW + cc) = pack8(kr); }
                    else if (i == 2) { *(v4u*)(Vb + (size_t)m * RW + (c - 1024)) = pack8(o); }
                    else if (i == 3) { *(v4u*)(Gb + (size_t)m * RW + (c - 1536)) = pack8(o); }
                    else { if (lane < 16) {
#pragma unroll
                            for (int e8 = 0; e8 < 8; ++e8) o[e8] = 1.0f - 2.0f * __builtin_amdgcn_rcpf(1.0f + __expf(2.0f * o[e8])); }
                        *(v4u*)(LA + (size_t)m * 256 + (c - 2048)) = pack8(o); }
                }
            }
            const int cc = 8 * lane;
            const f32x4 ka_ = *(const f32x4*)(k_k + cc), kb_ = *(const f32x4*)(k_k + cc + 4);
            const float kkw[8] = {ka_.x, ka_.y, ka_.z, ka_.w, kb_.x, kb_.y, kb_.z, kb_.w};
            v4u kq = zero4, kqn = zero4;
            if (gw < M) kqn = *(const v4u*)(Kb + (size_t)gw * RW + cc);
            for (int m = gw; m < M; m += NGW) {
                kq = kqn;
                if (m + NGW < M) kqn = *(const v4u*)(Kb + (size_t)(m + NGW) * RW + cc);
                const int tr = m & 255;
                if (tr == 0 || tr == 255) continue;
                float kf[8], kr[8]; float ss = 0.f;
                unpack8(kq, kf);
#pragma unroll
                for (int e8 = 0; e8 < 8; ++e8) { kr[e8] = kf[e8] * kkw[e8]; ss += kr[e8] * kr[e8]; }
                ss += dppf<0xB1>(ss); ss += dppf<0x4E>(ss); ss += dppf<0x141>(ss);
                const float inv = 1.0f / fmaxf(sqrtf(ss), 1e-12f);
#pragma unroll
                for (int e8 = 0; e8 < 8; ++e8) kr[e8] *= inv;
                *(v4u*)(KKb + (size_t)m * RW + cc) = pack8(kr);
            }
        }
        {
            LAS unsigned char* scr8 = lds + wave * 16384;
            for (int u = gw; u < 2048; u += NGW) {
                const int b = u >> 6, kvh = (u >> 5) & 1, tb = u & 31;
                const bf16* srck = PA + ((size_t)b * SEQ + tb * 64 + lane) * ACOLS + 512 + kvh * 64;
                const size_t tile0 = ((size_t)(b * 2 + kvh) * 64 + 2 * tb);
#pragma unroll
                for (int j8 = 0; j8 < 8; ++j8) *(LAS v4u*)(scr8 + lane * 144 + 16 * j8) = *(const v4u*)(srck + 8 * j8);
                LDS_WAIT(); asm volatile("" ::: "memory");
#pragma unroll
                for (int tt = 0; tt < 2; ++tt)
#pragma unroll
                    for (int ks = 0; ks < 4; ++ks) *(v4u*)(KB + (((tile0 + tt) * 4 + ks) * 64 + lane) * 8) = *(const LAS v4u*)(scr8 + (32 * tt + (lane & 31)) * 144 + (16 * ks + 8 * (lane >> 5)) * 2);
                LDS_WAIT(); asm volatile("" ::: "memory");
                LAS unsigned short* tile = (LAS unsigned short*)scr8;
                const bf16* srcv = srck + 128;
#pragma unroll
                for (int j8 = 0; j8 < 8; ++j8) { const v4u qv = *(const v4u*)(srcv + 8 * j8); LAS unsigned* dst = (LAS unsigned*)(tile + lane * 66 + 8 * j8);
                    dst[0] = qv.x; dst[1] = qv.y; dst[2] = qv.z; dst[3] = qv.w; }
                LDS_WAIT(); asm volatile("" ::: "memory");
#pragma unroll
                for (int tt = 0; tt < 2; ++tt)
#pragma unroll
                    for (int mb = 0; mb < 2; ++mb)
#pragma unroll
                        for (int k2 = 0; k2 < 2; ++k2) { unsigned w[4];
#pragma unroll
                            for (int e = 0; e < 4; ++e) { const int j0 = 2 * e, key0 = 32 * tt + 16 * k2 + 8 * (j0 >> 2) + 4 * (lane >> 5) + (j0 & 3);
                                const unsigned lo16 = tile[key0 * 66 + 32 * mb + (lane & 31)], hi16 = tile[(key0 + 1) * 66 + 32 * mb + (lane & 31)]; w[e] = lo16 | (hi16 << 16); }
                            *(v4u*)(VB + ((((tile0 + tt) * 2 + mb) * 2 + k2) * 64 + lane) * 8) = (v4u){w[0], w[1], w[2], w[3]}; }
                LDS_WAIT(); asm volatile("" ::: "memory");
            }
        }
        if (BOTH(3)) GRID_BAR();
    }
    if (IN(4)) { PTRS
        pg8::Gemm g{LA, WloraT, M, 2048, 256, 256}; pg8::StaticOrder S; S.init(M, 2048, G, bx);
        pg8::EpiLora E{RAW, w0, a0};
        pg8::gemm_phase<pg8::EpiLora, pg8::StaticOrder, true, true>(lds, g, S, E);
        if (BOTH(4)) GRID_BAR();
    }
    if (IN(6)) { PTRS
        typedef float f32x16 __attribute__((ext_vector_type(16)));
#define MF(a, b, c) __builtin_amdgcn_mfma_f32_32x32x16_bf16(a, b, c, 0, 0, 0)
#define ACCF(x, s) __builtin_bit_cast(bf16x8, (v4u){cvtpk_c((x)[8 * (s) + 0], (x)[8 * (s) + 1]), cvtpk_c((x)[8 * (s) + 2], (x)[8 * (s) + 3]), cvtpk_c((x)[8 * (s) + 4], (x)[8 * (s) + 5]), cvtpk_c((x)[8 * (s) + 6], (x)[8 * (s) + 7])})
#define LDN(img, pitch, rowb, k0) (*(const LAS bf16x8*)((img) + ((rowb) + q) * (pitch) + ((k0) + 8 * hh) * 2))
#define LDP(img, pitch, rowb, k0) ldsfrag_perm((img) + ((rowb) + q) * (pitch) + ((k0) + 4 * hh) * 2)
#define ZERO16(x) do { _Pragma("unroll") for (int r_ = 0; r_ < 16; ++r_) (x)[r_] = 0.f; } while (0)
#define MMAA(X, Y, Cacc) do { const bf16x8 xa_ = ACCF(X, 0), xb_ = ACCF(X, 1), ya_ = ACCF(Y, 0), yb_ = ACCF(Y, 1); Cacc = MF(xa_, ya_, Cacc); Cacc = MF(xb_, yb_, Cacc); } while (0)
#define PROGW(k) ((volatile LAS unsigned*)(lds + LDSCTL_OFF + 1024 + (k) * 64))
#define SPIN_UNTIL(cond) do { while (!(cond)) __builtin_amdgcn_s_sleep(1); asm volatile("" ::: "memory"); } while (0)
        constexpr int NCH = SEQ / 32;
        const int q = lane & 31, hh = lane >> 5;
        const bool run_scan = !(args.pad & 1);
        if (wave < 4 && run_scan) {
            const int sl = wave >> 1, ib = wave & 1;
            const int s = 2 * vcu + sl; const int d = s & 1, bh = s >> 1, b = bh >> 3, h = bh & 7;
            LAS unsigned char* sbase = lds + sl * 57856;
            LAS unsigned char* VT0 = lds + 115712 + wave * 5120;
            const LAS unsigned char* FR = lds + 136192 + sl * 8192;
            volatile LAS unsigned* progE = PROGW(wave); volatile LAS unsigned* ptE = PROGW(wave ^ 1); volatile LAS unsigned* progM = PROGW(4 + wave); volatile LAS unsigned* ptM = PROGW(4 + (wave ^ 1));
            volatile LAS unsigned* progF = PROGW(8 + wave); volatile LAS unsigned* progH = PROGW(12 + sl);
            const int cp = lane & 15, tq = lane >> 4;
            bf16* pY = RAW + d * 512 + h * 64 + ib * 32 + q;
            const unsigned tsel = d ? (unsigned)(3 - tq) : (unsigned)tq;
            const unsigned offS = tsel * 8u * 4096u + 64u * ib + 4u * cp, offT = tsel * 8u * 1024u + 64u * ib + 4u * cp;
            const unsigned oS = (unsigned)((d * 512 + h * 64) * 2), oT = (unsigned)(h * 128);
            unsigned pf[5][8], vq[8];
#define PF_TOK(cc, tl) ((unsigned)(b * SEQ + (d ? (SEQ - 1 - 32 * (cc) - (tl) - 24) : (32 * (cc) + (tl)))))
#define PF_ISSUE(cc, T0, T1) do { unsigned vS_ = offS, vT_ = offT; asm volatile("" : "+v"(vS_), "+v"(vT_));        \
            _Pragma("unroll") for (int tl = (T0); tl < (T1); ++tl) { const unsigned m0 = PF_TOK(cc, tl); \
                pf[0][tl] = *(const unsigned*)((ws + ((unsigned)WS_PR + oS + m0 * 4096u)) + vS_); pf[1][tl] = *(const unsigned*)((ws + ((unsigned)WS_PR + 2048u + oS + m0 * 4096u)) + vS_); pf[2][tl] = *(const unsigned*)((ws + ((unsigned)WS_KK + oT + m0 * 1024u)) + vT_); \
                pf[3][tl] = *(const unsigned*)((ws + ((unsigned)WS_K + oT + m0 * 1024u)) + vT_); pf[4][tl] = *(const unsigned*)((ws + ((unsigned)WS_R + oT + m0 * 1024u)) + vT_); } } while (0)
            PF_ISSUE(0, 0, 8);
            { unsigned vT_ = offT; asm volatile("" : "+v"(vT_));
#pragma unroll
              for (int tl = 0; tl < 8; ++tl) { const unsigned m0 = PF_TOK(0, tl); vq[tl] = *(const unsigned*)((ws + ((unsigned)WS_V + oT + m0 * 1024u)) + vT_); } }
            f32x16 H0a, H0b; ZERO16(H0a); ZERO16(H0b);
            for (int it = 0; it <= NCH; ++it) {
                if (it < NCH) {
                    LAS unsigned char* KQ = sbase + (it & 1) * 28928, *RQ = KQ + 4608, *KKI = KQ + 9216, *BKI = KQ + 13824, *KCT = KQ + 18432, *BCT = KQ + 23552; LAS float* GC = (LAS float*)(KQ + 28672);
                    LAS unsigned char* VTI = VT0 + (it & 1) * 2560;
                    if (it >= 2) SPIN_UNTIL(*progH + 1u >= (unsigned)it && *ptM + 1u >= (unsigned)it);
                    {
                    const float ka0 = k_a[h * 64 + 32 * ib + 2 * cp], ka1 = k_a[h * 64 + 32 * ib + 2 * cp + 1];
                    const float rk0 = r_k[h * 64 + 32 * ib + 2 * cp], rk1 = r_k[h * 64 + 32 * ib + 2 * cp + 1];
                    const int cn = it + 1 < NCH ? it + 1 : it;
                    unsigned nS_ = offS, nT_ = offT; asm volatile("" : "+v"(nS_), "+v"(nT_));
                    float t0 = 0.f, t1 = 0.f;
#pragma unroll
                    for (int tl = 0; tl < 8; ++tl) { t0 += bflo(pf[0][tl]); t1 += bfhi(pf[0][tl]); }
                    t0 *= -0.6065306597f; t1 *= -0.6065306597f;
                    float o0, o1, tot0, tot1;
                    {   const auto a0_ = __builtin_amdgcn_permlane16_swap(__float_as_uint(t0), __float_as_uint(t0), false, false), a1_ = __builtin_amdgcn_permlane16_swap(__float_as_uint(t1), __float_as_uint(t1), false, false);
                        const float n0 = (tq & 1) ? __uint_as_float(a0_[0]) : __uint_as_float(a0_[1]), n1 = (tq & 1) ? __uint_as_float(a1_[0]) : __uint_as_float(a1_[1]);
                        const float p0 = t0 + n0, p1 = t1 + n1;
                        const auto b0_ = __builtin_amdgcn_permlane32_swap(__float_as_uint(p0), __float_as_uint(p0), false, false), b1_ = __builtin_amdgcn_permlane32_swap(__float_as_uint(p1), __float_as_uint(p1), false, false);
                        const float q0 = (tq & 2) ? __uint_as_float(b0_[0]) : __uint_as_float(b0_[1]), q1 = (tq & 2) ? __uint_as_float(b1_[0]) : __uint_as_float(b1_[1]);
                        o0 = ((tq & 1) ? n0 : 0.f) + ((tq & 2) ? q0 : 0.f); o1 = ((tq & 1) ? n1 : 0.f) + ((tq & 2) ? q1 : 0.f); tot0 = p0 + q0; tot1 = p1 + q1; }
                    const float gC0 = __expf(tot0), gC1 = __expf(tot1);
                    float L0 = o0, L1 = o1; float eLp0 = __expf(L0), eLp1 = __expf(L1);
                    if (tq == 0) { GC[32 * ib + 2 * cp] = gC0; GC[32 * ib + 2 * cp + 1] = gC1; }
                    float bpk = 0.f;
#pragma unroll
                    for (int t2 = 0; t2 < 4; ++t2) {
                        float kc0[2], kc1[2], bc0[2], bc1[2];
#pragma unroll
                        for (int e = 0; e < 2; ++e) { const int tl = 2 * t2 + e, tau = 8 * tq + tl;
                            const float sg0 = bflo(pf[0][tl]), sg1 = bfhi(pf[0][tl]), a0_ = bflo(pf[1][tl]), a1_ = bfhi(pf[1][tl]), kk0 = bflo(pf[2][tl]), kk1 = bfhi(pf[2][tl]);
                            const float k0_ = bflo(pf[3][tl]), k1_ = bfhi(pf[3][tl]), r0_ = bflo(pf[4][tl]), r1_ = bfhi(pf[4][tl]);
                            L0 += -0.6065306597f * sg0; L1 += -0.6065306597f * sg1;
                            const float eL0 = __expf(L0), eL1 = __expf(L1), en0 = __builtin_amdgcn_rcpf(eL0), en1 = __builtin_amdgcn_rcpf(eL1);
                            const float kd0 = k0_ * (1.0f + (a0_ - 1.0f) * ka0), kd1 = k1_ * (1.0f + (a1_ - 1.0f) * ka1);
                            const float kkf0 = kd0 * en0, kkf1 = kd1 * en1, bkf0 = kk0 * a0_ * en0, bkf1 = kk1 * a1_ * en1;
                            {
                                float bp = r0_ * kd0 * rk0 + r1_ * kd1 * rk1;
                                bp += __shfl_xor(bp, 1); bp += __shfl_xor(bp, 2); bp += __shfl_xor(bp, 4); bp += __shfl_xor(bp, 8);
                                bpk = (cp == tl) ? bp : bpk; }
                            ((LAS unsigned*)KQ)[tau * 36 + 16 * ib + cp] = pg8::cvt_pk_bf16(kk0 * eLp0, kk1 * eLp1); ((LAS unsigned*)RQ)[tau * 36 + 16 * ib + cp] = pg8::cvt_pk_bf16(r0_ * eL0, r1_ * eL1);
                            ((LAS unsigned*)KKI)[tau * 36 + 16 * ib + cp] = pg8::cvt_pk_bf16(kkf0, kkf1); ((LAS unsigned*)BKI)[tau * 36 + 16 * ib + cp] = pg8::cvt_pk_bf16(bkf0, bkf1);
                            kc0[e] = kkf0 * gC0; kc1[e] = kkf1 * gC1; bc0[e] = -bkf0 * gC0; bc1[e] = -bkf1 * gC1;
                            eLp0 = eL0; eLp1 = eL1;
                            { const unsigned m0 = PF_TOK(cn, tl);
                              pf[0][tl] = *(const unsigned*)((ws + ((unsigned)WS_PR + oS + m0 * 4096u)) + nS_); pf[1][tl] = *(const unsigned*)((ws + ((unsigned)WS_PR + 2048u + oS + m0 * 4096u)) + nS_); pf[2][tl] = *(const unsigned*)((ws + ((unsigned)WS_KK + oT + m0 * 1024u)) + nT_);
                              pf[3][tl] = *(const unsigned*)((ws + ((unsigned)WS_K + oT + m0 * 1024u)) + nT_); pf[4][tl] = *(const unsigned*)((ws + ((unsigned)WS_R + oT + m0 * 1024u)) + nT_); } }
                        const int sp = 4 * tq + t2;
                        const int j0 = 32 * ib + 2 * cp;
                        ((LAS unsigned*)KCT)[j0 * 20 + sp] = pg8::cvt_pk_bf16(kc0[0], kc0[1]); ((LAS unsigned*)KCT)[(j0 + 1) * 20 + sp] = pg8::cvt_pk_bf16(kc1[0], kc1[1]);
                        ((LAS unsigned*)BCT)[j0 * 20 + sp] = pg8::cvt_pk_bf16(bc0[0], bc0[1]); ((LAS unsigned*)BCT)[(j0 + 1) * 20 + sp] = pg8::cvt_pk_bf16(bc1[0], bc1[1]);
                    }
                    if (cp < 8) { const int tt_ = 32 * it + 8 * tq + cp; const size_t mt_ = (size_t)b * SEQ + (d ? (SEQ - 1 - tt_) : tt_); BP4[((size_t)(d * 2 + ib) * M + mt_) * 8 + h] = bpk; }
#pragma unroll
                    for (int t2 = 0; t2 < 4; ++t2) { const int sp = 4 * tq + t2; const unsigned va = vq[2 * t2], vb = vq[2 * t2 + 1];
                        ((LAS unsigned*)VTI)[(2 * cp) * 20 + sp] = (va & 0xffffu) | (vb << 16); ((LAS unsigned*)VTI)[(2 * cp + 1) * 20 + sp] = (va >> 16) | (vb & 0xffff0000u); }
#pragma unroll
                    for (int tl = 0; tl < 8; ++tl) { const unsigned m0 = PF_TOK(cn, tl); vq[tl] = *(const unsigned*)((ws + ((unsigned)WS_V + oT + m0 * 1024u)) + nT_); }
                }
                    asm volatile("s_waitcnt lgkmcnt(0)" ::: "memory");
                    *progE = (unsigned)(it + 1);
                }
                if (it >= 1) {
                    const int c = it - 1;
                    const LAS unsigned char* KQ = sbase + (c & 1) * 28928, *RQ = KQ + 4608, *KCT = KQ + 18432, *BCT = KQ + 23552; const LAS float* GC = (const LAS float*)(KQ + 28672);
                    const LAS unsigned char* VTI = VT0 + (c & 1) * 2560;
                    SPIN_UNTIL(*ptE >= (unsigned)(c + 1));
                    f32x16 Zacc, Yacc, U; ZERO16(Zacc); ZERO16(Yacc); ZERO16(U);
                    const bf16x8 h0f0 = ACCF(H0a, 0), h0f1 = ACCF(H0a, 1), h0f2 = ACCF(H0b, 0), h0f3 = ACCF(H0b, 1);
                    Zacc = MF(LDP(KQ, 144, 0, 0), h0f0, Zacc); Zacc = MF(LDP(KQ, 144, 0, 16), h0f1, Zacc); Zacc = MF(LDP(KQ, 144, 0, 32), h0f2, Zacc); Zacc = MF(LDP(KQ, 144, 0, 48), h0f3, Zacc);
                    Yacc = MF(LDP(RQ, 144, 0, 0), h0f0, Yacc); Yacc = MF(LDP(RQ, 144, 0, 16), h0f1, Yacc); Yacc = MF(LDP(RQ, 144, 0, 32), h0f2, Yacc); Yacc = MF(LDP(RQ, 144, 0, 48), h0f3, Yacc);
#pragma unroll
                    for (int r_ = 0; r_ < 16; ++r_) { const int row_ = (r_ & 3) + 8 * (r_ >> 2) + 4 * hh; H0a[r_] *= GC[row_]; H0b[r_] *= GC[32 + row_]; }
                    H0a = MF(LDN(KCT, 80, 0, 0), LDN(VTI, 80, 0, 0), H0a); H0a = MF(LDN(KCT, 80, 0, 16), LDN(VTI, 80, 0, 16), H0a);
                    H0b = MF(LDN(KCT, 80, 32, 0), LDN(VTI, 80, 0, 0), H0b); H0b = MF(LDN(KCT, 80, 32, 16), LDN(VTI, 80, 0, 16), H0b);
                    SPIN_UNTIL(*progH >= (unsigned)(c + 1));
                    bf16x8 fr[8];
#pragma unroll
                    for (int f = 0; f < 8; ++f) fr[f] = *(const LAS bf16x8*)(FR + f * 1024 + lane * 16);
                    asm volatile("s_waitcnt lgkmcnt(0)" ::: "memory");
                    *progF = (unsigned)(c + 1);
                    Zacc = MF(fr[2], LDP(VTI, 80, 0, 0), Zacc); Zacc = MF(fr[3], LDP(VTI, 80, 0, 16), Zacc);
                    Yacc = MF(fr[4], LDP(VTI, 80, 0, 0), Yacc); Yacc = MF(fr[5], LDP(VTI, 80, 0, 16), Yacc);
                    U = MF(fr[0], ACCF(Zacc, 0), U); U = MF(fr[1], ACCF(Zacc, 1), U);
                    { const bf16x8 u0 = ACCF(U, 0), u1 = ACCF(U, 1);
                      Yacc = MF(fr[6], u0, Yacc); Yacc = MF(fr[7], u1, Yacc);
#pragma unroll
                      for (int r_ = 0; r_ < 16; ++r_) { const int tt = 32 * c + (r_ & 3) + 8 * (r_ >> 2) + 4 * hh; const size_t m = (size_t)b * SEQ + (d ? (SEQ - 1 - tt) : tt);
                          pY[m * 2048] = (bf16)(cvtpk_c(Yacc[r_], 0.f) & 0xffffu); }
                      H0a = MF(LDP(BCT, 80, 0, 0), u0, H0a); H0a = MF(LDP(BCT, 80, 0, 16), u1, H0a);
                      H0b = MF(LDP(BCT, 80, 32, 0), u0, H0b); H0b = MF(LDP(BCT, 80, 32, 16), u1, H0b); }
                    asm volatile("s_waitcnt lgkmcnt(0)" ::: "memory");
                    *progM = (unsigned)(c + 1);
                }
            }
#undef PF_ISSUE
#undef PF_TOK
        } else if (wave < 6 && run_scan) {
            const int sl = wave - 4;
            const LAS unsigned char* sbase = lds + sl * 57856;
            LAS unsigned char* FR = lds + 136192 + sl * 8192;
            volatile LAS unsigned* pE0 = PROGW(2 * sl), *pE1 = PROGW(2 * sl + 1), *pF0 = PROGW(8 + 2 * sl), *pF1 = PROGW(8 + 2 * sl + 1); volatile LAS unsigned* progH = PROGW(12 + sl);
            for (int c = 0; c < NCH; ++c) {
                const LAS unsigned char* KQ = sbase + (c & 1) * 28928, *RQ = KQ + 4608, *KKI = KQ + 9216, *BKI = KQ + 13824;
                SPIN_UNTIL(*pE0 >= (unsigned)(c + 1) && *pE1 >= (unsigned)(c + 1));
                f32x16 Rm, P, Pt, Rt, Aa, Ar, Ab;
                ZERO16(P); ZERO16(Pt); ZERO16(Aa); ZERO16(Ar); ZERO16(Ab);
#pragma unroll
                for (int ks = 0; ks < 4; ++ks) { const bf16x8 fb = LDN(BKI, 144, 0, 16 * ks), fq = LDN(KQ, 144, 0, 16 * ks), fk = LDN(KKI, 144, 0, 16 * ks), frq = LDN(RQ, 144, 0, 16 * ks);
                    P = MF(fb, fq, P); Pt = MF(fq, fb, Pt); Aa = MF(fk, fq, Aa); Ar = MF(fk, frq, Ar); Ab = MF(fb, frq, Ab); }
#pragma unroll
                for (int r_ = 0; r_ < 16; ++r_) { const int row_ = (r_ & 3) + 8 * (r_ >> 2) + 4 * hh; P[r_] = row_ < q ? -P[r_] : 0.f; Pt[r_] = row_ > q ? -Pt[r_] : 0.f; Rm[r_] = P[r_] + (row_ == q ? 1.0f : 0.f); Rt[r_] = Pt[r_] + (row_ == q ? 1.0f : 0.f);
                    Aa[r_] = row_ < q ? Aa[r_] : 0.f; Ar[r_] = row_ <= q ? Ar[r_] : 0.f; Ab[r_] = row_ <= q ? -Ab[r_] : 0.f; }
                const bf16x8 fa0 = ACCF(Aa, 0), fa1 = ACCF(Aa, 1), fr0 = ACCF(Ar, 0), fr1 = ACCF(Ar, 1), fb0 = ACCF(Ab, 0), fb1 = ACCF(Ab, 1);
#pragma unroll
                for (int k = 0; k < 4; ++k) {
                    f32x16 P2; ZERO16(P2); MMAA(Pt, P, P2);
                    MMAA(Rt, P2, Rm);
                    if (k < 3) { f32x16 P2t; ZERO16(P2t); MMAA(P, Pt, P2t); MMAA(P2, Rt, Rt); Pt = P2t; }
                    P = P2;
                }
                const bf16x8 ft0 = ACCF(Rm, 0), ft1 = ACCF(Rm, 1);
                asm volatile("s_waitcnt lgkmcnt(0)" ::: "memory");
                if (c >= 1) SPIN_UNTIL(*pF0 >= (unsigned)c && *pF1 >= (unsigned)c);
                *(LAS bf16x8*)(FR + 0 * 1024 + lane * 16) = ft0; *(LAS bf16x8*)(FR + 1 * 1024 + lane * 16) = ft1; *(LAS bf16x8*)(FR + 2 * 1024 + lane * 16) = fa0; *(LAS bf16x8*)(FR + 3 * 1024 + lane * 16) = fa1;
                *(LAS bf16x8*)(FR + 4 * 1024 + lane * 16) = fr0; *(LAS bf16x8*)(FR + 5 * 1024 + lane * 16) = fr1; *(LAS bf16x8*)(FR + 6 * 1024 + lane * 16) = fb0; *(LAS bf16x8*)(FR + 7 * 1024 + lane * 16) = fb1;
                asm volatile("s_waitcnt lgkmcnt(0)" ::: "memory");
                *progH = (unsigned)(c + 1);
            }
        }
        if (!(args.pad & 2)) {
            const int b = vcu >> 3, kvh = (vcu >> 2) & 1, qseg = vcu & 3;
            const bf16* kb0 = KB + ((size_t)(b * 2 + kvh) * 64) * 4 * 64 * 8 + lane * 8;
            const bf16* vb0 = VB + ((size_t)(b * 2 + kvh) * 64) * 4 * 64 * 8 + lane * 8;
            LAS unsigned* qctr = (LAS unsigned*)(lds + LDSCTL_OFF + 1024 + 14 * 64);
#define ATT_LOAD(kt_, KF, VF) do { _Pragma("unroll") for (int ks = 0; ks < 4; ++ks) KF[ks] = *(const bf16x8*)(kb0 + (size_t)((kt_) * 4 + ks) * 512); \
                _Pragma("unroll") for (int mb = 0; mb < 2; ++mb) _Pragma("unroll") for (int k2 = 0; k2 < 2; ++k2) VF[mb][k2] = *(const bf16x8*)(vb0 + (size_t)((kt_) * 4 + mb * 2 + k2) * 512); } while (0)
            for (;;) {
                unsigned e_ = 0; if (lane == 0) e_ = __hip_atomic_fetch_add(qctr, 1u, __ATOMIC_RELAXED, __HIP_MEMORY_SCOPE_WORKGROUP);
                const int e = __builtin_amdgcn_readfirstlane((int)e_);
                if (e >= 64) break;
                const int g = e & 3, qb = qseg * 16 + (e >> 2), hq = kvh * 4 + g;
                const int t = 32 * qb + q;
                const float slope = exp2f(-(float)(hq + 1));
                bf16* qrow = PA + ((size_t)b * SEQ + t) * ACOLS + hq * 64;
                bf16x8 qf[4];
#pragma unroll
                for (int ks = 0; ks < 4; ++ks) qf[ks] = *(const bf16x8*)(qrow + 16 * ks + 8 * hh);
                float mrun = sink[hq], lrun = 1.0f;
                f32x16 O0, O1; ZERO16(O0); ZERO16(O1);
                const int kt0 = qb - 4 < 0 ? 0 : qb - 4, kt1 = qb + 4 > 63 ? 63 : qb + 4;
                float nb[16];
#pragma unroll
                for (int r = 0; r < 16; ++r) nb[r] = slope * (float)(q - 4 * hh - ((r & 3) + 8 * (r >> 2)));
                bf16x8 kfA[4], vfA[2][2], kfB[4], vfB[2][2];
#define ATT_TILE(kt_, KF, VF) do { \
                    f32x16 acc; ZERO16(acc); \
                    _Pragma("unroll") for (int ks = 0; ks < 4; ++ks) acc = MF(KF[ks], qf[ks], acc); \
                      \
                    const int dlt = qb - (kt_); float sc[16]; float mx = -1e30f; \
                    if (dlt > 0) { _Pragma("unroll") for (int r = 0; r < 16; ++r) sc[r] = acc[r] * 0.125f - nb[r]; \
                        if (dlt == 4) { _Pragma("unroll") for (int r = 0; r < 16; ++r) sc[r] = nb[r] <= 0.f ? sc[r] : -1e30f; } } \
                    else if (dlt < 0) { _Pragma("unroll") for (int r = 0; r < 16; ++r) sc[r] = acc[r] * 0.125f + nb[r]; \
                        if (dlt == -4) { _Pragma("unroll") for (int r = 0; r < 16; ++r) sc[r] = nb[r] >= 0.f ? sc[r] : -1e30f; } } \
                    else { _Pragma("unroll") for (int r = 0; r < 16; ++r) sc[r] = acc[r] * 0.125f - fabsf(nb[r]); } \
                    const float coff = slope * 32.0f * (float)(dlt < 0 ? -dlt : dlt); \
                    _Pragma("unroll") for (int r = 0; r < 16; ++r) mx = fmaxf(mx, sc[r]); \
                    { const auto rr_ = __builtin_amdgcn_permlane32_swap(__float_as_uint(mx), __float_as_uint(mx), false, false); mx = fmaxf(__uint_as_float(rr_[0]), __uint_as_float(rr_[1])) - coff; }     \
                    const float mn = fmaxf(mrun, mx), alpha = __expf(mrun - mn); mrun = mn; \
                    const float sh = mn + coff; float rs = 0.f; \
                    _Pragma("unroll") for (int r = 0; r < 16; ++r) { sc[r] = __expf(sc[r] - sh); rs += sc[r]; } \
                    lrun = lrun * alpha + rs;                                  \
                    bf16x8 pb[2]; \
                    _Pragma("unroll") for (int k2 = 0; k2 < 2; ++k2) pb[k2] = __builtin_bit_cast(bf16x8, (v4u){cvtpk_c(sc[8 * k2 + 0], sc[8 * k2 + 1]), cvtpk_c(sc[8 * k2 + 2], sc[8 * k2 + 3]), cvtpk_c(sc[8 * k2 + 4], sc[8 * k2 + 5]), cvtpk_c(sc[8 * k2 + 6], sc[8 * k2 + 7])}); \
                    if (__ballot(alpha != 1.0f) != 0ull) { _Pragma("unroll") for (int r = 0; r < 16; ++r) { O0[r] *= alpha; O1[r] *= alpha; } } \
                    _Pragma("unroll") for (int k2 = 0; k2 < 2; ++k2) { O0 = MF(VF[0][k2], pb[k2], O0); O1 = MF(VF[1][k2], pb[k2], O1); } } while (0)
                ATT_LOAD(kt0, kfA, vfA);
                for (int kt = kt0; kt <= kt1; kt += 2) {
                    if (kt + 1 <= kt1) ATT_LOAD(kt + 1, kfB, vfB);
                    ATT_TILE(kt, kfA, vfA);
                    if (kt + 1 <= kt1) {
                        if (kt + 2 <= kt1) ATT_LOAD(kt + 2, kfA, vfA);
                        ATT_TILE(kt + 1, kfB, vfB);
                    }
                }
#undef ATT_TILE
                { const auto rr_ = __builtin_amdgcn_permlane32_swap(__float_as_uint(lrun), __float_as_uint(lrun), false, false); lrun = __uint_as_float(rr_[0]) + __uint_as_float(rr_[1]) - __expf(sink[hq] - mrun); }
                const float inv = __builtin_amdgcn_rcpf(lrun);
                const bf16* grow = PA + ((size_t)b * SEQ + t) * ACOLS + 768 + hq * 64;
#pragma unroll
                for (int mb = 0; mb < 2; ++mb)
#pragma unroll
                    for (int r4 = 0; r4 < 4; ++r4) { const int dd = mb * 32 + 8 * r4 + 4 * hh;
                        const uint2 gq = *(const uint2*)(grow + dd);
                        const float g0 = bflo(gq.x), g1 = bfhi(gq.x), g2 = bflo(gq.y), g3 = bfhi(gq.y);
                        const float o0 = (mb ? O1[4 * r4 + 0] : O0[4 * r4 + 0]) * inv, o1 = (mb ? O1[4 * r4 + 1] : O0[4 * r4 + 1]) * inv, o2 = (mb ? O1[4 * r4 + 2] : O0[4 * r4 + 2]) * inv, o3 = (mb ? O1[4 * r4 + 3] : O0[4 * r4 + 3]) * inv;
                        *(uint2*)(qrow + dd) = make_uint2(cvtpk_c(o0 * g0 * pg8::sigm(g0), o1 * g1 * pg8::sigm(g1)), cvtpk_c(o2 * g2 * pg8::sigm(g2), o3 * g3 * pg8::sigm(g3))); }
            }
#undef ATT_LOAD
        }
#undef MF
#undef ACCF
#undef LDN
#undef LDP
#undef ZERO16
#undef MMAA
#undef PROGW
#undef SPIN_UNTIL
        if (BOTH(6)) GRID_BAR();
    }
    if (IN(7)) { PTRS
        {
            const int c0 = 8 * lane;
            v4u q8[4], q8n[4]; float bsn = 0.f;
#define P7_LOAD(mm, Q, B) do { const bf16* rr_ = RAW + (size_t)(mm) * 2048 + c0; Q[0] = *(const v4u*)(rr_); Q[1] = *(const v4u*)(rr_ + 512); \
                Q[2] = *(const v4u*)(Vb + (size_t)(mm) * RW + c0); Q[3] = *(const v4u*)(Gb + (size_t)(mm) * RW + c0); { const size_t bi_ = (size_t)(mm) * 8 + (lane >> 3); B = (BP4[bi_] + BP4[(size_t)M * 8 + bi_]) + (BP4[(size_t)2 * M * 8 + bi_] + BP4[(size_t)3 * M * 8 + bi_]); } } while (0)
            const f32x4 gwa = *(const f32x4*)(gnw + c0), gwb = *(const f32x4*)(gnw + c0 + 4), gba = *(const f32x4*)(gnb + c0), gbb = *(const f32x4*)(gnb + c0 + 4);
            const float gw8[8] = {gwa.x, gwa.y, gwa.z, gwa.w, gwb.x, gwb.y, gwb.z, gwb.w}, gb8[8] = {gba.x, gba.y, gba.z, gba.w, gbb.x, gbb.y, gbb.z, gbb.w};
            if (gw < M) P7_LOAD(gw, q8n, bsn);
            for (int m = gw; m < M; m += NGW) {
#pragma unroll
                for (int i = 0; i < 4; ++i) q8[i] = q8n[i];
                const float bs = bsn;
                if (m + NGW < M) P7_LOAD(m + NGW, q8n, bsn);
                float y0[8], y1[8], vf[8], gf[8], y[8];
                unpack8(q8[0], y0); unpack8(q8[1], y1); unpack8(q8[2], vf); unpack8(q8[3], gf);
                float s = 0.f;
#pragma unroll
                for (int e = 0; e < 8; ++e) { y[e] = y0[e] + y1[e]; s += y[e]; }
                s += __shfl_xor(s, 1); s += __shfl_xor(s, 2); s += __shfl_xor(s, 4);
                const float mean = s * (1.f / 64.f); float qq = 0.f;
#pragma unroll
                for (int e = 0; e < 8; ++e) { const float dd = y[e] - mean; qq += dd * dd; }
                qq += __shfl_xor(qq, 1); qq += __shfl_xor(qq, 2); qq += __shfl_xor(qq, 4);
                const float rstd = 1.0f / sqrtf(qq * (1.f / 64.f) + 64e-5f);
                float r[8];
#pragma unroll
                for (int e = 0; e < 8; ++e) { const float yn = (y[e] - mean) * rstd * gw8[e] + gb8[e]; r[e] = (yn + bs * vf[e]) * gf[e] * sigmoidf_(gf[e]); }
                *(v4u*)(Vb + (size_t)m * RW + c0) = pack8(r);
            }
#undef P7_LOAD
        }
        if (BOTH(7)) GRID_BAR();
    }
    if (IN(8)) { PTRS
        { pg8::Gemm g{Hb, WinT + (size_t)3584 * 1024, M, 2048, 1024, 1024}; pg8::StaticOrder S; S.init(M, 2048, G, bx);
          pg8::EpiRoute E{PGT, PGT, 2048, 2048, 1 << 20};
          pg8::gemm_phase<pg8::EpiRoute, pg8::StaticOrder, true, true>(lds, g, S, E); }
        if (BOTH(8)) GRID_BAR();
    }
    if (IN(9)) { PTRS
        { pg8::Gemm g{Vb, WbrrT, M, 1024, 512, 512}; pg8::StaticOrder S; S.init(M, 1024, G, bx);
          pg8::EpiGate<0> E{MG, PGT};
          pg8::gemm_phase<pg8::EpiGate<0>, pg8::StaticOrder, true, true>(lds, g, S, E); }
        { pg8::Gemm g{PA, WbraT, M, 1024, 512, ACOLS}; pg8::StaticOrder S; S.init(M, 1024, G, bx);
          pg8::EpiGate<1> E{MG, PGT};
          pg8::gemm_phase<pg8::EpiGate<1>, pg8::StaticOrder, true, true>(lds, g, S, E); }
        if (BOTH(9)) GRID_BAR();
    }
    if (IN(10)) { PTRS
        pg8::Gemm g{MG, WoutT, M, 1024, 1024, 1024}; pg8::StaticOrder S; S.init(M, 1024, G, bx);
        pg8::EpiRoute E{OUTB, OUTB, 1024, 1024, 1 << 20};
        pg8::gemm_phase<pg8::EpiRoute, pg8::StaticOrder, true, true>(lds, g, S, E);
        if (BOTH(10)) GRID_BAR();
    }
    if (IN(11)) { PTRS
        {
            v4u oq[2], oqn[2]; f32x4 xq[4], xqn[4];
#define P11_LOAD(mm, O, X) do { _Pragma("unroll") for (int j = 0; j < 2; ++j) { O[j] = *(const v4u*)(OUTB + (size_t)(mm) * 1024 + 8 * (lane + 64 * j)); \
                X[2 * j] = *(const f32x4*)(x + (size_t)(mm) * DM + 8 * (lane + 64 * j)); X[2 * j + 1] = *(const f32x4*)(x + (size_t)(mm) * DM + 8 * (lane + 64 * j) + 4); } } while (0)
            if (gw < M) P11_LOAD(gw, oqn, xqn);
            for (int m = gw; m < M; m += NGW) {
                const int b = m >> 11;
#pragma unroll
                for (int j = 0; j < 2; ++j) { oq[j] = oqn[j]; xq[2 * j] = xqn[2 * j]; xq[2 * j + 1] = xqn[2 * j + 1]; }
                if (m + NGW < M) P11_LOAD(m + NGW, oqn, xqn);
                float o[2][8]; float s = 0.f;
#pragma unroll
                for (int j = 0; j < 2; ++j) { unpack8(oq[j], o[j]);
#pragma unroll
                    for (int e = 0; e < 8; ++e) s += o[j][e] * o[j][e]; }
                const float rinv = 1.0f / sqrtf(wave_sum(s) * (1.f / DM) + 1e-6f);
#pragma unroll
                for (int j = 0; j < 2; ++j) { const int c = 8 * (lane + 64 * j);
#pragma unroll
                    for (int hlf = 0; hlf < 2; ++hlf) { const int cc = c + 4 * hlf;
                        const f32x4 gp = *(const f32x4*)(gpost + cc), gt = *(const f32x4*)(ADA + b * 3072 + 2048 + cc);
                        f32x4 ov; ov.x = o[j][4 * hlf + 0]; ov.y = o[j][4 * hlf + 1]; ov.z = o[j][4 * hlf + 2]; ov.w = o[j][4 * hlf + 3];
                        *(f32x4*)(out + (size_t)m * DM + cc) = xq[2 * j + hlf] + gt * (ov * rinv * gp); } }
            }
#undef P11_LOAD
        }
    }
#undef IN
#undef BOTH
#undef GRID_BAR
}

extern "C" void kernel_launch(void* const* d_in, const int* in_sizes, int n_in, void* d_out, int out_size, void* d_ws, size_t ws_size, hipStream_t stream) {
    static int grid = 0;
    if (grid == 0) {
        if (n_in != NIN || in_sizes[0] != M * DM || out_size != M * DM || ws_size < WS_END) { fprintf(stderr, "kernel_launch: unexpected shapes: n_in %d in0 %d out %d ws %zu (need %zu)\n", n_in, n_in > 0 ? in_sizes[0] : -1, out_size, ws_size, (size_t)WS_END); grid = -1; return; }
        int dev = 0, cus = 0;
        if (hipGetDevice(&dev) != hipSuccess || hipDeviceGetAttribute(&cus, hipDeviceAttributeMultiprocessorCount, dev) != hipSuccess) { fprintf(stderr, "kernel_launch: device query failed\n"); grid = -1; return; }
        if (hipFuncSetAttribute((const void*)mk_fwd, hipFuncAttributeMaxDynamicSharedMemorySize, LDS_BYTES) != hipSuccess) { fprintf(stderr, "kernel_launch: hipFuncSetAttribute failed\n"); grid = -1; return; }
        (void)hipGetLastError();
        grid = cus;
        if (grid != 256) fprintf(stderr, "kernel_launch: %d CUs (built for 256)\n", grid);
    }
    if (grid < 0) return;
    if (hipMemsetAsync((char*)d_ws + WS_CTL, 0, CTL_ZERO_BYTES, stream) != hipSuccess) { fprintf(stderr, "kernel_launch: memset failed\n"); return; }
    Args a{};
    for (int i = 0; i < NIN; ++i) a.in[i] = (const float*)d_in[i];
    a.out = (float*)d_out; a.ws = (unsigned char*)d_ws;
    static const int plan[][2] = MK_PLAN;
    const int nl = (int)(sizeof(plan) / sizeof(plan[0]));
    for (int li = 0; li < nl; ++li) {
        a.ph_lo = plan[li][0]; a.ph_hi = plan[li][1]; a.li = li; a.pad = (li < nl - 1) ? MK_PROBE_FLAGS : 0;
        hipLaunchKernelGGL(mk_fwd, dim3(grid), dim3(NWAVES * 64), LDS_BYTES, stream, a);
        const hipError_t le = hipPeekAtLastError();
        if (le != hipSuccess) { fprintf(stderr, "kernel_launch: launch %d failed: %s\n", li, hipGetErrorName(le)); break; }
    }
}
```

```cpp
#include <hip/hip_runtime.h>
#include <cstdio>
#include <cstdint>
namespace pg8 {
#define PG8_LAS __attribute__((address_space(3)))
typedef unsigned short bf16_t;
typedef short bf16x8 __attribute__((ext_vector_type(8)));
typedef float f32x4 __attribute__((ext_vector_type(4)));
typedef unsigned u32x4 __attribute__((ext_vector_type(4)));
constexpr int BM = 256, BK = 64, HALF = 128, HTB = HALF * BK * 2  , STAGE_BYTES = 8 * HTB, NXCD = 8, WGM = 8;

__host__ __device__ __forceinline__ int lds_byte(int r, int c) { const int st = (r >> 4) * 2 + (c >> 5), rr = r & 15, cc = c & 31, ob = rr * 64 + cc * 2; return st * 1024 + (ob ^ (((ob >> 9) & 1) << 5)); }
__host__ __device__ __forceinline__ void stage_rc(int b, int& R, int& C) { const int st = b / 1024, sb = b % 1024, swz = sb ^ (((sb >> 9) & 1) << 5); R = (st >> 1) * 16 + swz / 64; C = (st & 1) * 32 + (swz % 64) / 2; }
__host__ __device__ __forceinline__ int perm32(int rho) { const int n = rho >> 4, i = rho & 15; return 8 * (i >> 2) + 4 * n + (i & 3); }

struct Unit { int pm, pn; };
struct Gemm { const bf16_t* A; const bf16_t* Bt; int M, N, K, lda; int asplit_pn, asplit_off; };

struct StaticOrder {
    int nM, nN, nwg, G, c;
    __host__ __device__ void init(int M, int N, int G_, int c_) { nM = M / BM; nN = N / BM; nwg = nM * nN; G = G_; c = c_; }
    __host__ __device__ bool next(int i, Unit& u) const {
        const long L = (long)i * G + c; if (L >= nwg) return false;
        int wgid = (int)L; { const int q = nwg / NXCD, r = nwg % NXCD, xcd = wgid % NXCD, off = wgid / NXCD; wgid = (xcd < r ? xcd * (q + 1) : r * (q + 1) + (xcd - r) * q) + off; }
        const int nig = WGM * nN, gid = wgid / nig, fm = gid * WGM, gsz = (nM - fm) < WGM ? (nM - fm) : WGM;
        u.pm = fm + ((wgid % nig) % gsz); u.pn = (wgid % nig) / gsz; return true;
    }
    __device__ __forceinline__ void a_ready(const Unit&) const {}
    __device__ __forceinline__ void done(const Unit&) const {}
};

__device__ __forceinline__ unsigned cvt_pk_bf16(float lo, float hi) { unsigned r; asm volatile("v_cvt_pk_bf16_f32 %0, %1, %2" : "=v"(r) : "v"(lo), "v"(hi)); return r; }
typedef float f32x2 __attribute__((ext_vector_type(2)));
__device__ __forceinline__ f32x2 gelu_pk(f32x2 v) {
    const f32x2 av = __builtin_elementwise_abs(v), d = av * 0.2316418882f + 1.0f;
    f32x2 t; t.x = __builtin_amdgcn_rcpf(d.x); t.y = __builtin_amdgcn_rcpf(d.y);
    f32x2 q = t * 0.5307027145f + (-0.7265760135f); q = q * t + 0.7107068705f; q = q * t + (-0.142248368f); q = q * t + 0.127414796f; q = q * t;
    const f32x2 s = (v * v) * (-0.72134752044f);
    f32x2 e; e.x = __builtin_amdgcn_exp2f(s.x); e.y = __builtin_amdgcn_exp2f(s.y);
    const f32x2 m = v * (q * e), r = v - m;
    f32x2 o; o.x = v.x < 0.f ? m.x : r.x; o.y = v.y < 0.f ? m.y : r.y; return o;
}

template <int ACT  > struct EpiBf16 {
    static constexpr bool PERM = true, AFTER_DRAIN = false; static_assert(ACT == 0 || ACT == 1, "EpiBf16: ACT is 0 (none) or 1 (gelu_pk)");
    bf16_t* O; int ldc; const float* bias; int split_cols; size_t split_stride; float scale0;
    __device__ __forceinline__ void operator()(const f32x4 (&acc)[2][2][4][2], const Unit& u, int wr, int wc, int fr, int fq) const {
        const int row0 = u.pm * BM + wr * 64 + fr; int colt = u.pn * BM; bf16_t* base = O;
        float sc = 1.f; if (split_cols) { const int t = colt / split_cols; base += (size_t)t * split_stride; colt -= t * split_cols; if (t == 0) sc = scale0; }
        const int col0 = colt + wc * 32 + 8 * fq, bcol0 = u.pn * BM + wc * 32 + 8 * fq;
        f32x4 bv[2][2];
#pragma unroll
        for (int bj = 0; bj < 2; ++bj)
#pragma unroll
            for (int n = 0; n < 2; ++n) bv[bj][n] = bias ? *(const f32x4*)(bias + bcol0 + bj * HALF + 4 * n) : (f32x4){0.f, 0.f, 0.f, 0.f};
#pragma unroll
        for (int ai = 0; ai < 2; ++ai)
#pragma unroll
            for (int m = 0; m < 4; ++m) { bf16_t* rowp = base + (size_t)(row0 + ai * HALF + m * 16) * ldc + col0;
#pragma unroll
                for (int bj = 0; bj < 2; ++bj) { f32x4 v0 = acc[ai][bj][m][0] + bv[bj][0], v1 = acc[ai][bj][m][1] + bv[bj][1];
                    if (ACT == 1) { f32x2 a = gelu_pk((f32x2){v0[0], v0[1]}), b = gelu_pk((f32x2){v0[2], v0[3]}), c = gelu_pk((f32x2){v1[0], v1[1]}), d = gelu_pk((f32x2){v1[2], v1[3]});
                        v0 = (f32x4){a.x, a.y, b.x, b.y}; v1 = (f32x4){c.x, c.y, d.x, d.y}; }
                    v0 = v0 * sc; v1 = v1 * sc; u32x4 w; w.x = cvt_pk_bf16(v0[0], v0[1]); w.y = cvt_pk_bf16(v0[2], v0[3]); w.z = cvt_pk_bf16(v1[0], v1[1]); w.w = cvt_pk_bf16(v1[2], v1[3]);
                    *(u32x4*)(rowp + bj * HALF) = w; } }
    }
};
template <class Epi, class Sched, bool ALIGN_EPI = false, bool SP2 = false>
__device__ __forceinline__ void gemm_phase(PG8_LAS unsigned char* lds, const Gemm g, const Sched& S, const Epi& E) {
    const int tid = threadIdx.x, wid = __builtin_amdgcn_readfirstlane(tid >> 6), lane = tid & 63, wr = wid >> 2, wc = wid & 3, fr = lane & 15, fq = lane >> 4;
    const int K = g.K, nt = K / BK;
    unsigned voffA[2], voffB[2];
#pragma unroll
    for (int i = 0; i < 2; ++i) { int R, C; stage_rc(tid * 16 + i * 8192, R, C); const int Rb = Epi::PERM ? ((R & ~31) + perm32(R & 31)) : R;
        voffA[i] = (unsigned)(R * g.lda + C) * 2u; voffB[i] = (unsigned)(Rb * K + C) * 2u; }
    const size_t kstep = (size_t)(BK * 2);
    const size_t hstepB = (size_t)HALF * K * 2, hstepA = (size_t)HALF * g.lda * 2;
    const size_t tstepB = 2 * hstepB, tstepA = 2 * hstepA;
    const unsigned ldsw = (unsigned)wid * 1024u;
    const int aoff = lds_byte(wr * 64 + fr, fq * 8), boff = lds_byte(wc * 32 + fr, fq * 8);
#define PG8_SA(b, h) (((b) * 2 + (h)) * HTB)
#define PG8_SB(b, h) ((4 + (b) * 2 + (h)) * HTB)
#define PG8_STAGE(bufoff, gbase, voff) do { _Pragma("unroll") for (int _i = 0; _i < 2; ++_i) \
        __builtin_amdgcn_global_load_lds((const unsigned*)((const char*)(gbase) + (voff)[_i]), (PG8_LAS unsigned*)(lds + (bufoff) + ldsw + _i * 8192), 16, 0, 0); } while (0)
#define PG8_LDA(dst, b, h) do { _Pragma("unroll") for (int m = 0; m < 4; ++m) _Pragma("unroll") for (int k = 0; k < 2; ++k) dst[m][k] = *(const PG8_LAS bf16x8*)(lds + PG8_SA(b, h) + aoff + m * 2048 + k * 1024); } while (0)
#define PG8_LDB(dst, b, h) do { _Pragma("unroll") for (int n = 0; n < 2; ++n) _Pragma("unroll") for (int k = 0; k < 2; ++k) dst[n][k] = *(const PG8_LAS bf16x8*)(lds + PG8_SB(b, h) + boff + n * 2048 + k * 1024); } while (0)
#define PG8_MMA(ai, bj, At, Bt) do { __builtin_amdgcn_s_setprio(1); _Pragma("unroll") for (int m = 0; m < 4; ++m) _Pragma("unroll") for (int n = 0; n < 2; ++n) _Pragma("unroll") for (int k = 0; k < 2; ++k) \
        acc[ai][bj][m][n] = __builtin_amdgcn_mfma_f32_16x16x32_bf16(Bt[n][k], At[m][k], acc[ai][bj][m][n], 0, 0, 0); __builtin_amdgcn_s_setprio(0); } while (0)
#define PG8_WAIT_V(n) asm volatile("s_waitcnt vmcnt(" #n ")" ::: "memory")
#define PG8_WAIT_L(n) asm volatile("s_waitcnt lgkmcnt(" #n ")" ::: "memory")
#define PG8_BAR __builtin_amdgcn_s_barrier()
#define PG8_SCHED __builtin_amdgcn_sched_barrier(0)
    Unit cur, nxt; int ui = 0;
    if (!S.next(0, cur)) return;
    f32x4 acc[2][2][4][2];
#pragma unroll
    for (int a = 0; a < 2; ++a)
#pragma unroll
        for (int b = 0; b < 2; ++b)
#pragma unroll
            for (int m = 0; m < 4; ++m)
#pragma unroll
                for (int n = 0; n < 2; ++n) acc[a][b][m][n] = (f32x4){0.f, 0.f, 0.f, 0.f};
    bf16x8 At[4][2], B0[2][2], B1[2][2];
    const char* cA = (const char*)g.A + (size_t)cur.pm * tstepA + (cur.pn >= g.asplit_pn ? g.asplit_off : 0); const char* cB = (const char*)g.Bt + (size_t)cur.pn * tstepB;
    S.a_ready(cur);
    if constexpr (SP2) {
        PG8_STAGE(PG8_SB(0, 0), cB, voffB); PG8_STAGE(PG8_SB(0, 1), cB + hstepB, voffB); PG8_STAGE(PG8_SA(0, 0), cA, voffA); PG8_STAGE(PG8_SA(0, 1), cA + hstepA, voffA);
        if (wr == 1) PG8_BAR;
        PG8_WAIT_V(2); PG8_BAR;
        PG8_STAGE(PG8_SB(1, 0), cB + kstep, voffB); PG8_STAGE(PG8_SA(1, 0), cA + kstep, voffA); PG8_STAGE(PG8_SB(1, 1), cB + hstepB + kstep, voffB);
        PG8_WAIT_V(6); PG8_BAR;
    } else {
        PG8_STAGE(PG8_SB(0, 0), cB, voffB); PG8_STAGE(PG8_SA(0, 0), cA, voffA); PG8_STAGE(PG8_SB(0, 1), cB + hstepB, voffB); PG8_STAGE(PG8_SA(0, 1), cA + hstepA, voffA);
        if (wr == 1) PG8_BAR;
        PG8_WAIT_V(4); PG8_BAR;
        PG8_STAGE(PG8_SB(1, 0), cB + kstep, voffB); PG8_STAGE(PG8_SA(1, 0), cA + kstep, voffA); PG8_STAGE(PG8_SB(1, 1), cB + hstepB + kstep, voffB);
        PG8_WAIT_V(6); PG8_BAR;
    }
    for (;;) {
        const bool has_next = S.next(ui + 1, nxt);
        const char* nA = has_next ? (const char*)g.A + (size_t)nxt.pm * tstepA + (nxt.pn >= g.asplit_pn ? g.asplit_off : 0) : cA; const char* nB = has_next ? (const char*)g.Bt + (size_t)nxt.pn * tstepB : cB;
        for (int t = 0; t < nt; t += 2) {
            const bool last = (t == nt - 2);
            const char* a1 = cA + (size_t)(t + 1) * kstep;
            const char* a2 = last ? nA : cA + (size_t)(t + 2) * kstep; const char* b2 = last ? nB : cB + (size_t)(t + 2) * kstep;
            const char* a3 = a2 + kstep; const char* b3 = b2 + kstep;
            if (last && has_next) S.a_ready(nxt);
            if constexpr (SP2) {
            PG8_LDB(B0, 0, 0); PG8_LDB(B1, 0, 1); PG8_SCHED; PG8_LDA(At, 0, 0); PG8_STAGE(PG8_SA(1, 1), a1 + hstepA, voffA);
            PG8_WAIT_V(8); PG8_WAIT_L(0); PG8_BAR; PG8_MMA(0, 0, At, B0); PG8_MMA(0, 1, At, B1); PG8_BAR; PG8_SCHED;
            PG8_LDA(At, 0, 1); PG8_STAGE(PG8_SB(0, 0), b2, voffB); PG8_STAGE(PG8_SB(0, 1), b2 + hstepB, voffB); PG8_STAGE(PG8_SA(0, 0), a2, voffA);
            PG8_WAIT_V(8); PG8_WAIT_L(0); PG8_BAR; PG8_MMA(1, 0, At, B0); PG8_MMA(1, 1, At, B1); PG8_BAR; PG8_SCHED;
            PG8_LDB(B0, 1, 0); PG8_LDB(B1, 1, 1); PG8_SCHED; PG8_LDA(At, 1, 0); PG8_STAGE(PG8_SA(0, 1), a2 + hstepA, voffA);
            PG8_WAIT_V(8); PG8_WAIT_L(0); PG8_BAR; PG8_MMA(0, 0, At, B0); PG8_MMA(0, 1, At, B1); PG8_BAR; PG8_SCHED;
            PG8_LDA(At, 1, 1); PG8_STAGE(PG8_SB(1, 0), b3, voffB); PG8_STAGE(PG8_SB(1, 1), b3 + hstepB, voffB); PG8_STAGE(PG8_SA(1, 0), a3, voffA);
            PG8_WAIT_V(8); PG8_WAIT_L(0); PG8_BAR; PG8_MMA(1, 0, At, B0); PG8_MMA(1, 1, At, B1); PG8_BAR; PG8_SCHED;
            } else {
            PG8_LDB(B0, 0, 0); PG8_SCHED; PG8_LDA(At, 0, 0); PG8_STAGE(PG8_SA(1, 1), a1 + hstepA, voffA);
            PG8_WAIT_L(8); PG8_BAR; PG8_WAIT_L(0); PG8_MMA(0, 0, At, B0); PG8_BAR; PG8_SCHED;
            PG8_LDB(B1, 0, 1); PG8_STAGE(PG8_SB(0, 0), b2, voffB);
            PG8_BAR; PG8_WAIT_L(0); PG8_MMA(0, 1, At, B1); PG8_BAR;
            PG8_LDA(At, 0, 1); PG8_STAGE(PG8_SA(0, 0), a2, voffA);
            PG8_BAR; PG8_WAIT_L(0); PG8_MMA(1, 0, At, B0); PG8_BAR; PG8_SCHED;
            PG8_STAGE(PG8_SB(0, 1), b2 + hstepB, voffB);
            PG8_WAIT_V(6); PG8_BAR; PG8_MMA(1, 1, At, B1); PG8_BAR;
            PG8_LDB(B0, 1, 0); PG8_SCHED; PG8_LDA(At, 1, 0); PG8_STAGE(PG8_SA(0, 1), a2 + hstepA, voffA);
            PG8_WAIT_L(8); PG8_BAR; PG8_WAIT_L(0); PG8_MMA(0, 0, At, B0); PG8_BAR; PG8_SCHED;
            PG8_LDB(B1, 1, 1); PG8_STAGE(PG8_SB(1, 0), b3, voffB);
            PG8_BAR; PG8_WAIT_L(0); PG8_MMA(0, 1, At, B1); PG8_BAR;
            PG8_LDA(At, 1, 1); PG8_STAGE(PG8_SA(1, 0), a3, voffA);
            PG8_BAR; PG8_WAIT_L(0); PG8_MMA(1, 0, At, B0); PG8_BAR; PG8_SCHED;
            PG8_STAGE(PG8_SB(1, 1), b3 + hstepB, voffB);
            PG8_WAIT_V(6); PG8_BAR; PG8_MMA(1, 1, At, B1); PG8_BAR;
            }
        }
        if constexpr (ALIGN_EPI) { if (wr == 0) PG8_BAR; }
        if constexpr (!Epi::AFTER_DRAIN) { E(acc, cur, wr, wc, fr, fq); S.done(cur); }
        if (!has_next) break;
#pragma unroll
        for (int a = 0; a < 2; ++a)
#pragma unroll
            for (int b = 0; b < 2; ++b)
#pragma unroll
                for (int m = 0; m < 4; ++m)
#pragma unroll
                    for (int n = 0; n < 2; ++n) acc[a][b][m][n] = (f32x4){0.f, 0.f, 0.f, 0.f};
        cur = nxt; cA = nA; cB = nB; ++ui;
        if constexpr (ALIGN_EPI) { if (wr == 1) PG8_BAR; }
    }
    PG8_WAIT_V(0);
    if constexpr (!ALIGN_EPI) { if (wr == 0) PG8_BAR; }
    PG8_BAR;
    if constexpr (Epi::AFTER_DRAIN) { E.fused(acc, cur, wr, wc, fr, fq, lds, wid, lane); S.done(cur); }
#undef PG8_SA
#undef PG8_SB
#undef PG8_STAGE
#undef PG8_LDA
#undef PG8_LDB
#undef PG8_MMA
#undef PG8_WAIT_V
#undef PG8_WAIT_L
#undef PG8_BAR
#undef PG8_SCHED
}
}
namespace pg8 {
struct EpiRoute {
    static constexpr bool PERM = true, AFTER_DRAIN = false;
    bf16_t* base0; bf16_t* base1; int ldc0, ldc1, tile1;
    __device__ __forceinline__ void operator()(const f32x4 (&acc)[2][2][4][2], const Unit& u, int wr, int wc, int fr, int fq) const {
        const bool second = u.pn >= tile1;
        bf16_t* O = second ? base1 : base0; const int ld = second ? ldc1 : ldc0; const int colt = (second ? u.pn - tile1 : u.pn) * BM;
        const int row0 = u.pm * BM + wr * 64 + fr;
        const int col0 = colt + wc * 32 + 8 * fq;
#pragma unroll
        for (int ai = 0; ai < 2; ++ai)
#pragma unroll
            for (int m = 0; m < 4; ++m) { bf16_t* rowp = O + (size_t)(row0 + ai * HALF + m * 16) * ld + col0;
#pragma unroll
                for (int bj = 0; bj < 2; ++bj) { const f32x4 v0 = acc[ai][bj][m][0], v1 = acc[ai][bj][m][1];
                    u32x4 w; w.x = cvt_pk_bf16(v0[0], v0[1]); w.y = cvt_pk_bf16(v0[2], v0[3]); w.z = cvt_pk_bf16(v1[0], v1[1]); w.w = cvt_pk_bf16(v1[2], v1[3]);
                    *(u32x4*)(rowp + bj * HALF) = w; } }
    }
};
}
namespace pg8 {
__device__ __forceinline__ float sigm(float x) { return __builtin_amdgcn_rcpf(1.0f + __expf(-x)); }
struct EpiLora {
    static constexpr bool PERM = true, AFTER_DRAIN = false;
    bf16_t* O; const float* w0; const float* a0;
    __device__ __forceinline__ void operator()(const f32x4 (&acc)[2][2][4][2], const Unit& u, int wr, int wc, int fr, int fq) const {
        const int row0 = u.pm * BM + wr * 64 + fr, col0 = u.pn * BM + wc * 32 + 8 * fq;
        const float* par = (u.pn >= 4) ? (a0 - 1024) : w0;
#pragma unroll
        for (int ai = 0; ai < 2; ++ai)
#pragma unroll
            for (int m = 0; m < 4; ++m) {
#pragma unroll
                for (int bj = 0; bj < 2; ++bj) { bf16_t* rowp = O + (size_t)(row0 + ai * HALF + m * 16) * 2048 + col0 + bj * HALF;
                    const f32x4 x0 = acc[ai][bj][m][0] + *(const f32x4*)(par + col0 + bj * HALF), x1 = acc[ai][bj][m][1] + *(const f32x4*)(par + col0 + bj * HALF + 4); u32x4 w;
                    w.x = cvt_pk_bf16(sigm(x0[0]), sigm(x0[1])); w.y = cvt_pk_bf16(sigm(x0[2]), sigm(x0[3])); w.z = cvt_pk_bf16(sigm(x1[0]), sigm(x1[1])); w.w = cvt_pk_bf16(sigm(x1[2]), sigm(x1[3]));
                    *(u32x4*)rowp = w; }
                asm volatile("" ::: "memory"); }
    }
};
template <int MODE> struct EpiGate {
    static constexpr bool PERM = true, AFTER_DRAIN = false;
    bf16_t* O; const bf16_t* Gl;
    __device__ __forceinline__ void operator()(const f32x4 (&acc)[2][2][4][2], const Unit& u, int wr, int wc, int fr, int fq) const {
        const int row0 = u.pm * BM + wr * 64 + fr, col0 = u.pn * BM + wc * 32 + 8 * fq;
#pragma unroll
        for (int ai = 0; ai < 2; ++ai) {
            u32x4 gq[4][2], tq[4][2];
#pragma unroll
            for (int m = 0; m < 4; ++m)
#pragma unroll
                for (int bj = 0; bj < 2; ++bj) { const size_t row = (size_t)(row0 + ai * HALF + m * 16); const int col = col0 + bj * HALF;
                    gq[m][bj] = *(const u32x4*)(Gl + row * 2048 + MODE * 1024 + col);
                    if (MODE == 1) tq[m][bj] = *(const u32x4*)(O + row * 1024 + col); }
#pragma unroll
            for (int m = 0; m < 4; ++m)
#pragma unroll
                for (int bj = 0; bj < 2; ++bj) { const size_t row = (size_t)(row0 + ai * HALF + m * 16); const int col = col0 + bj * HALF;
                    const unsigned gw[4] = {gq[m][bj].x, gq[m][bj].y, gq[m][bj].z, gq[m][bj].w}; float g[8];
#pragma unroll
                    for (int e = 0; e < 4; ++e) { g[2 * e] = sigm(__builtin_bit_cast(float, gw[e] << 16)); g[2 * e + 1] = sigm(__builtin_bit_cast(float, gw[e] & 0xffff0000u)); }
                    const f32x4 v0 = acc[ai][bj][m][0], v1 = acc[ai][bj][m][1];
                    float r[8] = {g[0] * v0[0], g[1] * v0[1], g[2] * v0[2], g[3] * v0[3], g[4] * v1[0], g[5] * v1[1], g[6] * v1[2], g[7] * v1[3]};
                    if (MODE == 1) { const unsigned tw[4] = {tq[m][bj].x, tq[m][bj].y, tq[m][bj].z, tq[m][bj].w};
#pragma unroll
                        for (int e = 0; e < 4; ++e) { r[2 * e] += __builtin_bit_cast(float, tw[e] << 16); r[2 * e + 1] += __builtin_bit_cast(float, tw[e] & 0xffff0000u); } }
                    u32x4 w; w.x = cvt_pk_bf16(r[0], r[1]); w.y = cvt_pk_bf16(r[2], r[3]); w.z = cvt_pk_bf16(r[4], r[5]); w.w = cvt_pk_bf16(r[6], r[7]);
                    *(u32x4*)(O + row * 1024 + col) = w; }
        }
    }
};
}
namespace pg8 {
struct EpiGateCat {
    static constexpr bool PERM = true, AFTER_DRAIN = false;
    bf16_t* O; const bf16_t* Gl;
    __device__ __forceinline__ void mid(f32x4 (&acc)[2][2][4][2], const Unit& u, int wr, int wc, int fr, int fq) const {
        const int row0 = u.pm * BM + wr * 64 + fr, col0 = u.pn * BM + wc * 32 + 8 * fq;
#pragma unroll
        for (int ai = 0; ai < 2; ++ai) {
            u32x4 gr[4][2], ga[4][2];
#pragma unroll
            for (int m = 0; m < 4; ++m)
#pragma unroll
                for (int bj = 0; bj < 2; ++bj) { const size_t row = (size_t)(row0 + ai * HALF + m * 16); const int col = col0 + bj * HALF;
                    gr[m][bj] = *(const u32x4*)(Gl + row * 2048 + col); ga[m][bj] = *(const u32x4*)(Gl + row * 2048 + 1024 + col); }
#pragma unroll
            for (int m = 0; m < 4; ++m)
#pragma unroll
                for (int bj = 0; bj < 2; ++bj) { const unsigned wr_[4] = {gr[m][bj].x, gr[m][bj].y, gr[m][bj].z, gr[m][bj].w}, wa_[4] = {ga[m][bj].x, ga[m][bj].y, ga[m][bj].z, ga[m][bj].w}; float rt[8];
#pragma unroll
                    for (int e = 0; e < 4; ++e) {
                        const float r0 = __builtin_bit_cast(float, wr_[e] << 16), r1 = __builtin_bit_cast(float, wr_[e] & 0xffff0000u), a0 = __builtin_bit_cast(float, wa_[e] << 16), a1 = __builtin_bit_cast(float, wa_[e] & 0xffff0000u);
                        rt[2 * e] = (1.0f + __expf(-a0)) * __builtin_amdgcn_rcpf(1.0f + __expf(-r0)); rt[2 * e + 1] = (1.0f + __expf(-a1)) * __builtin_amdgcn_rcpf(1.0f + __expf(-r1)); }
                    acc[ai][bj][m][0] = acc[ai][bj][m][0] * (f32x4){rt[0], rt[1], rt[2], rt[3]}; acc[ai][bj][m][1] = acc[ai][bj][m][1] * (f32x4){rt[4], rt[5], rt[6], rt[7]}; }
        }
    }
    __device__ __forceinline__ void operator()(const f32x4 (&acc)[2][2][4][2], const Unit& u, int wr, int wc, int fr, int fq) const {
        const int row0 = u.pm * BM + wr * 64 + fr, col0 = u.pn * BM + wc * 32 + 8 * fq;
#pragma unroll
        for (int ai = 0; ai < 2; ++ai) {
            u32x4 ga[4][2];
#pragma unroll
            for (int m = 0; m < 4; ++m)
#pragma unroll
                for (int bj = 0; bj < 2; ++bj) { const size_t row = (size_t)(row0 + ai * HALF + m * 16); const int col = col0 + bj * HALF; ga[m][bj] = *(const u32x4*)(Gl + row * 2048 + 1024 + col); }
#pragma unroll
            for (int m = 0; m < 4; ++m)
#pragma unroll
                for (int bj = 0; bj < 2; ++bj) { const size_t row = (size_t)(row0 + ai * HALF + m * 16); const int col = col0 + bj * HALF;
                    const unsigned wa_[4] = {ga[m][bj].x, ga[m][bj].y, ga[m][bj].z, ga[m][bj].w}; float g[8];
#pragma unroll
                    for (int e = 0; e < 4; ++e) { g[2 * e] = sigm(__builtin_bit_cast(float, wa_[e] << 16)); g[2 * e + 1] = sigm(__builtin_bit_cast(float, wa_[e] & 0xffff0000u)); }
                    const f32x4 v0 = acc[ai][bj][m][0], v1 = acc[ai][bj][m][1];
                    u32x4 w; w.x = cvt_pk_bf16(g[0] * v0[0], g[1] * v0[1]); w.y = cvt_pk_bf16(g[2] * v0[2], g[3] * v0[3]); w.z = cvt_pk_bf16(g[4] * v1[0], g[5] * v1[1]); w.w = cvt_pk_bf16(g[6] * v1[2], g[7] * v1[3]);
                    *(u32x4*)(O + row * 1024 + col) = w; }
        }
    }
};
}
namespace pg8 {
template <int CTRL> __device__ __forceinline__ float dppz(float v) { return __builtin_bit_cast(float, __builtin_amdgcn_update_dpp(0, __builtin_bit_cast(int, v), CTRL, 0xf, 0xf, true)); }
struct EpiShift {
    static constexpr bool PERM = true, AFTER_DRAIN = false;
    bf16_t* R4;
    bf16_t* LAo;
    bf16_t* PAo;
    bf16_t* EDGE;
    const float* mu;
    PG8_LAS unsigned char* halo;
    int Mrows;
    __device__ __forceinline__ static int hidx(int wr, int wc, int ai, int edge, int bj, int n, int fq) { return ((((((wr * 4 + wc) * 2 + ai) * 2 + edge) * 2 + bj) * 2 + n) * 4 + fq) * 16; }
    __device__ __forceinline__ void operator()(const f32x4 (&acc)[2][2][4][2], const Unit& u, int wr, int wc, int fr, int fq) const {
        const int row0 = u.pm * BM + wr * 64 + fr, colL = wc * 32 + 8 * fq;
        if (u.pn >= 9) {
            const int col0 = (u.pn - 9) * BM + colL;
#pragma unroll
            for (int ai = 0; ai < 2; ++ai)
#pragma unroll
                for (int m = 0; m < 4; ++m) { bf16_t* rowp = PAo + (size_t)(row0 + ai * HALF + m * 16) * 1280 + col0;
#pragma unroll
                    for (int bj = 0; bj < 2; ++bj) { const f32x4 v0 = acc[ai][bj][m][0], v1 = acc[ai][bj][m][1];
                        u32x4 w; w.x = cvt_pk_bf16(v0[0], v0[1]); w.y = cvt_pk_bf16(v0[2], v0[3]); w.z = cvt_pk_bf16(v1[0], v1[1]); w.w = cvt_pk_bf16(v1[2], v1[3]);
                        *(u32x4*)(rowp + bj * HALF) = w; } }
            return;
        }
        if (fr == 0 || fr == 15) { const int edge = fr == 15, mm = edge ? 3 : 0;
#pragma unroll
            for (int ai = 0; ai < 2; ++ai)
#pragma unroll
                for (int bj = 0; bj < 2; ++bj)
#pragma unroll
                    for (int n = 0; n < 2; ++n) *(PG8_LAS f32x4*)(halo + hidx(wr, wc, ai, edge, bj, n, fq)) = edge ? acc[ai][bj][3][n] : acc[ai][bj][0][n];
            (void)mm; }
        if ((wr == 0 && fr < 2) || (wr == 1 && fr >= 14)) { const int slot = wr == 0 ? fr : fr - 12;
            bf16_t* ep = EDGE + ((size_t)u.pm * 4 + slot) * 2304 + u.pn * BM + colL;
#pragma unroll
            for (int bj = 0; bj < 2; ++bj) { const f32x4 v0 = wr == 0 ? acc[0][bj][0][0] : acc[1][bj][3][0], v1 = wr == 0 ? acc[0][bj][0][1] : acc[1][bj][3][1];
                u32x4 w; w.x = cvt_pk_bf16(v0[0], v0[1]); w.y = cvt_pk_bf16(v0[2], v0[3]); w.z = cvt_pk_bf16(v1[0], v1[1]); w.w = cvt_pk_bf16(v1[2], v1[3]);
                *(u32x4*)(ep + bj * HALF) = w; } }
        asm volatile("s_waitcnt lgkmcnt(0)" ::: "memory");
        __builtin_amdgcn_s_barrier();
        asm volatile("" ::: "memory");
        const bool isla = u.pn == 8;
        bf16_t* obase = isla ? LAo : R4 + (size_t)(u.pn >> 1) * Mrows * 512 + (u.pn & 1) * 256;
        const int ld = isla ? 256 : 512;
#pragma unroll
        for (int bj = 0; bj < 2; ++bj) {
            const float* mup = mu + u.pn * BM + bj * HALF + colL;
            f32x4 m0[2], m1[2], c0[2];
#pragma unroll
            for (int n = 0; n < 2; ++n) { m0[n] = *(const f32x4*)(mup + 4 * n); m1[n] = *(const f32x4*)(mup + 2304 + 4 * n); c0[n] = 1.0f - m0[n] - m1[n]; }
#pragma unroll
            for (int ai = 0; ai < 2; ++ai) {
                f32x4 hp[2], hn[2];
                const bool hasp = (wr == 1) || (ai == 1), hasn = (wr == 0) || (ai == 0);
                const int pw = wr ^ 1, pai = (wr == 1) ? ai : 0, nai = (wr == 0) ? ai : 1;
#pragma unroll
                for (int n = 0; n < 2; ++n) { hp[n] = hasp ? *(const PG8_LAS f32x4*)(halo + hidx(pw, wc, pai, 1, bj, n, fq)) : (f32x4){0.f, 0.f, 0.f, 0.f};
                                              hn[n] = hasn ? *(const PG8_LAS f32x4*)(halo + hidx(pw, wc, nai, 0, bj, n, fq)) : (f32x4){0.f, 0.f, 0.f, 0.f}; }
                unsigned wq[4][4];
#pragma unroll
                for (int n = 0; n < 2; ++n) {
                    f32x4 A[4], B[4];
#pragma unroll
                    for (int m = 0; m < 4; ++m) { A[m] = acc[ai][bj][m][n] * m0[n]; B[m] = acc[ai][bj][m][n] * m1[n]; }
                    const f32x4 Ah = hp[n] * m0[n], Bh = hn[n] * m1[n];
#pragma unroll
                    for (int m = 0; m < 4; ++m) { const f32x4 p = acc[ai][bj][m][n], Am = m > 0 ? A[m > 0 ? m - 1 : 0] : Ah, Bp = m < 3 ? B[m < 3 ? m + 1 : 3] : Bh; float o[4];
#pragma unroll
                        for (int k = 0; k < 4; ++k) { float v = c0[n][k] * p[k];
                            v += dppz<0x111>(A[m][k]); v += dppz<0x10F>(Am[k]);
                            v += dppz<0x101>(B[m][k]); v += dppz<0x11F>(Bp[k]);
                            o[k] = v; }
                        if (isla && bj == 0) {
#pragma unroll
                            for (int e = 0; e < 4; ++e) o[e] = 1.0f - 2.0f * __builtin_amdgcn_rcpf(1.0f + __expf(2.0f * o[e])); }
                        wq[m][2 * n] = cvt_pk_bf16(o[0], o[1]); wq[m][2 * n + 1] = cvt_pk_bf16(o[2], o[3]); }
                }
#pragma unroll
                for (int m = 0; m < 4; ++m) { u32x4 w; w.x = wq[m][0]; w.y = wq[m][1]; w.z = wq[m][2]; w.w = wq[m][3];
                    *(u32x4*)(obase + (size_t)(row0 + ai * HALF + m * 16) * ld + bj * HALF + colL) = w; }
            }
        }
    }
};
}
#define GAS __attribute__((address_space(1)))
#define LAS __attribute__((address_space(3)))
typedef unsigned short bf16;
typedef unsigned v4u __attribute__((ext_vector_type(4)));
typedef float f32x4 __attribute__((ext_vector_type(4)));
typedef short bf16x8 __attribute__((ext_vector_type(8)));
typedef GAS unsigned gu32;
typedef GAS unsigned long long gu64;
#define RLX_AGENT __ATOMIC_RELAXED, __HIP_MEMORY_SCOPE_AGENT
#define LDS_WAIT() asm volatile("s_waitcnt lgkmcnt(0)" ::: "memory")
#define VM_WAIT() asm volatile("s_waitcnt vmcnt(0)" ::: "memory")
__device__ __forceinline__ unsigned long long rt() { return __builtin_amdgcn_s_memrealtime(); }
__device__ __forceinline__ unsigned f2bf(float f) { unsigned u = __builtin_bit_cast(unsigned, f); return (u + 0x7fffu + ((u >> 16) & 1u)) >> 16; }
__device__ __forceinline__ unsigned pk2(float lo, float hi) { return f2bf(lo) | (f2bf(hi) << 16); }
#define XB_TMO      128
#define XB_XCNT(j)  (256  + 64 * (j))
#define XB_XSUB(j)  (1280 + 64 * (j))
#define XB_XGEN(j)  (2304 + 64 * (j))
#define XB_TOP      3328
#define XB_TOPGEN   3392
#define XCD_BAR_WORDS 3456
#define XB_SPIN_CAP (1u << 18)

__device__ __forceinline__ unsigned xb_ld(unsigned* p)              { return __hip_atomic_load(p, __ATOMIC_RELAXED, __HIP_MEMORY_SCOPE_AGENT); }
__device__ __forceinline__ unsigned xb_add(unsigned* p, unsigned v) { return __hip_atomic_fetch_add(p, v, __ATOMIC_RELAXED, __HIP_MEMORY_SCOPE_AGENT); }
__device__ __forceinline__ unsigned xb_xcc_id() { return (unsigned)__builtin_amdgcn_s_getreg((3 << 11) | 20) & 0xFu; }
#define XB_SPIN(cond, bar) do { unsigned _sp = 0; while (cond) { __builtin_amdgcn_s_sleep(1); \
    if ((++_sp & 255u) == 0u) { if (xb_ld(&(bar)[XB_TMO])) break; if (_sp > XB_SPIN_CAP) { atomicAdd(&(bar)[XB_TMO], 1u); break; } } } } while (0)

struct XcdBarrier {
    unsigned* bar; unsigned x;
    volatile LAS unsigned* st;
};

__device__ __forceinline__ XcdBarrier xcd_barrier_post(unsigned* bar, volatile LAS unsigned* st) {
    XcdBarrier b; b.bar = bar; b.x = xb_xcc_id(); b.st = st;
    if (threadIdx.x == 0) (void)xb_add(&bar[XB_XCNT(b.x)], 1u);
    return b;
}
__device__ __forceinline__ void xcd_barrier_complete(unsigned* bar, unsigned x, unsigned& nloc, unsigned& nx) {
    const unsigned G = gridDim.x * gridDim.y * gridDim.z;
    unsigned sum, cnt, mine, sp = 0u;
    for (;;) {
        sum = 0u; cnt = 0u; mine = 0u;
#pragma unroll
        for (unsigned j = 0; j < 16; ++j) { const unsigned c = xb_ld(&bar[XB_XCNT(j)]); sum += c; cnt += (c > 0u) ? 1u : 0u; mine = (j == x) ? c : mine; }
        if (sum == G) break;
        __builtin_amdgcn_s_sleep(1);
        if ((++sp & 255u) == 0u) { if (xb_ld(&bar[XB_TMO])) break; if (sp > XB_SPIN_CAP) { atomicAdd(&bar[XB_TMO], 1u); break; } }
    }
    nloc = mine > 0u ? mine : 1u; nx = cnt > 0u ? cnt : 1u;
}

__device__ __forceinline__ void xcd_barrier(const XcdBarrier& b) {
    asm volatile("s_waitcnt vmcnt(0)" ::: "memory");
    __syncthreads();
    if (threadIdx.x == 0) {
        unsigned* bar = b.bar;
        __builtin_amdgcn_s_waitcnt(0);
        unsigned nloc = b.st[0], nx = b.st[1];
        if (nloc == 0u) { xcd_barrier_complete(bar, b.x, nloc, nx); b.st[0] = nloc; b.st[1] = nx; }
        const unsigned old = xb_add(&bar[XB_XSUB(b.x)], 1u);
        const unsigned gen = old / nloc;
        if (old + 1u == (gen + 1u) * nloc) {
            __builtin_amdgcn_fence(__ATOMIC_RELEASE, "agent");
            asm volatile("s_waitcnt vmcnt(0)" ::: "memory");
            const unsigned og = xb_add(&bar[XB_TOP], 1u);
            const unsigned tg = og / nx;
            if (og + 1u == (tg + 1u) * nx) xb_add(&bar[XB_TOPGEN], 1u);
            else XB_SPIN(xb_ld(&bar[XB_TOPGEN]) == tg, bar);
            __builtin_amdgcn_fence(__ATOMIC_ACQUIRE, "agent");
            xb_add(&bar[XB_XGEN(b.x)], 1u);
            asm volatile("s_waitcnt vmcnt(0)" ::: "memory");
        } else {
            XB_SPIN(xb_ld(&bar[XB_XGEN(b.x)]) == gen, bar);
            __builtin_amdgcn_fence(__ATOMIC_ACQUIRE, "agent");
            asm volatile("s_waitcnt vmcnt(0)" ::: "memory");
        }
    }
    __syncthreads();
}
constexpr int NWAVES = 8;
constexpr int BATCH = 32, SEQ = 2048, DM = 1024, M = BATCH * SEQ;
constexpr int RW = 512, RCOLS = 2304, ACOLS = 1280, GCOLS = 2048;
enum { I_X = 0, I_C, I_WADA, I_BADA, I_GPRE, I_GPOST, I_WIN, I_MU, I_W0, I_WUP, I_A0, I_AUP, I_KK, I_KA, I_RK, I_GNW, I_GNB, I_SINK, I_WBRR, I_WBRA, I_WOUT, NIN };
#ifndef MK_N_LAUNCHES
#define MK_N_LAUNCHES 1
#endif
constexpr int N_PHASES = 12;
#ifndef MK_PLAN
#define MK_PLAN {{0, N_PHASES}}
#endif
#ifndef MK_PROBE_FLAGS
#define MK_PROBE_FLAGS 0
#endif
constexpr int N_LAUNCHES = MK_N_LAUNCHES;
constexpr size_t MiB = 1u << 20;
constexpr size_t WS_CTL = 0, CTL_ZERO_BYTES = 1 * MiB;
constexpr size_t WS_ADA = 512 * 1024;
constexpr size_t WS_BSUM = 2 * MiB;
constexpr size_t WS_BP4 = 984 * MiB;
constexpr size_t WS_WINT = 4 * MiB;
constexpr size_t WS_WBRR = 15 * MiB, WS_WBRA = 16 * MiB, WS_WOUT = 17 * MiB, WS_WLORA = 19 * MiB;
constexpr size_t WS_H = 24 * MiB;
constexpr size_t WS_PA = 152 * MiB;
constexpr size_t WS_PR = 312 * MiB;
constexpr size_t WS_KD1 = 568 * MiB;
constexpr size_t WS_LA = 600 * MiB;
constexpr size_t WS_R = 632 * MiB, WS_K = 696 * MiB, WS_V = 760 * MiB, WS_G = 824 * MiB, WS_KK = 888 * MiB;
constexpr size_t WS_MG = 568 * MiB;
constexpr size_t WS_PG = 312 * MiB;
constexpr size_t WS_BR = 568 * MiB;
constexpr size_t WS_BA = 824 * MiB;
constexpr size_t WS_KB = 952 * MiB, WS_VB = 968 * MiB;
constexpr size_t WS_EDGE = 992 * MiB;
constexpr size_t WS_END = 1024 * MiB;
constexpr int CW_BAR = 4096;
constexpr int RING_BYTES = 155648, LDSCTL_OFF = RING_BYTES, MISC_OFF = LDSCTL_OFF + 320, LDS_BYTES = 163840;

__device__ __forceinline__ float bflo(unsigned w) { return __builtin_bit_cast(float, w << 16); }
__device__ __forceinline__ float bfhi(unsigned w) { return __builtin_bit_cast(float, w & 0xffff0000u); }
__device__ __forceinline__ float bf2f(bf16 u) { return __builtin_bit_cast(float, (unsigned)u << 16); }
__device__ __forceinline__ void unpack8(const v4u q, float* f) { f[0] = bflo(q.x); f[1] = bfhi(q.x); f[2] = bflo(q.y); f[3] = bfhi(q.y); f[4] = bflo(q.z); f[5] = bfhi(q.z); f[6] = bflo(q.w); f[7] = bfhi(q.w); }
__device__ __forceinline__ unsigned cvtpk_c(float lo, float hi);
__device__ __forceinline__ v4u pack8(const float* f) { v4u o; o.x = cvtpk_c(f[0], f[1]); o.y = cvtpk_c(f[2], f[3]); o.z = cvtpk_c(f[4], f[5]); o.w = cvtpk_c(f[6], f[7]); return o; }
__device__ __forceinline__ float sigmoidf_(float x) { return __builtin_amdgcn_rcpf(1.0f + __expf(-x)); }
__device__ __forceinline__ float wave_sum(float v) {
#pragma unroll
    for (int o = 1; o < 64; o <<= 1) v += __shfl_xor(v, o);
    return v;
}
__device__ __forceinline__ void transpose_item(const float* W, int K, int N, bf16* WT, int ldwt, int row_off, int kcol_off, LAS float* scr, int item, int lane) {
    const int nblk = N / 32, kb = item / nblk, nb = item % nblk, k0 = 64 * kb, n0 = 32 * nb;
#pragma unroll 8
    for (int i = 0; i < 32; ++i) { const int kk = 2 * i + (lane >> 5); scr[kk * 33 + (lane & 31)] = W[(size_t)(k0 + kk) * N + n0 + (lane & 31)]; }
    LDS_WAIT(); asm volatile("" ::: "memory");
    const int c = lane & 7;
#pragma unroll
    for (int j = 0; j < 4; ++j) { const int n = (lane >> 3) + 8 * j; const LAS float* s = scr + (8 * c) * 33 + n;
        v4u o; o.x = pk2(s[0 * 33], s[1 * 33]); o.y = pk2(s[2 * 33], s[3 * 33]); o.z = pk2(s[4 * 33], s[5 * 33]); o.w = pk2(s[6 * 33], s[7 * 33]);
        *(GAS v4u*)(WT + (size_t)(row_off + n0 + n) * ldwt + kcol_off + k0 + 8 * c) = o; }
    LDS_WAIT(); asm volatile("" ::: "memory");
}

typedef unsigned u32x2_t __attribute__((ext_vector_type(2)));
typedef float f32x2_c __attribute__((ext_vector_type(2))); typedef __bf16 bf16x2_c __attribute__((ext_vector_type(2)));
__device__ __forceinline__ unsigned cvtpk_c(float lo, float hi) { const f32x2_c v = {lo, hi}; const bf16x2_c b = __builtin_convertvector(v, bf16x2_c); return __builtin_bit_cast(unsigned, b); }
__device__ __forceinline__ bf16x8 ldsfrag_perm(const LAS unsigned char* p) { const u32x2_t a = *(const LAS u32x2_t*)p, b = *(const LAS u32x2_t*)(p + 16); return __builtin_bit_cast(bf16x8, (v4u){a.x, a.y, b.x, b.y}); }
template <int CTRL> __device__ __forceinline__ float dppf(float v) { return __builtin_bit_cast(float, __builtin_amdgcn_update_dpp(0, __builtin_bit_cast(int, v), CTRL, 0xf, 0xf, true)); }
struct Args { const float* in[NIN]; float* out; unsigned char* ws; int ph_lo, ph_hi, li, pad; };

#define PTRS const int G = gridDim.x, bx = blockIdx.x; const int vcu = (G % 8 == 0) ? (bx % 8) * (G / 8) + bx / 8 : bx; const int gw = vcu * NWAVES + wave, NGW = G * NWAVES; (void)gw; (void)NGW; const float* x = args.in[I_X]; const float* cin = args.in[I_C]; const float* wada = args.in[I_WADA]; const float* bada = args.in[I_BADA]; const float* gpre = args.in[I_GPRE]; const float* gpost = args.in[I_GPOST]; const float* win = args.in[I_WIN]; const float* mu = args.in[I_MU]; const float* w0 = args.in[I_W0]; const float* wup = args.in[I_WUP]; const float* a0 = args.in[I_A0]; const float* aup = args.in[I_AUP]; const float* k_k = args.in[I_KK]; const float* k_a = args.in[I_KA]; const float* r_k = args.in[I_RK]; const float* gnw = args.in[I_GNW]; const float* gnb = args.in[I_GNB]; const float* sink = args.in[I_SINK]; const float* wbrr = args.in[I_WBRR]; const float* wbra = args.in[I_WBRA]; const float* wout = args.in[I_WOUT]; float* out = args.out; float* ADA = (float*)(ws + WS_ADA); float* BSUM = (float*)(ws + WS_BSUM); float* BP4 = (float*)(ws + WS_BP4); (void)BSUM; bf16* WinT = (bf16*)(ws + WS_WINT); bf16* WbrrT = (bf16*)(ws + WS_WBRR); bf16* WbraT = (bf16*)(ws + WS_WBRA); bf16* WoutT = (bf16*)(ws + WS_WOUT); bf16* WloraT = (bf16*)(ws + WS_WLORA); bf16* Hb = (bf16*)(ws + WS_H); bf16* MG = (bf16*)(ws + WS_MG); bf16* PA = (bf16*)(ws + WS_PA); bf16* PR = (bf16*)(ws + WS_PR); bf16* RAW = (bf16*)(ws + WS_PR); bf16* PGT = (bf16*)(ws + WS_PG); bf16* OUTB = (bf16*)(ws + WS_PR); bf16* KD1 = (bf16*)(ws + WS_KD1); bf16* LA = (bf16*)(ws + WS_LA); bf16* Rb = (bf16*)(ws + WS_R); bf16* Kb = (bf16*)(ws + WS_K); bf16* Vb = (bf16*)(ws + WS_V); bf16* Gb = (bf16*)(ws + WS_G); bf16* KKb = (bf16*)(ws + WS_KK); bf16* KB = (bf16*)(ws + WS_KB); bf16* VB = (bf16*)(ws + WS_VB); bf16* EDGE = (bf16*)(ws + WS_EDGE); bf16* BR = (bf16*)(ws + WS_BR); bf16* BA = (bf16*)(ws + WS_BA);
__global__ void __launch_bounds__(NWAVES * 64, 2) mk_fwd(Args args) {
    extern __shared__ __attribute__((aligned(16))) unsigned char lds_raw[];
    LAS unsigned char* lds = (LAS unsigned char*)lds_raw;
    volatile LAS unsigned* MISC = (volatile LAS unsigned*)(lds + MISC_OFF);
    const int tid = threadIdx.x, lane = tid & 63, wave = __builtin_amdgcn_readfirstlane(tid >> 6);
    unsigned char* ws = args.ws;
    gu32* ctl = (gu32*)(ws + WS_CTL);
    for (int u = tid; u < (LDS_BYTES - LDSCTL_OFF) / 4; u += NWAVES * 64) ((LAS unsigned*)(lds + LDSCTL_OFF))[u] = 0u;
    __syncthreads();
    XcdBarrier bar; bar.bar = (unsigned*)(ctl + CW_BAR); bar.x = 0; bar.st = nullptr;
    const bool use_bar = (args.ph_hi - args.ph_lo) > 1;
    if (use_bar) bar = xcd_barrier_post((unsigned*)(ctl + CW_BAR) + args.li * XCD_BAR_WORDS, MISC + 8);
#define GRID_BAR() do { if (use_bar) xcd_barrier(bar); } while (0)
#define IN(k) (args.ph_lo <= (k) && (k) < args.ph_hi)
#define BOTH(k) (IN(k) && IN((k) + 1))
    if (IN(0)) { PTRS
        LAS float* scr = (LAS float*)(lds + wave * 16384);
        constexpr int I_IN = 16 * 176, I_BRR = 8 * 32, I_OUT = 16 * 32, I_LORA = 64, NT = I_IN + 2 * I_BRR + I_OUT + I_LORA;
        for (int it = gw; it < NT; it += NGW) {
            int r = it;
            if (r < I_IN) { transpose_item(win, 1024, 5632, WinT, 1024, 0, 0, scr, r, lane); continue; } r -= I_IN;
            if (r < I_BRR) { transpose_item(wbrr, 512, 1024, WbrrT, 512, 0, 0, scr, r, lane); continue; } r -= I_BRR;
            if (r < I_BRR) { transpose_item(wbra, 512, 1024, WbraT, 512, 0, 0, scr, r, lane); continue; } r -= I_BRR;
            if (r < I_OUT) { transpose_item(wout, 1024, 1024, WoutT, 1024, 0, 0, scr, r, lane); continue; } r -= I_OUT;
            { const int mat = r >> 4, nb = r & 15, half = mat >> 1, dd = mat & 1; const float* W = (half ? aup : wup) + (size_t)dd * 64 * 512;
              bf16* WL = WloraT + (size_t)half * 1024 * 128;
              transpose_item(W, 64, 512, WL, 128, dd * 512, dd * 64, scr, nb, lane);
#pragma unroll
              for (int i = 0; i < 4; ++i) { const int q = lane + 64 * i, row = q >> 3, chunk = (q & 7) + (dd ? 0 : 8);
                  *(GAS v4u*)(WL + (size_t)(dd * 512 + nb * 32 + row) * 128 + chunk * 8) = (v4u){0u, 0u, 0u, 0u}; } }
        }
        for (int it = gw; it < 1536; it += NGW) {
            const int nblk = it % 48, r_ = it / 48, bg = r_ & 7, kq = r_ >> 3, n = nblk * 64 + lane, b0 = bg * 4, kbase = kq * 256;
#pragma unroll
            for (int bb = 0; bb < 4; ++bb)
#pragma unroll
                for (int kk = 0; kk < 4; ++kk) { const int k = lane + 64 * kk; const float cv = cin[(b0 + bb) * 1024 + kbase + k]; scr[k * 4 + bb] = cv * sigmoidf_(cv); }
            LDS_WAIT(); asm volatile("" ::: "memory");
            float acc[4] = {0.f, 0.f, 0.f, 0.f};
#pragma unroll 32
            for (int k = 0; k < 256; ++k) { const float wv = wada[(size_t)(kbase + k) * 3072 + n]; const f32x4 s = *(const LAS f32x4*)(scr + k * 4);
                acc[0] += s[0] * wv; acc[1] += s[1] * wv; acc[2] += s[2] * wv; acc[3] += s[3] * wv; }
            const float bn = kq == 0 ? bada[n] : 0.f;
#pragma unroll
            for (int bb = 0; bb < 4; ++bb) atomicAdd(ADA + (b0 + bb) * 3072 + n, acc[bb] + bn);
            LDS_WAIT(); asm volatile("" ::: "memory");
        }
        if (BOTH(0)) GRID_BAR();
    }
    if (IN(1)) { PTRS
        {
            f32x4 v[4], vn[4];
#define P1_LOAD(mm, V) do { const GAS f32x4* xr_ = (const GAS f32x4*)(x + (size_t)(mm) * DM) + lane; _Pragma("unroll") for (int j = 0; j < 4; ++j) V[j] = xr_[64 * j]; } while (0)
            if (gw < M) P1_LOAD(gw, vn);
            for (int m = gw; m < M; m += NGW) {
                const int b = m >> 11;
#pragma unroll
                for (int j = 0; j < 4; ++j) v[j] = vn[j];
                if (m + NGW < M) P1_LOAD(m + NGW, vn);
                float s = 0.f;
#pragma unroll
                for (int j = 0; j < 4; ++j) s += (v[j].x * v[j].x + v[j].y * v[j].y) + (v[j].z * v[j].z + v[j].w * v[j].w);
                const float rinv = 1.0f / sqrtf(wave_sum(s) * (1.f / DM) + 1e-6f);
                GAS unsigned long long* o8 = (GAS unsigned long long*)(Hb + (size_t)m * DM) + lane;
#pragma unroll
                for (int j = 0; j < 4; ++j) { const int c = 4 * (lane + 64 * j);
                    const f32x4 gp = *(const f32x4*)(gpre + c), sh = *(const f32x4*)(ADA + b * 3072 + c), sc = *(const f32x4*)(ADA + b * 3072 + 1024 + c);
                    const f32x4 hh = v[j] * rinv * gp * (sc + 1.0f) + sh;
                    o8[64 * j] = (unsigned long long)cvtpk_c(hh.x, hh.y) | ((unsigned long long)cvtpk_c(hh.z, hh.w) << 32); }
            }
#undef P1_LOAD
        }
        if (BOTH(1)) GRID_BAR();
    }
    if (IN(2)) { PTRS
        pg8::Gemm g{Hb, WinT, M, 3584, 1024, 1024}; pg8::StaticOrder S; S.init(M, 3584, G, bx);
        pg8::EpiShift E{Rb, LA, PA, EDGE, mu, lds + pg8::STAGE_BYTES, M};
        pg8::gemm_phase<pg8::EpiShift, pg8::StaticOrder, true, true>(lds, g, S, E);
        if (BOTH(2)) GRID_BAR();
    }
    if (IN(3)) { PTRS
        {
            const v4u zero4 = (v4u){0u, 0u, 0u, 0u};
            for (int it = gw; it < 2 * (M / 256); it += NGW) {
                const int pm = it >> 1, e = it & 1, m = pm * 256 + (e ? 255 : 0), tseg = pm & 7;
                const bf16* ec = EDGE + ((size_t)pm * 4 + (e ? 3 : 0)) * RCOLS;
                const bf16* ep = e ? EDGE + ((size_t)pm * 4 + 2) * RCOLS : EDGE + ((size_t)(pm - 1) * 4 + 3) * RCOLS;
                const bf16* en = e ? EDGE + ((size_t)(pm + 1) * 4 + 0) * RCOLS : EDGE + ((size_t)pm * 4 + 1) * RCOLS;
                const bool hasp = e || tseg > 0, hasn = !e || tseg < 7;
#pragma unroll
                for (int i = 0; i < 5; ++i) {
                    if (i == 4 && lane >= 32) break;
                    const int c = 8 * (lane + 64 * i);
                    const v4u cu = *(const v4u*)(ec + c), pv = hasp ? *(const v4u*)(ep + c) : zero4, nx = hasn ? *(const v4u*)(en + c) : zero4;
                    const f32x4 m0a = *(const f32x4*)(mu + c), m0b = *(const f32x4*)(mu + c + 4), m1a = *(const f32x4*)(mu + RCOLS + c), m1b = *(const f32x4*)(mu + RCOLS + c + 4);
                    const float mm0[8] = {m0a.x, m0a.y, m0a.z, m0a.w, m0b.x, m0b.y, m0b.z, m0b.w}, mm1[8] = {m1a.x, m1a.y, m1a.z, m1a.w, m1b.x, m1b.y, m1b.z, m1b.w};
                    float p[8], pp[8], pn[8], o[8];
                    unpack8(cu, p); unpack8(pv, pp); unpack8(nx, pn);
#pragma unroll
                    for (int e8 = 0; e8 < 8; ++e8) o[e8] = p[e8] + mm0[e8] * (pp[e8] - p[e8]) + mm1[e8] * (pn[e8] - p[e8]);
                    if (i == 0) { *(v4u*)(Rb + (size_t)m * RW + c) = pack8(o); }
                    else if (i == 1) { const int cc = c - 512;
                        *(v4u*)(Kb + (size_t)m * RW + cc) = pack8(o);
                        const f32x4 ka_ = *(const f32x4*)(k_k + cc), kb_ = *(const f32x4*)(k_k + cc + 4);
                        const float kkw[8] = {ka_.x, ka_.y, ka_.z, ka_.w, kb_.x, kb_.y, kb_.z, kb_.w};
                        float kr[8]; float ss = 0.f;
#pragma unroll
                        for (int e8 = 0; e8 < 8; ++e8) { kr[e8] = o[e8] * kkw[e8]; ss += kr[e8] * kr[e8]; }
                        ss += __shfl_xor(ss, 1); ss += __shfl_xor(ss, 2); ss += __shfl_xor(ss, 4);
                        const float inv = 1.0f / fmaxf(sqrtf(ss), 1e-12f);
#pragma unroll
                        for (int e8 = 0; e8 < 8; ++e8) kr[e8] *= inv;
                        *(v4u*)(KKb + (size_t)m * RW + cc) = pack8(kr); }
                    else if (i == 2) { *(v4u*)(Vb + (size_t)m * RW + (c - 1024)) = pack8(o); }
                    else if (i == 3) { *(v4u*)(Gb + (size_t)m * RW + (c - 1536)) = pack8(o); }
                    else { if (lane < 16) {
#pragma unroll
                            for (int e8 = 0; e8 < 8; ++e8) o[e8] = 1.0f - 2.0f * __builtin_amdgcn_rcpf(1.0f + __expf(2.0f * o[e8])); }
                        *(v4u*)(LA + (size_t)m * 256 + (c - 2048)) = pack8(o); }
                }
            }
            const int cc = 8 * lane;
            const f32x4 ka_ = *(const f32x4*)(k_k + cc), kb_ = *(const f32x4*)(k_k + cc + 4);
            const float kkw[8] = {ka_.x, ka_.y, ka_.z, ka_.w, kb_.x, kb_.y, kb_.z, kb_.w};
            v4u kq = zero4, kqn = zero4;
            if (gw < M) kqn = *(const v4u*)(Kb + (size_t)gw * RW + cc);
            for (int m = gw; m < M; m += NGW) {
                kq = kqn;
                if (m + NGW < M) kqn = *(const v4u*)(Kb + (size_t)(m + NGW) * RW + cc);
                const int tr = m & 255;
                if (tr == 0 || tr == 255) continue;
                float kf[8], kr[8]; float ss = 0.f;
                unpack8(kq, kf);
#pragma unroll
                for (int e8 = 0; e8 < 8; ++e8) { kr[e8] = kf[e8] * kkw[e8]; ss += kr[e8] * kr[e8]; }
                ss += dppf<0xB1>(ss); ss += dppf<0x4E>(ss); ss += dppf<0x141>(ss);
                const float inv = 1.0f / fmaxf(sqrtf(ss), 1e-12f);
#pragma unroll
                for (int e8 = 0; e8 < 8; ++e8) kr[e8] *= inv;
                *(v4u*)(KKb + (size_t)m * RW + cc) = pack8(kr);
            }
        }
        {
            LAS unsigned char* scr8 = lds + wave * 16384;
            for (int u = gw; u < 2048; u += NGW) {
                const int b = u >> 6, kvh = (u >> 5) & 1, tb = u & 31;
                const bf16* srck = PA + ((size_t)b * SEQ + tb * 64 + lane) * ACOLS + 512 + kvh * 64;
                const size_t tile0 = ((size_t)(b * 2 + kvh) * 64 + 2 * tb);
#pragma unroll
                for (int j8 = 0; j8 < 8; ++j8) *(LAS v4u*)(scr8 + lane * 144 + 16 * j8) = *(const v4u*)(srck + 8 * j8);
                LDS_WAIT(); asm volatile("" ::: "memory");
#pragma unroll
                for (int tt = 0; tt < 2; ++tt)
#pragma unroll
                    for (int ks = 0; ks < 4; ++ks) *(v4u*)(KB + (((tile0 + tt) * 4 + ks) * 64 + lane) * 8) = *(const LAS v4u*)(scr8 + (32 * tt + (lane & 31)) * 144 + (16 * ks + 8 * (lane >> 5)) * 2);
                LDS_WAIT(); asm volatile("" ::: "memory");
                LAS unsigned short* tile = (LAS unsigned short*)scr8;
                const bf16* srcv = srck + 128;
#pragma unroll
                for (int j8 = 0; j8 < 8; ++j8) { const v4u qv = *(const v4u*)(srcv + 8 * j8); LAS unsigned* dst = (LAS unsigned*)(tile + lane * 66 + 8 * j8);
                    dst[0] = qv.x; dst[1] = qv.y; dst[2] = qv.z; dst[3] = qv.w; }
                LDS_WAIT(); asm volatile("" ::: "memory");
#pragma unroll
                for (int tt = 0; tt < 2; ++tt)
#pragma unroll
                    for (int mb = 0; mb < 2; ++mb)
#pragma unroll
                        for (int k2 = 0; k2 < 2; ++k2) { unsigned w[4];
#pragma unroll
                            for (int e = 0; e < 4; ++e) { const int j0 = 2 * e, key0 = 32 * tt + 16 * k2 + 8 * (j0 >> 2) + 4 * (lane >> 5) + (j0 & 3);
                                const unsigned lo16 = tile[key0 * 66 + 32 * mb + (lane & 31)], hi16 = tile[(key0 + 1) * 66 + 32 * mb + (lane & 31)]; w[e] = lo16 | (hi16 << 16); }
                            *(v4u*)(VB + ((((tile0 + tt) * 2 + mb) * 2 + k2) * 64 + lane) * 8) = (v4u){w[0], w[1], w[2], w[3]}; }
                LDS_WAIT(); asm volatile("" ::: "memory");
            }
        }
        if (BOTH(3)) GRID_BAR();
    }
    if (IN(4)) { PTRS
        pg8::Gemm g{LA, WloraT, M, 2048, 128, 256, 4, 256}; pg8::StaticOrder S; S.init(M, 2048, G, bx);
        pg8::EpiLora E{RAW, w0, a0};
        pg8::gemm_phase<pg8::EpiLora, pg8::StaticOrder, true, true>(lds, g, S, E);
        if (BOTH(4)) GRID_BAR();
    }
    if (IN(6)) { PTRS
        typedef float f32x16 __attribute__((ext_vector_type(16)));
#define MF(a, b, c) __builtin_amdgcn_mfma_f32_32x32x16_bf16(a, b, c, 0, 0, 0)
#define ACCF(x, s) __builtin_bit_cast(bf16x8, (v4u){cvtpk_c((x)[8 * (s) + 0], (x)[8 * (s) + 1]), cvtpk_c((x)[8 * (s) + 2], (x)[8 * (s) + 3]), cvtpk_c((x)[8 * (s) + 4], (x)[8 * (s) + 5]), cvtpk_c((x)[8 * (s) + 6], (x)[8 * (s) + 7])})
#define LDN(img, pitch, rowb, k0) (*(const LAS bf16x8*)((img) + ((rowb) + q) * (pitch) + ((k0) + 8 * hh) * 2))
#define LDP(img, pitch, rowb, k0) ldsfrag_perm((img) + ((rowb) + q) * (pitch) + ((k0) + 4 * hh) * 2)
#define ZERO16(x) do { _Pragma("unroll") for (int r_ = 0; r_ < 16; ++r_) (x)[r_] = 0.f; } while (0)
#define MMAA(X, Y, Cacc) do { const bf16x8 xa_ = ACCF(X, 0), xb_ = ACCF(X, 1), ya_ = ACCF(Y, 0), yb_ = ACCF(Y, 1); Cacc = MF(xa_, ya_, Cacc); Cacc = MF(xb_, yb_, Cacc); } while (0)
#define PROGW(k) ((volatile LAS unsigned*)(lds + LDSCTL_OFF + 1024 + (k) * 64))
#define SPIN_UNTIL(cond) do { while (!(cond)) __builtin_amdgcn_s_sleep(1); asm volatile("" ::: "memory"); } while (0)
        constexpr int NCH = SEQ / 32;
        const int q = lane & 31, hh = lane >> 5;
        const bool run_scan = !(args.pad & 1);
        if (wave < 4 && run_scan) {
            const int sl = wave >> 1, ib = wave & 1;
            const int s = 2 * vcu + sl; const int d = s & 1, bh = s >> 1, b = bh >> 3, h = bh & 7;
            LAS unsigned char* sbase = lds + sl * 57856;
            LAS unsigned char* VT0 = lds + 115712 + wave * 5120;
            const LAS unsigned char* FR = lds + 136192 + sl * 8192;
            volatile LAS unsigned* progE = PROGW(wave); volatile LAS unsigned* ptE = PROGW(wave ^ 1); volatile LAS unsigned* progM = PROGW(4 + wave); volatile LAS unsigned* ptM = PROGW(4 + (wave ^ 1));
            volatile LAS unsigned* progF = PROGW(8 + wave); volatile LAS unsigned* progH = PROGW(12 + sl);
            const int cp = lane & 15, tq = lane >> 4;
            bf16* pY = RAW + d * 512 + h * 64 + ib * 32 + q;
            const unsigned tsel = d ? (unsigned)(3 - tq) : (unsigned)tq;
            const unsigned offS = tsel * 8u * 4096u + 64u * ib + 4u * cp, offT = tsel * 8u * 1024u + 64u * ib + 4u * cp;
            const unsigned oS = (unsigned)((d * 512 + h * 64) * 2), oT = (unsigned)(h * 128);
            unsigned pf[5][8], vq[8];
#define PF_TOK(cc, tl) ((unsigned)(b * SEQ + (d ? (SEQ - 1 - 32 * (cc) - (tl) - 24) : (32 * (cc) + (tl)))))
#define PF_ISSUE(cc, T0, T1) do { unsigned vS_ = offS, vT_ = offT; asm volatile("" : "+v"(vS_), "+v"(vT_));        \
            _Pragma("unroll") for (int tl = (T0); tl < (T1); ++tl) { const unsigned m0 = PF_TOK(cc, tl); \
                pf[0][tl] = *(const unsigned*)((ws + ((unsigned)WS_PR + oS + m0 * 4096u)) + vS_); pf[1][tl] = *(const unsigned*)((ws + ((unsigned)WS_PR + 2048u + oS + m0 * 4096u)) + vS_); pf[2][tl] = *(const unsigned*)((ws + ((unsigned)WS_KK + oT + m0 * 1024u)) + vT_); \
                pf[3][tl] = *(const unsigned*)((ws + ((unsigned)WS_K + oT + m0 * 1024u)) + vT_); pf[4][tl] = *(const unsigned*)((ws + ((unsigned)WS_R + oT + m0 * 1024u)) + vT_); } } while (0)
            PF_ISSUE(0, 0, 8);
            { unsigned vT_ = offT; asm volatile("" : "+v"(vT_));
#pragma unroll
              for (int tl = 0; tl < 8; ++tl) { const unsigned m0 = PF_TOK(0, tl); vq[tl] = *(const unsigned*)((ws + ((unsigned)WS_V + oT + m0 * 1024u)) + vT_); } }
            f32x16 H0a, H0b; ZERO16(H0a); ZERO16(H0b);
            for (int it = 0; it <= NCH; ++it) {
                if (it < NCH) {
                    LAS unsigned char* KQ = sbase + (it & 1) * 28928, *RQ = KQ + 4608, *KKI = KQ + 9216, *BKI = KQ + 13824, *KCT = KQ + 18432, *BCT = KQ + 23552; LAS float* GC = (LAS float*)(KQ + 28672);
                    LAS unsigned char* VTI = VT0 + (it & 1) * 2560;
                    if (it >= 2) SPIN_UNTIL(*progH + 1u >= (unsigned)it && *ptM + 1u >= (unsigned)it);
                    {
                    const float ka0 = k_a[h * 64 + 32 * ib + 2 * cp], ka1 = k_a[h * 64 + 32 * ib + 2 * cp + 1];
                    const float rk0 = r_k[h * 64 + 32 * ib + 2 * cp], rk1 = r_k[h * 64 + 32 * ib + 2 * cp + 1];
                    const int cn = it + 1 < NCH ? it + 1 : it;
                    unsigned nS_ = offS, nT_ = offT; asm volatile("" : "+v"(nS_), "+v"(nT_));
                    float t0 = 0.f, t1 = 0.f;
#pragma unroll
                    for (int tl = 0; tl < 8; ++tl) { t0 += bflo(pf[0][tl]); t1 += bfhi(pf[0][tl]); }
                    t0 *= -0.6065306597f; t1 *= -0.6065306597f;
                    float o0, o1, tot0, tot1;
                    {   const auto a0_ = __builtin_amdgcn_permlane16_swap(__float_as_uint(t0), __float_as_uint(t0), false, false), a1_ = __builtin_amdgcn_permlane16_swap(__float_as_uint(t1), __float_as_uint(t1), false, false);
                        const float n0 = (tq & 1) ? __uint_as_float(a0_[0]) : __uint_as_float(a0_[1]), n1 = (tq & 1) ? __uint_as_float(a1_[0]) : __uint_as_float(a1_[1]);
                        const float p0 = t0 + n0, p1 = t1 + n1;
                        const auto b0_ = __builtin_amdgcn_permlane32_swap(__float_as_uint(p0), __float_as_uint(p0), false, false), b1_ = __builtin_amdgcn_permlane32_swap(__float_as_uint(p1), __float_as_uint(p1), false, false);
                        const float q0 = (tq & 2) ? __uint_as_float(b0_[0]) : __uint_as_float(b0_[1]), q1 = (tq & 2) ? __uint_as_float(b1_[0]) : __uint_as_float(b1_[1]);
                        o0 = ((tq & 1) ? n0 : 0.f) + ((tq & 2) ? q0 : 0.f); o1 = ((tq & 1) ? n1 : 0.f) + ((tq & 2) ? q1 : 0.f); tot0 = p0 + q0; tot1 = p1 + q1; }
                    const float gC0 = __expf(tot0), gC1 = __expf(tot1);
                    float L0 = o0, L1 = o1; float eLp0 = __expf(L0), eLp1 = __expf(L1);
                    if (tq == 0) { GC[32 * ib + 2 * cp] = gC0; GC[32 * ib + 2 * cp + 1] = gC1; }
                    float bpk = 0.f;
#pragma unroll
                    for (int t2 = 0; t2 < 4; ++t2) {
                        float kc0[2], kc1[2], bc0[2], bc1[2];
#pragma unroll
                        for (int e = 0; e < 2; ++e) { const int tl = 2 * t2 + e, tau = 8 * tq + tl;
                            const float sg0 = bflo(pf[0][tl]), sg1 = bfhi(pf[0][tl]), a0_ = bflo(pf[1][tl]), a1_ = bfhi(pf[1][tl]), kk0 = bflo(pf[2][tl]), kk1 = bfhi(pf[2][tl]);
                            const float k0_ = bflo(pf[3][tl]), k1_ = bfhi(pf[3][tl]), r0_ = bflo(pf[4][tl]), r1_ = bfhi(pf[4][tl]);
                            L0 += -0.6065306597f * sg0; L1 += -0.6065306597f * sg1;
                            const float eL0 = __expf(L0), eL1 = __expf(L1), en0 = __builtin_amdgcn_rcpf(eL0), en1 = __builtin_amdgcn_rcpf(eL1);
                            const float kd0 = k0_ * (1.0f + (a0_ - 1.0f) * ka0), kd1 = k1_ * (1.0f + (a1_ - 1.0f) * ka1);
                            const float kkf0 = kd0 * en0, kkf1 = kd1 * en1, bkf0 = kk0 * a0_ * en0, bkf1 = kk1 * a1_ * en1;
                            {
                                float bp = r0_ * kd0 * rk0 + r1_ * kd1 * rk1;
                                bp += __shfl_xor(bp, 1); bp += __shfl_xor(bp, 2); bp += __shfl_xor(bp, 4); bp += __shfl_xor(bp, 8);
                                bpk = (cp == tl) ? bp : bpk; }
                            ((LAS unsigned*)KQ)[tau * 36 + 16 * ib + cp] = pg8::cvt_pk_bf16(kk0 * eLp0, kk1 * eLp1); ((LAS unsigned*)RQ)[tau * 36 + 16 * ib + cp] = pg8::cvt_pk_bf16(r0_ * eL0, r1_ * eL1);
                            ((LAS unsigned*)KKI)[tau * 36 + 16 * ib + cp] = pg8::cvt_pk_bf16(kkf0, kkf1); ((LAS unsigned*)BKI)[tau * 36 + 16 * ib + cp] = pg8::cvt_pk_bf16(bkf0, bkf1);
                            kc0[e] = kkf0 * gC0; kc1[e] = kkf1 * gC1; bc0[e] = -bkf0 * gC0; bc1[e] = -bkf1 * gC1;
                            eLp0 = eL0; eLp1 = eL1;
                            { const unsigned m0 = PF_TOK(cn, tl);
                              pf[0][tl] = *(const unsigned*)((ws + ((unsigned)WS_PR + oS + m0 * 4096u)) + nS_); pf[1][tl] = *(const unsigned*)((ws + ((unsigned)WS_PR + 2048u + oS + m0 * 4096u)) + nS_); pf[2][tl] = *(const unsigned*)((ws + ((unsigned)WS_KK + oT + m0 * 1024u)) + nT_);
                              pf[3][tl] = *(const unsigned*)((ws + ((unsigned)WS_K + oT + m0 * 1024u)) + nT_); pf[4][tl] = *(const unsigned*)((ws + ((unsigned)WS_R + oT + m0 * 1024u)) + nT_); } }
                        const int sp = 4 * tq + t2;
                        const int j0 = 32 * ib + 2 * cp;
                        ((LAS unsigned*)KCT)[j0 * 20 + sp] = pg8::cvt_pk_bf16(kc0[0], kc0[1]); ((LAS unsigned*)KCT)[(j0 + 1) * 20 + sp] = pg8::cvt_pk_bf16(kc1[0], kc1[1]);
                        ((LAS unsigned*)BCT)[j0 * 20 + sp] = pg8::cvt_pk_bf16(bc0[0], bc0[1]); ((LAS unsigned*)BCT)[(j0 + 1) * 20 + sp] = pg8::cvt_pk_bf16(bc1[0], bc1[1]);
                    }
                    if (cp < 8) { const int tt_ = 32 * it + 8 * tq + cp; const size_t mt_ = (size_t)b * SEQ + (d ? (SEQ - 1 - tt_) : tt_); BP4[((size_t)(d * 2 + ib) * M + mt_) * 8 + h] = bpk; }
#pragma unroll
                    for (int t2 = 0; t2 < 4; ++t2) { const int sp = 4 * tq + t2; const unsigned va = vq[2 * t2], vb = vq[2 * t2 + 1];
                        ((LAS unsigned*)VTI)[(2 * cp) * 20 + sp] = (va & 0xffffu) | (vb << 16); ((LAS unsigned*)VTI)[(2 * cp + 1) * 20 + sp] = (va >> 16) | (vb & 0xffff0000u); }
#pragma unroll
                    for (int tl = 0; tl < 8; ++tl) { const unsigned m0 = PF_TOK(cn, tl); vq[tl] = *(const unsigned*)((ws + ((unsigned)WS_V + oT + m0 * 1024u)) + nT_); }
                }
                    asm volatile("s_waitcnt lgkmcnt(0)" ::: "memory");
                    *progE = (unsigned)(it + 1);
                }
                if (it >= 1) {
                    const int c = it - 1;
                    const LAS unsigned char* KQ = sbase + (c & 1) * 28928, *RQ = KQ + 4608, *KCT = KQ + 18432, *BCT = KQ + 23552; const LAS float* GC = (const LAS float*)(KQ + 28672);
                    const LAS unsigned char* VTI = VT0 + (c & 1) * 2560;
                    SPIN_UNTIL(*ptE >= (unsigned)(c + 1));
                    f32x16 Zacc, Yacc, U; ZERO16(Zacc); ZERO16(Yacc); ZERO16(U);
                    const bf16x8 h0f0 = ACCF(H0a, 0), h0f1 = ACCF(H0a, 1), h0f2 = ACCF(H0b, 0), h0f3 = ACCF(H0b, 1);
                    Zacc = MF(LDP(KQ, 144, 0, 0), h0f0, Zacc); Zacc = MF(LDP(KQ, 144, 0, 16), h0f1, Zacc); Zacc = MF(LDP(KQ, 144, 0, 32), h0f2, Zacc); Zacc = MF(LDP(KQ, 144, 0, 48), h0f3, Zacc);
                    Yacc = MF(LDP(RQ, 144, 0, 0), h0f0, Yacc); Yacc = MF(LDP(RQ, 144, 0, 16), h0f1, Yacc); Yacc = MF(LDP(RQ, 144, 0, 32), h0f2, Yacc); Yacc = MF(LDP(RQ, 144, 0, 48), h0f3, Yacc);
#pragma unroll
                    for (int r_ = 0; r_ < 16; ++r_) { const int row_ = (r_ & 3) + 8 * (r_ >> 2) + 4 * hh; H0a[r_] *= GC[row_]; H0b[r_] *= GC[32 + row_]; }
                    H0a = MF(LDN(KCT, 80, 0, 0), LDN(VTI, 80, 0, 0), H0a); H0a = MF(LDN(KCT, 80, 0, 16), LDN(VTI, 80, 0, 16), H0a);
                    H0b = MF(LDN(KCT, 80, 32, 0), LDN(VTI, 80, 0, 0), H0b); H0b = MF(LDN(KCT, 80, 32, 16), LDN(VTI, 80, 0, 16), H0b);
                    SPIN_UNTIL(*progH >= (unsigned)(c + 1));
                    bf16x8 fr[8];
#pragma unroll
                    for (int f = 0; f < 8; ++f) fr[f] = *(const LAS bf16x8*)(FR + f * 1024 + lane * 16);
                    asm volatile("s_waitcnt lgkmcnt(0)" ::: "memory");
                    *progF = (unsigned)(c + 1);
                    Zacc = MF(fr[2], LDP(VTI, 80, 0, 0), Zacc); Zacc = MF(fr[3], LDP(VTI, 80, 0, 16), Zacc);
                    Yacc = MF(fr[4], LDP(VTI, 80, 0, 0), Yacc); Yacc = MF(fr[5], LDP(VTI, 80, 0, 16), Yacc);
                    U = MF(fr[0], ACCF(Zacc, 0), U); U = MF(fr[1], ACCF(Zacc, 1), U);
                    { const bf16x8 u0 = ACCF(U, 0), u1 = ACCF(U, 1);
                      Yacc = MF(fr[6], u0, Yacc); Yacc = MF(fr[7], u1, Yacc);
#pragma unroll
                      for (int r_ = 0; r_ < 16; ++r_) { const int tt = 32 * c + (r_ & 3) + 8 * (r_ >> 2) + 4 * hh; const size_t m = (size_t)b * SEQ + (d ? (SEQ - 1 - tt) : tt);
                          pY[m * 2048] = (bf16)(cvtpk_c(Yacc[r_], 0.f) & 0xffffu); }
                      H0a = MF(LDP(BCT, 80, 0, 0), u0, H0a); H0a = MF(LDP(BCT, 80, 0, 16), u1, H0a);
                      H0b = MF(LDP(BCT, 80, 32, 0), u0, H0b); H0b = MF(LDP(BCT, 80, 32, 16), u1, H0b); }
                    asm volatile("s_waitcnt lgkmcnt(0)" ::: "memory");
                    *progM = (unsigned)(c + 1);
                }
            }
#undef PF_ISSUE
#undef PF_TOK
        } else if (wave < 6 && run_scan) {
            const int sl = wave - 4;
            const LAS unsigned char* sbase = lds + sl * 57856;
            LAS unsigned char* FR = lds + 136192 + sl * 8192;
            volatile LAS unsigned* pE0 = PROGW(2 * sl), *pE1 = PROGW(2 * sl + 1), *pF0 = PROGW(8 + 2 * sl), *pF1 = PROGW(8 + 2 * sl + 1); volatile LAS unsigned* progH = PROGW(12 + sl);
            for (int c = 0; c < NCH; ++c) {
                const LAS unsigned char* KQ = sbase + (c & 1) * 28928, *RQ = KQ + 4608, *KKI = KQ + 9216, *BKI = KQ + 13824;
                SPIN_UNTIL(*pE0 >= (unsigned)(c + 1) && *pE1 >= (unsigned)(c + 1));
                f32x16 Rm, P, Pt, Rt, Aa, Ar, Ab;
                ZERO16(P); ZERO16(Pt); ZERO16(Aa); ZERO16(Ar); ZERO16(Ab);
#pragma unroll
                for (int ks = 0; ks < 4; ++ks) { const bf16x8 fb = LDN(BKI, 144, 0, 16 * ks), fq = LDN(KQ, 144, 0, 16 * ks), fk = LDN(KKI, 144, 0, 16 * ks), frq = LDN(RQ, 144, 0, 16 * ks);
                    P = MF(fb, fq, P); Pt = MF(fq, fb, Pt); Aa = MF(fk, fq, Aa); Ar = MF(fk, frq, Ar); Ab = MF(fb, frq, Ab); }
#pragma unroll
                for (int r_ = 0; r_ < 16; ++r_) { const int row_ = (r_ & 3) + 8 * (r_ >> 2) + 4 * hh; P[r_] = row_ < q ? -P[r_] : 0.f; Pt[r_] = row_ > q ? -Pt[r_] : 0.f; Rm[r_] = P[r_] + (row_ == q ? 1.0f : 0.f); Rt[r_] = Pt[r_] + (row_ == q ? 1.0f : 0.f);
                    Aa[r_] = row_ < q ? Aa[r_] : 0.f; Ar[r_] = row_ <= q ? Ar[r_] : 0.f; Ab[r_] = row_ <= q ? -Ab[r_] : 0.f; }
                const bf16x8 fa0 = ACCF(Aa, 0), fa1 = ACCF(Aa, 1), fr0 = ACCF(Ar, 0), fr1 = ACCF(Ar, 1), fb0 = ACCF(Ab, 0), fb1 = ACCF(Ab, 1);
#pragma unroll
                for (int k = 0; k < 4; ++k) {
                    f32x16 P2; ZERO16(P2); MMAA(Pt, P, P2);
                    MMAA(Rt, P2, Rm);
                    if (k < 3) { f32x16 P2t; ZERO16(P2t); MMAA(P, Pt, P2t); MMAA(P2, Rt, Rt); Pt = P2t; }
                    P = P2;
                }
                const bf16x8 ft0 = ACCF(Rm, 0), ft1 = ACCF(Rm, 1);
                asm volatile("s_waitcnt lgkmcnt(0)" ::: "memory");
                if (c >= 1) SPIN_UNTIL(*pF0 >= (unsigned)c && *pF1 >= (unsigned)c);
                *(LAS bf16x8*)(FR + 0 * 1024 + lane * 16) = ft0; *(LAS bf16x8*)(FR + 1 * 1024 + lane * 16) = ft1; *(LAS bf16x8*)(FR + 2 * 1024 + lane * 16) = fa0; *(LAS bf16x8*)(FR + 3 * 1024 + lane * 16) = fa1;
                *(LAS bf16x8*)(FR + 4 * 1024 + lane * 16) = fr0; *(LAS bf16x8*)(FR + 5 * 1024 + lane * 16) = fr1; *(LAS bf16x8*)(FR + 6 * 1024 + lane * 16) = fb0; *(LAS bf16x8*)(FR + 7 * 1024 + lane * 16) = fb1;
                asm volatile("s_waitcnt lgkmcnt(0)" ::: "memory");
                *progH = (unsigned)(c + 1);
            }
        }
        if (!(args.pad & 2)) {
            const int b = vcu >> 3, kvh = (vcu >> 2) & 1, qseg = vcu & 3;
            const bf16* kb0 = KB + ((size_t)(b * 2 + kvh) * 64) * 4 * 64 * 8 + lane * 8;
            const bf16* vb0 = VB + ((size_t)(b * 2 + kvh) * 64) * 4 * 64 * 8 + lane * 8;
            LAS unsigned* qctr = (LAS unsigned*)(lds + LDSCTL_OFF + 1024 + 14 * 64);
#define ATT_LOAD(kt_, KF, VF) do { _Pragma("unroll") for (int ks = 0; ks < 4; ++ks) KF[ks] = *(const bf16x8*)(kb0 + (size_t)((kt_) * 4 + ks) * 512); \
                _Pragma("unroll") for (int mb = 0; mb < 2; ++mb) _Pragma("unroll") for (int k2 = 0; k2 < 2; ++k2) VF[mb][k2] = *(const bf16x8*)(vb0 + (size_t)((kt_) * 4 + mb * 2 + k2) * 512); } while (0)
            for (;;) {
                unsigned e_ = 0; if (lane == 0) e_ = __hip_atomic_fetch_add(qctr, 1u, __ATOMIC_RELAXED, __HIP_MEMORY_SCOPE_WORKGROUP);
                const int e = __builtin_amdgcn_readfirstlane((int)e_);
                if (e >= 64) break;
                const int g = e & 3, qb = qseg * 16 + (e >> 2), hq = kvh * 4 + g;
                const int t = 32 * qb + q;
                const float slope = exp2f(-(float)(hq + 1));
                bf16* qrow = PA + ((size_t)b * SEQ + t) * ACOLS + hq * 64;
                bf16x8 qf[4];
#pragma unroll
                for (int ks = 0; ks < 4; ++ks) qf[ks] = *(const bf16x8*)(qrow + 16 * ks + 8 * hh);
                float mrun = sink[hq], lrun = 1.0f;
                f32x16 O0, O1; ZERO16(O0); ZERO16(O1);
                const int kt0 = qb - 4 < 0 ? 0 : qb - 4, kt1 = qb + 4 > 63 ? 63 : qb + 4;
                float nb[16];
#pragma unroll
                for (int r = 0; r < 16; ++r) nb[r] = slope * (float)(q - 4 * hh - ((r & 3) + 8 * (r >> 2)));
                bf16x8 kfA[4], vfA[2][2], kfB[4], vfB[2][2];
#define ATT_TILE(kt_, KF, VF) do { \
                    f32x16 acc; ZERO16(acc); \
                    _Pragma("unroll") for (int ks = 0; ks < 4; ++ks) acc = MF(KF[ks], qf[ks], acc); \
                      \
                    const int dlt = qb - (kt_); float sc[16]; float mx = -1e30f; \
                    if (dlt > 0) { _Pragma("unroll") for (int r = 0; r < 16; ++r) sc[r] = acc[r] * 0.125f - nb[r]; \
                        if (dlt == 4) { _Pragma("unroll") for (int r = 0; r < 16; ++r) sc[r] = nb[r] <= 0.f ? sc[r] : -1e30f; } } \
                    else if (dlt < 0) { _Pragma("unroll") for (int r = 0; r < 16; ++r) sc[r] = acc[r] * 0.125f + nb[r]; \
                        if (dlt == -4) { _Pragma("unroll") for (int r = 0; r < 16; ++r) sc[r] = nb[r] >= 0.f ? sc[r] : -1e30f; } } \
                    else { _Pragma("unroll") for (int r = 0; r < 16; ++r) sc[r] = acc[r] * 0.125f - fabsf(nb[r]); } \
                    const float coff = slope * 32.0f * (float)(dlt < 0 ? -dlt : dlt); \
                    _Pragma("unroll") for (int r = 0; r < 16; ++r) mx = fmaxf(mx, sc[r]); \
                    { const auto rr_ = __builtin_amdgcn_permlane32_swap(__float_as_uint(mx), __float_as_uint(mx), false, false); mx = fmaxf(__uint_as_float(rr_[0]), __uint_as_float(rr_[1])) - coff; }     \
                    const float mn = fmaxf(mrun, mx), alpha = __expf(mrun - mn); mrun = mn; \
                    const float sh = mn + coff; float rs = 0.f; \
                    _Pragma("unroll") for (int r = 0; r < 16; ++r) { sc[r] = __expf(sc[r] - sh); rs += sc[r]; } \
                    lrun = lrun * alpha + rs;                                  \
                    bf16x8 pb[2]; \
                    _Pragma("unroll") for (int k2 = 0; k2 < 2; ++k2) pb[k2] = __builtin_bit_cast(bf16x8, (v4u){cvtpk_c(sc[8 * k2 + 0], sc[8 * k2 + 1]), cvtpk_c(sc[8 * k2 + 2], sc[8 * k2 + 3]), cvtpk_c(sc[8 * k2 + 4], sc[8 * k2 + 5]), cvtpk_c(sc[8 * k2 + 6], sc[8 * k2 + 7])}); \
                    if (__ballot(alpha != 1.0f) != 0ull) { _Pragma("unroll") for (int r = 0; r < 16; ++r) { O0[r] *= alpha; O1[r] *= alpha; } } \
                    _Pragma("unroll") for (int k2 = 0; k2 < 2; ++k2) { O0 = MF(VF[0][k2], pb[k2], O0); O1 = MF(VF[1][k2], pb[k2], O1); } } while (0)
                ATT_LOAD(kt0, kfA, vfA);
                for (int kt = kt0; kt <= kt1; kt += 2) {
                    if (kt + 1 <= kt1) ATT_LOAD(kt + 1, kfB, vfB);
                    ATT_TILE(kt, kfA, vfA);
                    if (kt + 1 <= kt1) {
                        if (kt + 2 <= kt1) ATT_LOAD(kt + 2, kfA, vfA);
                        ATT_TILE(kt + 1, kfB, vfB);
                    }
                }
#undef ATT_TILE
                { const auto rr_ = __builtin_amdgcn_permlane32_swap(__float_as_uint(lrun), __float_as_uint(lrun), false, false); lrun = __uint_as_float(rr_[0]) + __uint_as_float(rr_[1]) - __expf(sink[hq] - mrun); }
                const float inv = __builtin_amdgcn_rcpf(lrun);
                const bf16* grow = PA + ((size_t)b * SEQ + t) * ACOLS + 768 + hq * 64;
#pragma unroll
                for (int mb = 0; mb < 2; ++mb)
#pragma unroll
                    for (int r4 = 0; r4 < 4; ++r4) { const int dd = mb * 32 + 8 * r4 + 4 * hh;
                        const uint2 gq = *(const uint2*)(grow + dd);
                        const float g0 = bflo(gq.x), g1 = bfhi(gq.x), g2 = bflo(gq.y), g3 = bfhi(gq.y);
                        const float o0 = (mb ? O1[4 * r4 + 0] : O0[4 * r4 + 0]) * inv, o1 = (mb ? O1[4 * r4 + 1] : O0[4 * r4 + 1]) * inv, o2 = (mb ? O1[4 * r4 + 2] : O0[4 * r4 + 2]) * inv, o3 = (mb ? O1[4 * r4 + 3] : O0[4 * r4 + 3]) * inv;
                        *(uint2*)(qrow + dd) = make_uint2(cvtpk_c(o0 * g0 * pg8::sigm(g0), o1 * g1 * pg8::sigm(g1)), cvtpk_c(o2 * g2 * pg8::sigm(g2), o3 * g3 * pg8::sigm(g3))); }
            }
#undef ATT_LOAD
        }
#undef MF
#undef ACCF
#undef LDN
#undef LDP
#undef ZERO16
#undef MMAA
#undef PROGW
#undef SPIN_UNTIL
        if (BOTH(6)) GRID_BAR();
    }
    if (IN(7)) { PTRS
        {
            const int c0 = 8 * lane;
            v4u q8[4], q8n[4]; float bsn = 0.f;
#define P7_LOAD(mm, Q, B) do { const bf16* rr_ = RAW + (size_t)(mm) * 2048 + c0; Q[0] = *(const v4u*)(rr_); Q[1] = *(const v4u*)(rr_ + 512); \
                Q[2] = *(const v4u*)(Vb + (size_t)(mm) * RW + c0); Q[3] = *(const v4u*)(Gb + (size_t)(mm) * RW + c0); { const size_t bi_ = (size_t)(mm) * 8 + (lane >> 3); B = (BP4[bi_] + BP4[(size_t)M * 8 + bi_]) + (BP4[(size_t)2 * M * 8 + bi_] + BP4[(size_t)3 * M * 8 + bi_]); } } while (0)
            const f32x4 gwa = *(const f32x4*)(gnw + c0), gwb = *(const f32x4*)(gnw + c0 + 4), gba = *(const f32x4*)(gnb + c0), gbb = *(const f32x4*)(gnb + c0 + 4);
            const float gw8[8] = {gwa.x, gwa.y, gwa.z, gwa.w, gwb.x, gwb.y, gwb.z, gwb.w}, gb8[8] = {gba.x, gba.y, gba.z, gba.w, gbb.x, gbb.y, gbb.z, gbb.w};
            if (gw < M) P7_LOAD(gw, q8n, bsn);
            for (int m = gw; m < M; m += NGW) {
#pragma unroll
                for (int i = 0; i < 4; ++i) q8[i] = q8n[i];
                const float bs = bsn;
                if (m + NGW < M) P7_LOAD(m + NGW, q8n, bsn);
                float y0[8], y1[8], vf[8], gf[8], y[8];
                unpack8(q8[0], y0); unpack8(q8[1], y1); unpack8(q8[2], vf); unpack8(q8[3], gf);
                float s = 0.f;
#pragma unroll
                for (int e = 0; e < 8; ++e) { y[e] = y0[e] + y1[e]; s += y[e]; }
                s += __shfl_xor(s, 1); s += __shfl_xor(s, 2); s += __shfl_xor(s, 4);
                const float mean = s * (1.f / 64.f); float qq = 0.f;
#pragma unroll
                for (int e = 0; e < 8; ++e) { const float dd = y[e] - mean; qq += dd * dd; }
                qq += __shfl_xor(qq, 1); qq += __shfl_xor(qq, 2); qq += __shfl_xor(qq, 4);
                const float rstd = 1.0f / sqrtf(qq * (1.f / 64.f) + 64e-5f);
                float r[8];
#pragma unroll
                for (int e = 0; e < 8; ++e) { const float yn = (y[e] - mean) * rstd * gw8[e] + gb8[e]; r[e] = (yn + bs * vf[e]) * gf[e] * sigmoidf_(gf[e]); }
                *(v4u*)(Vb + (size_t)m * RW + c0) = pack8(r);
            }
#undef P7_LOAD
        }
        if (BOTH(7)) GRID_BAR();
    }
    if (IN(8)) { PTRS
        { pg8::Gemm g{Hb, WinT + (size_t)3584 * 1024, M, 2048, 1024, 1024}; pg8::StaticOrder S; S.init(M, 2048, G, bx);
          pg8::EpiRoute E{PGT, PGT, 2048, 2048, 1 << 20};
          pg8::gemm_phase<pg8::EpiRoute, pg8::StaticOrder, true, true>(lds, g, S, E); }
        if (BOTH(8)) GRID_BAR();
    }
    if (IN(9)) { PTRS
        { pg8::Gemm g{Vb, WbrrT, M, 1024, 512, 512}; pg8::StaticOrder S; S.init(M, 1024, G, bx);
          pg8::EpiGate<0> E{MG, PGT};
          pg8::gemm_phase<pg8::EpiGate<0>, pg8::StaticOrder, true, true>(lds, g, S, E); }
        { pg8::Gemm g{PA, WbraT, M, 1024, 512, ACOLS}; pg8::StaticOrder S; S.init(M, 1024, G, bx);
          pg8::EpiGate<1> E{MG, PGT};
          pg8::gemm_phase<pg8::EpiGate<1>, pg8::StaticOrder, true, true>(lds, g, S, E); }
        if (BOTH(9)) GRID_BAR();
    }
    if (IN(10)) { PTRS
        pg8::Gemm g{MG, WoutT, M, 1024, 1024, 1024}; pg8::StaticOrder S; S.init(M, 1024, G, bx);
        pg8::EpiRoute E{OUTB, OUTB, 1024, 1024, 1 << 20};
        pg8::gemm_phase<pg8::EpiRoute, pg8::StaticOrder, true, true>(lds, g, S, E);
        if (BOTH(10)) GRID_BAR();
    }
    if (IN(11)) { PTRS
        {
            v4u oq[2], oqn[2]; f32x4 xq[4], xqn[4];
#define P11_LOAD(mm, O, X) do { _Pragma("unroll") for (int j = 0; j < 2; ++j) { O[j] = *(const v4u*)(OUTB + (size_t)(mm) * 1024 + 8 * (lane + 64 * j)); \
                X[2 * j] = *(const f32x4*)(x + (size_t)(mm) * DM + 8 * (lane + 64 * j)); X[2 * j + 1] = *(const f32x4*)(x + (size_t)(mm) * DM + 8 * (lane + 64 * j) + 4); } } while (0)
            if (gw < M) P11_LOAD(gw, oqn, xqn);
            for (int m = gw; m < M; m += NGW) {
                const int b = m >> 11;
#pragma unroll
                for (int j = 0; j < 2; ++j) { oq[j] = oqn[j]; xq[2 * j] = xqn[2 * j]; xq[2 * j + 1] = xqn[2 * j + 1]; }
                if (m + NGW < M) P11_LOAD(m + NGW, oqn, xqn);
                float o[2][8]; float s = 0.f;
#pragma unroll
                for (int j = 0; j < 2; ++j) { unpack8(oq[j], o[j]);
#pragma unroll
                    for (int e = 0; e < 8; ++e) s += o[j][e] * o[j][e]; }
                const float rinv = 1.0f / sqrtf(wave_sum(s) * (1.f / DM) + 1e-6f);
#pragma unroll
                for (int j = 0; j < 2; ++j) { const int c = 8 * (lane + 64 * j);
#pragma unroll
                    for (int hlf = 0; hlf < 2; ++hlf) { const int cc = c + 4 * hlf;
                        const f32x4 gp = *(const f32x4*)(gpost + cc), gt = *(const f32x4*)(ADA + b * 3072 + 2048 + cc);
                        f32x4 ov; ov.x = o[j][4 * hlf + 0]; ov.y = o[j][4 * hlf + 1]; ov.z = o[j][4 * hlf + 2]; ov.w = o[j][4 * hlf + 3];
                        *(f32x4*)(out + (size_t)m * DM + cc) = xq[2 * j + hlf] + gt * (ov * rinv * gp); } }
            }
#undef P11_LOAD
        }
    }
#undef IN
#undef BOTH
#undef GRID_BAR
}

extern "C" void kernel_launch(void* const* d_in, const int* in_sizes, int n_in, void* d_out, int out_size, void* d_ws, size_t ws_size, hipStream_t stream) {
    static int grid = 0;
    if (grid == 0) {
        if (n_in != NIN || in_sizes[0] != M * DM || out_size != M * DM || ws_size < WS_END) { fprintf(stderr, "kernel_launch: unexpected shapes: n_in %d in0 %d out %d ws %zu (need %zu)\n", n_in, n_in > 0 ? in_sizes[0] : -1, out_size, ws_size, (size_t)WS_END); grid = -1; return; }
        int dev = 0, cus = 0;
        if (hipGetDevice(&dev) != hipSuccess || hipDeviceGetAttribute(&cus, hipDeviceAttributeMultiprocessorCount, dev) != hipSuccess) { fprintf(stderr, "kernel_launch: device query failed\n"); grid = -1; return; }
        if (hipFuncSetAttribute((const void*)mk_fwd, hipFuncAttributeMaxDynamicSharedMemorySize, LDS_BYTES) != hipSuccess) { fprintf(stderr, "kernel_launch: hipFuncSetAttribute failed\n"); grid = -1; return; }
        (void)hipGetLastError();
        grid = cus;
        if (grid != 256) fprintf(stderr, "kernel_launch: %d CUs (built for 256)\n", grid);
    }
    if (grid < 0) return;
    if (hipMemsetAsync((char*)d_ws + WS_CTL, 0, CTL_ZERO_BYTES, stream) != hipSuccess) { fprintf(stderr, "kernel_launch: memset failed\n"); return; }
    Args a{};
    for (int i = 0; i < NIN; ++i) a.in[i] = (const float*)d_in[i];
    a.out = (float*)d_out; a.ws = (unsigned char*)d_ws;
    static const int plan[][2] = MK_PLAN;
    const int nl = (int)(sizeof(plan) / sizeof(plan[0]));
    for (int li = 0; li < nl; ++li) {
        a.ph_lo = plan[li][0]; a.ph_hi = plan[li][1]; a.li = li; a.pad = (li < nl - 1) ? MK_PROBE_FLAGS : 0;
        hipLaunchKernelGGL(mk_fwd, dim3(grid), dim3(NWAVES * 64), LDS_BYTES, stream, a);
        const hipError_t le = hipPeekAtLastError();
        if (le != hipSuccess) { fprintf(stderr, "kernel_launch: launch %d failed: %s\n", li, hipGetErrorName(le)); break; }
    }
}
```

```cpp
#include <hip/hip_runtime.h>
#include <cstdio>
#include <cstdint>
namespace pg8 {
#define PG8_LAS __attribute__((address_space(3)))
typedef unsigned short bf16_t;
typedef short bf16x8 __attribute__((ext_vector_type(8)));
typedef float f32x4 __attribute__((ext_vector_type(4)));
typedef unsigned u32x4 __attribute__((ext_vector_type(4)));
constexpr int BM = 256, BK = 64, HALF = 128, HTB = HALF * BK * 2  , STAGE_BYTES = 8 * HTB, NXCD = 8, WGM = 8;

__host__ __device__ __forceinline__ int lds_byte(int r, int c) { const int st = (r >> 4) * 2 + (c >> 5), rr = r & 15, cc = c & 31, ob = rr * 64 + cc * 2; return st * 1024 + (ob ^ (((ob >> 9) & 1) << 5)); }
__host__ __device__ __forceinline__ void stage_rc(int b, int& R, int& C) { const int st = b / 1024, sb = b % 1024, swz = sb ^ (((sb >> 9) & 1) << 5); R = (st >> 1) * 16 + swz / 64; C = (st & 1) * 32 + (swz % 64) / 2; }
__host__ __device__ __forceinline__ int perm32(int rho) { const int n = rho >> 4, i = rho & 15; return 8 * (i >> 2) + 4 * n + (i & 3); }

struct Unit { int pm, pn; };
struct Gemm { const bf16_t* A; const bf16_t* Bt; int M, N, K, lda; int asplit_pn, asplit_off; };

struct StaticOrder {
    int nM, nN, nwg, G, c;
    __host__ __device__ void init(int M, int N, int G_, int c_) { nM = M / BM; nN = N / BM; nwg = nM * nN; G = G_; c = c_; }
    __host__ __device__ bool next(int i, Unit& u) const {
        const long L = (long)i * G + c; if (L >= nwg) return false;
        int wgid = (int)L; { const int q = nwg / NXCD, r = nwg % NXCD, xcd = wgid % NXCD, off = wgid / NXCD; wgid = (xcd < r ? xcd * (q + 1) : r * (q + 1) + (xcd - r) * q) + off; }
        const int nig = WGM * nN, gid = wgid / nig, fm = gid * WGM, gsz = (nM - fm) < WGM ? (nM - fm) : WGM;
        u.pm = fm + ((wgid % nig) % gsz); u.pn = (wgid % nig) / gsz; return true;
    }
    __device__ __forceinline__ void a_ready(const Unit&) const {}
    __device__ __forceinline__ void done(const Unit&) const {}
};

__device__ __forceinline__ unsigned cvt_pk_bf16(float lo, float hi) { unsigned r; asm volatile("v_cvt_pk_bf16_f32 %0, %1, %2" : "=v"(r) : "v"(lo), "v"(hi)); return r; }
typedef float f32x2 __attribute__((ext_vector_type(2)));
__device__ __forceinline__ f32x2 gelu_pk(f32x2 v) {
    const f32x2 av = __builtin_elementwise_abs(v), d = av * 0.2316418882f + 1.0f;
    f32x2 t; t.x = __builtin_amdgcn_rcpf(d.x); t.y = __builtin_amdgcn_rcpf(d.y);
    f32x2 q = t * 0.5307027145f + (-0.7265760135f); q = q * t + 0.7107068705f; q = q * t + (-0.142248368f); q = q * t + 0.127414796f; q = q * t;
    const f32x2 s = (v * v) * (-0.72134752044f);
    f32x2 e; e.x = __builtin_amdgcn_exp2f(s.x); e.y = __builtin_amdgcn_exp2f(s.y);
    const f32x2 m = v * (q * e), r = v - m;
    f32x2 o; o.x = v.x < 0.f ? m.x : r.x; o.y = v.y < 0.f ? m.y : r.y; return o;
}

template <int ACT  > struct EpiBf16 {
    static constexpr bool PERM = true, AFTER_DRAIN = false; static_assert(ACT == 0 || ACT == 1, "EpiBf16: ACT is 0 (none) or 1 (gelu_pk)");
    bf16_t* O; int ldc; const float* bias; int split_cols; size_t split_stride; float scale0;
    __device__ __forceinline__ void operator()(const f32x4 (&acc)[2][2][4][2], const Unit& u, int wr, int wc, int fr, int fq) const {
        const int row0 = u.pm * BM + wr * 64 + fr; int colt = u.pn * BM; bf16_t* base = O;
        float sc = 1.f; if (split_cols) { const int t = colt / split_cols; base += (size_t)t * split_stride; colt -= t * split_cols; if (t == 0) sc = scale0; }
        const int col0 = colt + wc * 32 + 8 * fq, bcol0 = u.pn * BM + wc * 32 + 8 * fq;
        f32x4 bv[2][2];
#pragma unroll
        for (int bj = 0; bj < 2; ++bj)
#pragma unroll
            for (int n = 0; n < 2; ++n) bv[bj][n] = bias ? *(const f32x4*)(bias + bcol0 + bj * HALF + 4 * n) : (f32x4){0.f, 0.f, 0.f, 0.f};
#pragma unroll
        for (int ai = 0; ai < 2; ++ai)
#pragma unroll
            for (int m = 0; m < 4; ++m) { bf16_t* rowp = base + (size_t)(row0 + ai * HALF + m * 16) * ldc + col0;
#pragma unroll
                for (int bj = 0; bj < 2; ++bj) { f32x4 v0 = acc[ai][bj][m][0] + bv[bj][0], v1 = acc[ai][bj][m][1] + bv[bj][1];
                    if (ACT == 1) { f32x2 a = gelu_pk((f32x2){v0[0], v0[1]}), b = gelu_pk((f32x2){v0[2], v0[3]}), c = gelu_pk((f32x2){v1[0], v1[1]}), d = gelu_pk((f32x2){v1[2], v1[3]});
                        v0 = (f32x4){a.x, a.y, b.x, b.y}; v1 = (f32x4){c.x, c.y, d.x, d.y}; }
                    v0 = v0 * sc; v1 = v1 * sc; u32x4 w; w.x = cvt_pk_bf16(v0[0], v0[1]); w.y = cvt_pk_bf16(v0[2], v0[3]); w.z = cvt_pk_bf16(v1[0], v1[1]); w.w = cvt_pk_bf16(v1[2], v1[3]);
                    *(u32x4*)(rowp + bj * HALF) = w; } }
    }
};
template <class Epi, class Sched, bool ALIGN_EPI = false, bool SP2 = false>
__device__ __forceinline__ void gemm_phase(PG8_LAS unsigned char* lds, const Gemm g, const Sched& S, const Epi& E) {
    const int tid = threadIdx.x, wid = __builtin_amdgcn_readfirstlane(tid >> 6), lane = tid & 63, wr = wid >> 2, wc = wid & 3, fr = lane & 15, fq = lane >> 4;
    const int K = g.K, nt = K / BK;
    unsigned voffA[2], voffB[2];
#pragma unroll
    for (int i = 0; i < 2; ++i) { int R, C; stage_rc(tid * 16 + i * 8192, R, C); const int Rb = Epi::PERM ? ((R & ~31) + perm32(R & 31)) : R;
        voffA[i] = (unsigned)(R * g.lda + C) * 2u; voffB[i] = (unsigned)(Rb * K + C) * 2u; }
    const size_t kstep = (size_t)(BK * 2);
    const size_t hstepB = (size_t)HALF * K * 2, hstepA = (size_t)HALF * g.lda * 2;
    const size_t tstepB = 2 * hstepB, tstepA = 2 * hstepA;
    const unsigned ldsw = (unsigned)wid * 1024u;
    const int aoff = lds_byte(wr * 64 + fr, fq * 8), boff = lds_byte(wc * 32 + fr, fq * 8);
#define PG8_SA(b, h) (((b) * 2 + (h)) * HTB)
#define PG8_SB(b, h) ((4 + (b) * 2 + (h)) * HTB)
#define PG8_STAGE(bufoff, gbase, voff) do { _Pragma("unroll") for (int _i = 0; _i < 2; ++_i) \
        __builtin_amdgcn_global_load_lds((const unsigned*)((const char*)(gbase) + (voff)[_i]), (PG8_LAS unsigned*)(lds + (bufoff) + ldsw + _i * 8192), 16, 0, 0); } while (0)
#define PG8_LDA(dst, b, h) do { _Pragma("unroll") for (int m = 0; m < 4; ++m) _Pragma("unroll") for (int k = 0; k < 2; ++k) dst[m][k] = *(const PG8_LAS bf16x8*)(lds + PG8_SA(b, h) + aoff + m * 2048 + k * 1024); } while (0)
#define PG8_LDB(dst, b, h) do { _Pragma("unroll") for (int n = 0; n < 2; ++n) _Pragma("unroll") for (int k = 0; k < 2; ++k) dst[n][k] = *(const PG8_LAS bf16x8*)(lds + PG8_SB(b, h) + boff + n * 2048 + k * 1024); } while (0)
#define PG8_MMA(ai, bj, At, Bt) do { __builtin_amdgcn_s_setprio(1); _Pragma("unroll") for (int m = 0; m < 4; ++m) _Pragma("unroll") for (int n = 0; n < 2; ++n) _Pragma("unroll") for (int k = 0; k < 2; ++k) \
        acc[ai][bj][m][n] = __builtin_amdgcn_mfma_f32_16x16x32_bf16(Bt[n][k], At[m][k], acc[ai][bj][m][n], 0, 0, 0); __builtin_amdgcn_s_setprio(0); } while (0)
#define PG8_WAIT_V(n) asm volatile("s_waitcnt vmcnt(" #n ")" ::: "memory")
#define PG8_WAIT_L(n) asm volatile("s_waitcnt lgkmcnt(" #n ")" ::: "memory")
#define PG8_BAR __builtin_amdgcn_s_barrier()
#define PG8_SCHED __builtin_amdgcn_sched_barrier(0)
    Unit cur, nxt; int ui = 0;
    if (!S.next(0, cur)) return;
    f32x4 acc[2][2][4][2];
#pragma unroll
    for (int a = 0; a < 2; ++a)
#pragma unroll
        for (int b = 0; b < 2; ++b)
#pragma unroll
            for (int m = 0; m < 4; ++m)
#pragma unroll
                for (int n = 0; n < 2; ++n) acc[a][b][m][n] = (f32x4){0.f, 0.f, 0.f, 0.f};
    bf16x8 At[4][2], B0[2][2], B1[2][2];
    const char* cA = (const char*)g.A + (size_t)cur.pm * tstepA + (cur.pn >= g.asplit_pn ? g.asplit_off : 0); const char* cB = (const char*)g.Bt + (size_t)cur.pn * tstepB;
    S.a_ready(cur);
    if constexpr (SP2) {
        PG8_STAGE(PG8_SB(0, 0), cB, voffB); PG8_STAGE(PG8_SB(0, 1), cB + hstepB, voffB); PG8_STAGE(PG8_SA(0, 0), cA, voffA); PG8_STAGE(PG8_SA(0, 1), cA + hstepA, voffA);
        if (wr == 1) PG8_BAR;
        PG8_WAIT_V(2); PG8_BAR;
        PG8_STAGE(PG8_SB(1, 0), cB + kstep, voffB); PG8_STAGE(PG8_SA(1, 0), cA + kstep, voffA); PG8_STAGE(PG8_SB(1, 1), cB + hstepB + kstep, voffB);
        PG8_WAIT_V(6); PG8_BAR;
    } else {
        PG8_STAGE(PG8_SB(0, 0), cB, voffB); PG8_STAGE(PG8_SA(0, 0), cA, voffA); PG8_STAGE(PG8_SB(0, 1), cB + hstepB, voffB); PG8_STAGE(PG8_SA(0, 1), cA + hstepA, voffA);
        if (wr == 1) PG8_BAR;
        PG8_WAIT_V(4); PG8_BAR;
        PG8_STAGE(PG8_SB(1, 0), cB + kstep, voffB); PG8_STAGE(PG8_SA(1, 0), cA + kstep, voffA); PG8_STAGE(PG8_SB(1, 1), cB + hstepB + kstep, voffB);
        PG8_WAIT_V(6); PG8_BAR;
    }
    for (;;) {
        const bool has_next = S.next(ui + 1, nxt);
        const char* nA = has_next ? (const char*)g.A + (size_t)nxt.pm * tstepA + (nxt.pn >= g.asplit_pn ? g.asplit_off : 0) : cA; const char* nB = has_next ? (const char*)g.Bt + (size_t)nxt.pn * tstepB : cB;
        for (int t = 0; t < nt; t += 2) {
            const bool last = (t == nt - 2);
            const char* a1 = cA + (size_t)(t + 1) * kstep;
            const char* a2 = last ? nA : cA + (size_t)(t + 2) * kstep; const char* b2 = last ? nB : cB + (size_t)(t + 2) * kstep;
            const char* a3 = a2 + kstep; const char* b3 = b2 + kstep;
            if (last && has_next) S.a_ready(nxt);
            if constexpr (SP2) {
            PG8_LDB(B0, 0, 0); PG8_LDB(B1, 0, 1); PG8_SCHED; PG8_LDA(At, 0, 0); PG8_STAGE(PG8_SA(1, 1), a1 + hstepA, voffA);
            PG8_WAIT_V(8); PG8_WAIT_L(0); PG8_BAR; PG8_MMA(0, 0, At, B0); PG8_MMA(0, 1, At, B1); PG8_BAR; PG8_SCHED;
            PG8_LDA(At, 0, 1); PG8_STAGE(PG8_SB(0, 0), b2, voffB); PG8_STAGE(PG8_SB(0, 1), b2 + hstepB, voffB); PG8_STAGE(PG8_SA(0, 0), a2, voffA);
            PG8_WAIT_V(8); PG8_WAIT_L(0); PG8_BAR; PG8_MMA(1, 0, At, B0); PG8_MMA(1, 1, At, B1); PG8_BAR; PG8_SCHED;
            PG8_LDB(B0, 1, 0); PG8_LDB(B1, 1, 1); PG8_SCHED; PG8_LDA(At, 1, 0); PG8_STAGE(PG8_SA(0, 1), a2 + hstepA, voffA);
            PG8_WAIT_V(8); PG8_WAIT_L(0); PG8_BAR; PG8_MMA(0, 0, At, B0); PG8_MMA(0, 1, At, B1); PG8_BAR; PG8_SCHED;
            PG8_LDA(At, 1, 1); PG8_STAGE(PG8_SB(1, 0), b3, voffB); PG8_STAGE(PG8_SB(1, 1), b3 + hstepB, voffB); PG8_STAGE(PG8_SA(1, 0), a3, voffA);
            PG8_WAIT_V(8); PG8_WAIT_L(0); PG8_BAR; PG8_MMA(1, 0, At, B0); PG8_MMA(1, 1, At, B1); PG8_BAR; PG8_SCHED;
            } else {
            PG8_LDB(B0, 0, 0); PG8_SCHED; PG8_LDA(At, 0, 0); PG8_STAGE(PG8_SA(1, 1), a1 + hstepA, voffA);
            PG8_WAIT_L(8); PG8_BAR; PG8_WAIT_L(0); PG8_MMA(0, 0, At, B0); PG8_BAR; PG8_SCHED;
            PG8_LDB(B1, 0, 1); PG8_STAGE(PG8_SB(0, 0), b2, voffB);
            PG8_BAR; PG8_WAIT_L(0); PG8_MMA(0, 1, At, B1); PG8_BAR;
            PG8_LDA(At, 0, 1); PG8_STAGE(PG8_SA(0, 0), a2, voffA);
            PG8_BAR; PG8_WAIT_L(0); PG8_MMA(1, 0, At, B0); PG8_BAR; PG8_SCHED;
            PG8_STAGE(PG8_SB(0, 1), b2 + hstepB, voffB);
            PG8_WAIT_V(6); PG8_BAR; PG8_MMA(1, 1, At, B1); PG8_BAR;
            PG8_LDB(B0, 1, 0); PG8_SCHED; PG8_LDA(At, 1, 0); PG8_STAGE(PG8_SA(0, 1), a2 + hstepA, voffA);
            PG8_WAIT_L(8); PG8_BAR; PG8_WAIT_L(0); PG8_MMA(0, 0, At, B0); PG8_BAR; PG8_SCHED;
            PG8_LDB(B1, 1, 1); PG8_STAGE(PG8_SB(1, 0), b3, voffB);
            PG8_BAR; PG8_WAIT_L(0); PG8_MMA(0, 1, At, B1); PG8_BAR;
            PG8_LDA(At, 1, 1); PG8_STAGE(PG8_SA(1, 0), a3, voffA);
            PG8_BAR; PG8_WAIT_L(0); PG8_MMA(1, 0, At, B0); PG8_BAR; PG8_SCHED;
            PG8_STAGE(PG8_SB(1, 1), b3 + hstepB, voffB);
            PG8_WAIT_V(6); PG8_BAR; PG8_MMA(1, 1, At, B1); PG8_BAR;
            }
        }
        if constexpr (ALIGN_EPI) { if (wr == 0) PG8_BAR; }
        if constexpr (!Epi::AFTER_DRAIN) { E(acc, cur, wr, wc, fr, fq); S.done(cur); }
        if (!has_next) break;
#pragma unroll
        for (int a = 0; a < 2; ++a)
#pragma unroll
            for (int b = 0; b < 2; ++b)
#pragma unroll
                for (int m = 0; m < 4; ++m)
#pragma unroll
                    for (int n = 0; n < 2; ++n) acc[a][b][m][n] = (f32x4){0.f, 0.f, 0.f, 0.f};
        cur = nxt; cA = nA; cB = nB; ++ui;
        if constexpr (ALIGN_EPI) { if (wr == 1) PG8_BAR; }
    }
    PG8_WAIT_V(0);
    if constexpr (!ALIGN_EPI) { if (wr == 0) PG8_BAR; }
    PG8_BAR;
    if constexpr (Epi::AFTER_DRAIN) { E.fused(acc, cur, wr, wc, fr, fq, lds, wid, lane); S.done(cur); }
#undef PG8_SA
#undef PG8_SB
#undef PG8_STAGE
#undef PG8_LDA
#undef PG8_LDB
#undef PG8_MMA
#undef PG8_WAIT_V
#undef PG8_WAIT_L
#undef PG8_BAR
#undef PG8_SCHED
}
}
namespace pg8 {
struct EpiRoute {
    static constexpr bool PERM = true, AFTER_DRAIN = false;
    bf16_t* base0; bf16_t* base1; int ldc0, ldc1, tile1;
    __device__ __forceinline__ void operator()(const f32x4 (&acc)[2][2][4][2], const Unit& u, int wr, int wc, int fr, int fq) const {
        const bool second = u.pn >= tile1;
        bf16_t* O = second ? base1 : base0; const int ld = second ? ldc1 : ldc0; const int colt = (second ? u.pn - tile1 : u.pn) * BM;
        const int row0 = u.pm * BM + wr * 64 + fr;
        const int col0 = colt + wc * 32 + 8 * fq;
#pragma unroll
        for (int ai = 0; ai < 2; ++ai)
#pragma unroll
            for (int m = 0; m < 4; ++m) { bf16_t* rowp = O + (size_t)(row0 + ai * HALF + m * 16) * ld + col0;
#pragma unroll
                for (int bj = 0; bj < 2; ++bj) { const f32x4 v0 = acc[ai][bj][m][0], v1 = acc[ai][bj][m][1];
                    u32x4 w; w.x = cvt_pk_bf16(v0[0], v0[1]); w.y = cvt_pk_bf16(v0[2], v0[3]); w.z = cvt_pk_bf16(v1[0], v1[1]); w.w = cvt_pk_bf16(v1[2], v1[3]);
                    *(u32x4*)(rowp + bj * HALF) = w; } }
    }
};
}
namespace pg8 {
struct EpiFrag {
    static constexpr bool PERM = true, AFTER_DRAIN = false;
    bf16_t* O; int NT;
    __device__ __forceinline__ void operator()(const f32x4 (&acc)[2][2][4][2], const Unit& u, int wr, int wc, int fr, int fq) const {
        bf16_t* base = O + (((size_t)u.pm * NT + u.pn) * 8 + (wr * 4 + wc)) * (16 * 512) + (fq * 16 + fr) * 8;
#pragma unroll
        for (int ai = 0; ai < 2; ++ai)
#pragma unroll
            for (int m = 0; m < 4; ++m)
#pragma unroll
                for (int bj = 0; bj < 2; ++bj) { const f32x4 v0 = acc[ai][bj][m][0], v1 = acc[ai][bj][m][1];
                    u32x4 w; w.x = cvt_pk_bf16(v0[0], v0[1]); w.y = cvt_pk_bf16(v0[2], v0[3]); w.z = cvt_pk_bf16(v1[0], v1[1]); w.w = cvt_pk_bf16(v1[2], v1[3]);
                    *(u32x4*)(base + ((ai * 4 + m) * 2 + bj) * 512) = w; }
    }
};
}
namespace pg8 {
__device__ __forceinline__ float sigm(float x) { return __builtin_amdgcn_rcpf(1.0f + __expf(-x)); }
struct EpiLora {
    static constexpr bool PERM = true, AFTER_DRAIN = false;
    bf16_t* O; const float* w0; const float* a0;
    __device__ __forceinline__ void operator()(const f32x4 (&acc)[2][2][4][2], const Unit& u, int wr, int wc, int fr, int fq) const {
        const int row0 = u.pm * BM + wr * 64 + fr, col0 = u.pn * BM + wc * 32 + 8 * fq;
        const float* par = (u.pn >= 4) ? (a0 - 1024) : w0;
#pragma unroll
        for (int ai = 0; ai < 2; ++ai)
#pragma unroll
            for (int m = 0; m < 4; ++m) {
#pragma unroll
                for (int bj = 0; bj < 2; ++bj) { bf16_t* rowp = O + (size_t)(row0 + ai * HALF + m * 16) * 2048 + col0 + bj * HALF;
                    const f32x4 x0 = acc[ai][bj][m][0] + *(const f32x4*)(par + col0 + bj * HALF), x1 = acc[ai][bj][m][1] + *(const f32x4*)(par + col0 + bj * HALF + 4); u32x4 w;
                    w.x = cvt_pk_bf16(sigm(x0[0]), sigm(x0[1])); w.y = cvt_pk_bf16(sigm(x0[2]), sigm(x0[3])); w.z = cvt_pk_bf16(sigm(x1[0]), sigm(x1[1])); w.w = cvt_pk_bf16(sigm(x1[2]), sigm(x1[3]));
                    *(u32x4*)rowp = w; }
                asm volatile("" ::: "memory"); }
    }
};
template <int MODE> struct EpiGate {
    static constexpr bool PERM = true, AFTER_DRAIN = false;
    bf16_t* O; const bf16_t* Gl; bf16_t* F;
    __device__ __forceinline__ void operator()(const f32x4 (&acc)[2][2][4][2], const Unit& u, int wr, int wc, int fr, int fq) const {
        const int row0 = u.pm * BM + wr * 64 + fr, col0 = u.pn * BM + wc * 32 + 8 * fq;
        bf16_t* fbase = F + (((size_t)u.pm * 4 + u.pn) * 8 + (wr * 4 + wc)) * (16 * 512) + (fq * 16 + fr) * 8;
#pragma unroll
        for (int ai = 0; ai < 2; ++ai) {
            u32x4 gq[4][2], tq[4][2];
#pragma unroll
            for (int m = 0; m < 4; ++m)
#pragma unroll
                for (int bj = 0; bj < 2; ++bj) { const size_t row = (size_t)(row0 + ai * HALF + m * 16); const int col = col0 + bj * HALF;
                    gq[m][bj] = *(const u32x4*)(Gl + ((((((size_t)u.pm * 8 + (u.pn + 4 * MODE)) * 8 + (wr * 4 + wc)) * 2 + ai) * 4 + m) * 2 + bj) * 512 + (fq * 16 + fr) * 8);
                    if (MODE == 1) tq[m][bj] = *(const u32x4*)(fbase + ((ai * 4 + m) * 2 + bj) * 512); }
#pragma unroll
            for (int m = 0; m < 4; ++m)
#pragma unroll
                for (int bj = 0; bj < 2; ++bj) { const size_t row = (size_t)(row0 + ai * HALF + m * 16); const int col = col0 + bj * HALF;
                    const unsigned gw[4] = {gq[m][bj].x, gq[m][bj].y, gq[m][bj].z, gq[m][bj].w}; float g[8];
#pragma unroll
                    for (int e = 0; e < 4; ++e) { g[2 * e] = sigm(__builtin_bit_cast(float, gw[e] << 16)); g[2 * e + 1] = sigm(__builtin_bit_cast(float, gw[e] & 0xffff0000u)); }
                    const f32x4 v0 = acc[ai][bj][m][0], v1 = acc[ai][bj][m][1];
                    float r[8] = {g[0] * v0[0], g[1] * v0[1], g[2] * v0[2], g[3] * v0[3], g[4] * v1[0], g[5] * v1[1], g[6] * v1[2], g[7] * v1[3]};
                    if (MODE == 1) { const unsigned tw[4] = {tq[m][bj].x, tq[m][bj].y, tq[m][bj].z, tq[m][bj].w};
#pragma unroll
                        for (int e = 0; e < 4; ++e) { r[2 * e] += __builtin_bit_cast(float, tw[e] << 16); r[2 * e + 1] += __builtin_bit_cast(float, tw[e] & 0xffff0000u); } }
                    u32x4 w; w.x = cvt_pk_bf16(r[0], r[1]); w.y = cvt_pk_bf16(r[2], r[3]); w.z = cvt_pk_bf16(r[4], r[5]); w.w = cvt_pk_bf16(r[6], r[7]);
                    if (MODE == 0) *(u32x4*)(fbase + ((ai * 4 + m) * 2 + bj) * 512) = w; else *(u32x4*)(O + row * 1024 + col) = w; }
        }
    }
};
}
namespace pg8 {
struct EpiGateCat {
    static constexpr bool PERM = true, AFTER_DRAIN = false;
    bf16_t* O; const bf16_t* Gl;
    __device__ __forceinline__ void mid(f32x4 (&acc)[2][2][4][2], const Unit& u, int wr, int wc, int fr, int fq) const {
        const int row0 = u.pm * BM + wr * 64 + fr, col0 = u.pn * BM + wc * 32 + 8 * fq;
#pragma unroll
        for (int ai = 0; ai < 2; ++ai) {
            u32x4 gr[4][2], ga[4][2];
#pragma unroll
            for (int m = 0; m < 4; ++m)
#pragma unroll
                for (int bj = 0; bj < 2; ++bj) { const size_t row = (size_t)(row0 + ai * HALF + m * 16); const int col = col0 + bj * HALF;
                    gr[m][bj] = *(const u32x4*)(Gl + row * 2048 + col); ga[m][bj] = *(const u32x4*)(Gl + row * 2048 + 1024 + col); }
#pragma unroll
            for (int m = 0; m < 4; ++m)
#pragma unroll
                for (int bj = 0; bj < 2; ++bj) { const unsigned wr_[4] = {gr[m][bj].x, gr[m][bj].y, gr[m][bj].z, gr[m][bj].w}, wa_[4] = {ga[m][bj].x, ga[m][bj].y, ga[m][bj].z, ga[m][bj].w}; float rt[8];
#pragma unroll
                    for (int e = 0; e < 4; ++e) {
                        const float r0 = __builtin_bit_cast(float, wr_[e] << 16), r1 = __builtin_bit_cast(float, wr_[e] & 0xffff0000u), a0 = __builtin_bit_cast(float, wa_[e] << 16), a1 = __builtin_bit_cast(float, wa_[e] & 0xffff0000u);
                        rt[2 * e] = (1.0f + __expf(-a0)) * __builtin_amdgcn_rcpf(1.0f + __expf(-r0)); rt[2 * e + 1] = (1.0f + __expf(-a1)) * __builtin_amdgcn_rcpf(1.0f + __expf(-r1)); }
                    acc[ai][bj][m][0] = acc[ai][bj][m][0] * (f32x4){rt[0], rt[1], rt[2], rt[3]}; acc[ai][bj][m][1] = acc[ai][bj][m][1] * (f32x4){rt[4], rt[5], rt[6], rt[7]}; }
        }
    }
    __device__ __forceinline__ void operator()(const f32x4 (&acc)[2][2][4][2], const Unit& u, int wr, int wc, int fr, int fq) const {
        const int row0 = u.pm * BM + wr * 64 + fr, col0 = u.pn * BM + wc * 32 + 8 * fq;
#pragma unroll
        for (int ai = 0; ai < 2; ++ai) {
            u32x4 ga[4][2];
#pragma unroll
            for (int m = 0; m < 4; ++m)
#pragma unroll
                for (int bj = 0; bj < 2; ++bj) { const size_t row = (size_t)(row0 + ai * HALF + m * 16); const int col = col0 + bj * HALF; ga[m][bj] = *(const u32x4*)(Gl + row * 2048 + 1024 + col); }
#pragma unroll
            for (int m = 0; m < 4; ++m)
#pragma unroll
                for (int bj = 0; bj < 2; ++bj) { const size_t row = (size_t)(row0 + ai * HALF + m * 16); const int col = col0 + bj * HALF;
                    const unsigned wa_[4] = {ga[m][bj].x, ga[m][bj].y, ga[m][bj].z, ga[m][bj].w}; float g[8];
#pragma unroll
                    for (int e = 0; e < 4; ++e) { g[2 * e] = sigm(__builtin_bit_cast(float, wa_[e] << 16)); g[2 * e + 1] = sigm(__builtin_bit_cast(float, wa_[e] & 0xffff0000u)); }
                    const f32x4 v0 = acc[ai][bj][m][0], v1 = acc[ai][bj][m][1];
                    u32x4 w; w.x = cvt_pk_bf16(g[0] * v0[0], g[1] * v0[1]); w.y = cvt_pk_bf16(g[2] * v0[2], g[3] * v0[3]); w.z = cvt_pk_bf16(g[4] * v1[0], g[5] * v1[1]); w.w = cvt_pk_bf16(g[6] * v1[2], g[7] * v1[3]);
                    *(u32x4*)(O + row * 1024 + col) = w; }
        }
    }
};
}
namespace pg8 {
template <int CTRL> __device__ __forceinline__ float dppz(float v) { return __builtin_bit_cast(float, __builtin_amdgcn_update_dpp(0, __builtin_bit_cast(int, v), CTRL, 0xf, 0xf, true)); }
struct EpiShift {
    static constexpr bool PERM = true, AFTER_DRAIN = false;
    bf16_t* R4;
    bf16_t* LAo;
    bf16_t* PAo;
    bf16_t* EDGE;
    const float* mu;
    PG8_LAS unsigned char* halo;
    int Mrows;
    __device__ __forceinline__ static int hidx(int wr, int wc, int ai, int edge, int bj, int n, int fq) { return ((((((wr * 4 + wc) * 2 + ai) * 2 + edge) * 2 + bj) * 2 + n) * 4 + fq) * 16; }
    __device__ __forceinline__ void operator()(const f32x4 (&acc)[2][2][4][2], const Unit& u, int wr, int wc, int fr, int fq) const {
        const int row0 = u.pm * BM + wr * 64 + fr, colL = wc * 32 + 8 * fq;
        if (u.pn >= 9) {
            const int col0 = (u.pn - 9) * BM + colL;
#pragma unroll
            for (int ai = 0; ai < 2; ++ai)
#pragma unroll
                for (int m = 0; m < 4; ++m) { bf16_t* rowp = PAo + (size_t)(row0 + ai * HALF + m * 16) * 1280 + col0;
#pragma unroll
                    for (int bj = 0; bj < 2; ++bj) { const f32x4 v0 = acc[ai][bj][m][0], v1 = acc[ai][bj][m][1];
                        u32x4 w; w.x = cvt_pk_bf16(v0[0], v0[1]); w.y = cvt_pk_bf16(v0[2], v0[3]); w.z = cvt_pk_bf16(v1[0], v1[1]); w.w = cvt_pk_bf16(v1[2], v1[3]);
                        *(u32x4*)(rowp + bj * HALF) = w; } }
            return;
        }
        if (fr == 0 || fr == 15) { const int edge = fr == 15, mm = edge ? 3 : 0;
#pragma unroll
            for (int ai = 0; ai < 2; ++ai)
#pragma unroll
                for (int bj = 0; bj < 2; ++bj)
#pragma unroll
                    for (int n = 0; n < 2; ++n) *(PG8_LAS f32x4*)(halo + hidx(wr, wc, ai, edge, bj, n, fq)) = edge ? acc[ai][bj][3][n] : acc[ai][bj][0][n];
            (void)mm; }
        if ((wr == 0 && fr < 2) || (wr == 1 && fr >= 14)) { const int slot = wr == 0 ? fr : fr - 12;
            bf16_t* ep = EDGE + ((size_t)u.pm * 4 + slot) * 2304 + u.pn * BM + colL;
#pragma unroll
            for (int bj = 0; bj < 2; ++bj) { const f32x4 v0 = wr == 0 ? acc[0][bj][0][0] : acc[1][bj][3][0], v1 = wr == 0 ? acc[0][bj][0][1] : acc[1][bj][3][1];
                u32x4 w; w.x = cvt_pk_bf16(v0[0], v0[1]); w.y = cvt_pk_bf16(v0[2], v0[3]); w.z = cvt_pk_bf16(v1[0], v1[1]); w.w = cvt_pk_bf16(v1[2], v1[3]);
                *(u32x4*)(ep + bj * HALF) = w; } }
        asm volatile("s_waitcnt lgkmcnt(0)" ::: "memory");
        __builtin_amdgcn_s_barrier();
        asm volatile("" ::: "memory");
        const bool isla = u.pn == 8;
        bf16_t* obase = isla ? LAo : R4 + (size_t)(u.pn >> 1) * Mrows * 512 + (u.pn & 1) * 256;
        const int ld = isla ? 256 : 512;
#pragma unroll
        for (int bj = 0; bj < 2; ++bj) {
            const float* mup = mu + u.pn * BM + bj * HALF + colL;
            f32x4 m0[2], m1[2], c0[2];
#pragma unroll
            for (int n = 0; n < 2; ++n) { m0[n] = *(const f32x4*)(mup + 4 * n); m1[n] = *(const f32x4*)(mup + 2304 + 4 * n); c0[n] = 1.0f - m0[n] - m1[n]; }
#pragma unroll
            for (int ai = 0; ai < 2; ++ai) {
                f32x4 hp[2], hn[2];
                const bool hasp = (wr == 1) || (ai == 1), hasn = (wr == 0) || (ai == 0);
                const int pw = wr ^ 1, pai = (wr == 1) ? ai : 0, nai = (wr == 0) ? ai : 1;
#pragma unroll
                for (int n = 0; n < 2; ++n) { hp[n] = hasp ? *(const PG8_LAS f32x4*)(halo + hidx(pw, wc, pai, 1, bj, n, fq)) : (f32x4){0.f, 0.f, 0.f, 0.f};
                                              hn[n] = hasn ? *(const PG8_LAS f32x4*)(halo + hidx(pw, wc, nai, 0, bj, n, fq)) : (f32x4){0.f, 0.f, 0.f, 0.f}; }
                unsigned wq[4][4];
#pragma unroll
                for (int n = 0; n < 2; ++n) {
                    f32x4 A[4], B[4];
#pragma unroll
                    for (int m = 0; m < 4; ++m) { A[m] = acc[ai][bj][m][n] * m0[n]; B[m] = acc[ai][bj][m][n] * m1[n]; }
                    const f32x4 Ah = hp[n] * m0[n], Bh = hn[n] * m1[n];
#pragma unroll
                    for (int m = 0; m < 4; ++m) { const f32x4 p = acc[ai][bj][m][n], Am = m > 0 ? A[m > 0 ? m - 1 : 0] : Ah, Bp = m < 3 ? B[m < 3 ? m + 1 : 3] : Bh; float o[4];
#pragma unroll
                        for (int k = 0; k < 4; ++k) { float v = c0[n][k] * p[k];
                            v += dppz<0x111>(A[m][k]); v += dppz<0x10F>(Am[k]);
                            v += dppz<0x101>(B[m][k]); v += dppz<0x11F>(Bp[k]);
                            o[k] = v; }
                        if (isla && bj == 0) {
#pragma unroll
                            for (int e = 0; e < 4; ++e) o[e] = 1.0f - 2.0f * __builtin_amdgcn_rcpf(1.0f + __expf(2.0f * o[e])); }
                        wq[m][2 * n] = cvt_pk_bf16(o[0], o[1]); wq[m][2 * n + 1] = cvt_pk_bf16(o[2], o[3]); }
                }
#pragma unroll
                for (int m = 0; m < 4; ++m) { u32x4 w; w.x = wq[m][0]; w.y = wq[m][1]; w.z = wq[m][2]; w.w = wq[m][3];
                    *(u32x4*)(obase + (size_t)(row0 + ai * HALF + m * 16) * ld + bj * HALF + colL) = w; }
            }
        }
    }
};
}
#define GAS __attribute__((address_space(1)))
#define LAS __attribute__((address_space(3)))
typedef unsigned short bf16;
typedef unsigned v4u __attribute__((ext_vector_type(4)));
typedef float f32x4 __attribute__((ext_vector_type(4)));
typedef short bf16x8 __attribute__((ext_vector_type(8)));
typedef GAS unsigned gu32;
typedef GAS unsigned long long gu64;
#define RLX_AGENT __ATOMIC_RELAXED, __HIP_MEMORY_SCOPE_AGENT
#define LDS_WAIT() asm volatile("s_waitcnt lgkmcnt(0)" ::: "memory")
#define VM_WAIT() asm volatile("s_waitcnt vmcnt(0)" ::: "memory")
__device__ __forceinline__ unsigned long long rt() { return __builtin_amdgcn_s_memrealtime(); }
__device__ __forceinline__ unsigned f2bf(float f) { unsigned u = __builtin_bit_cast(unsigned, f); return (u + 0x7fffu + ((u >> 16) & 1u)) >> 16; }
__device__ __forceinline__ unsigned pk2(float lo, float hi) { return f2bf(lo) | (f2bf(hi) << 16); }
#define XB_TMO      128
#define XB_XCNT(j)  (256  + 64 * (j))
#define XB_XSUB(j)  (1280 + 64 * (j))
#define XB_XGEN(j)  (2304 + 64 * (j))
#define XB_TOP      3328
#define XB_TOPGEN   3392
#define XCD_BAR_WORDS 3456
#define XB_SPIN_CAP (1u << 18)

__device__ __forceinline__ unsigned xb_ld(unsigned* p)              { return __hip_atomic_load(p, __ATOMIC_RELAXED, __HIP_MEMORY_SCOPE_AGENT); }
__device__ __forceinline__ unsigned xb_add(unsigned* p, unsigned v) { return __hip_atomic_fetch_add(p, v, __ATOMIC_RELAXED, __HIP_MEMORY_SCOPE_AGENT); }
__device__ __forceinline__ unsigned xb_xcc_id() { return (unsigned)__builtin_amdgcn_s_getreg((3 << 11) | 20) & 0xFu; }
#define XB_SPIN(cond, bar) do { unsigned _sp = 0; while (cond) { __builtin_amdgcn_s_sleep(1); \
    if ((++_sp & 255u) == 0u) { if (xb_ld(&(bar)[XB_TMO])) break; if (_sp > XB_SPIN_CAP) { atomicAdd(&(bar)[XB_TMO], 1u); break; } } } } while (0)

struct XcdBarrier {
    unsigned* bar; unsigned x;
    volatile LAS unsigned* st;
};

__device__ __forceinline__ XcdBarrier xcd_barrier_post(unsigned* bar, volatile LAS unsigned* st) {
    XcdBarrier b; b.bar = bar; b.x = xb_xcc_id(); b.st = st;
    if (threadIdx.x == 0) (void)xb_add(&bar[XB_XCNT(b.x)], 1u);
    return b;
}
__device__ __forceinline__ void xcd_barrier_complete(unsigned* bar, unsigned x, unsigned& nloc, unsigned& nx) {
    const unsigned G = gridDim.x * gridDim.y * gridDim.z;
    unsigned sum, cnt, mine, sp = 0u;
    for (;;) {
        sum = 0u; cnt = 0u; mine = 0u;
#pragma unroll
        for (unsigned j = 0; j < 16; ++j) { const unsigned c = xb_ld(&bar[XB_XCNT(j)]); sum += c; cnt += (c > 0u) ? 1u : 0u; mine = (j == x) ? c : mine; }
        if (sum == G) break;
        __builtin_amdgcn_s_sleep(1);
        if ((++sp & 255u) == 0u) { if (xb_ld(&bar[XB_TMO])) break; if (sp > XB_SPIN_CAP) { atomicAdd(&bar[XB_TMO], 1u); break; } }
    }
    nloc = mine > 0u ? mine : 1u; nx = cnt > 0u ? cnt : 1u;
}

__device__ __forceinline__ void xcd_barrier(const XcdBarrier& b) {
    asm volatile("s_waitcnt vmcnt(0)" ::: "memory");
    __syncthreads();
    if (threadIdx.x == 0) {
        unsigned* bar = b.bar;
        __builtin_amdgcn_s_waitcnt(0);
        unsigned nloc = b.st[0], nx = b.st[1];
        if (nloc == 0u) { xcd_barrier_complete(bar, b.x, nloc, nx); b.st[0] = nloc; b.st[1] = nx; }
        const unsigned old = xb_add(&bar[XB_XSUB(b.x)], 1u);
        const unsigned gen = old / nloc;
        if (old + 1u == (gen + 1u) * nloc) {
            __builtin_amdgcn_fence(__ATOMIC_RELEASE, "agent");
            asm volatile("s_waitcnt vmcnt(0)" ::: "memory");
            const unsigned og = xb_add(&bar[XB_TOP], 1u);
            const unsigned tg = og / nx;
            if (og + 1u == (tg + 1u) * nx) xb_add(&bar[XB_TOPGEN], 1u);
            else XB_SPIN(xb_ld(&bar[XB_TOPGEN]) == tg, bar);
            __builtin_amdgcn_fence(__ATOMIC_ACQUIRE, "agent");
            xb_add(&bar[XB_XGEN(b.x)], 1u);
            asm volatile("s_waitcnt vmcnt(0)" ::: "memory");
        } else {
            XB_SPIN(xb_ld(&bar[XB_XGEN(b.x)]) == gen, bar);
            __builtin_amdgcn_fence(__ATOMIC_ACQUIRE, "agent");
            asm volatile("s_waitcnt vmcnt(0)" ::: "memory");
        }
    }
    __syncthreads();
}
constexpr int NWAVES = 8;
constexpr int BATCH = 32, SEQ = 2048, DM = 1024, M = BATCH * SEQ;
constexpr int RW = 512, RCOLS = 2304, ACOLS = 1280, GCOLS = 2048;
enum { I_X = 0, I_C, I_WADA, I_BADA, I_GPRE, I_GPOST, I_WIN, I_MU, I_W0, I_WUP, I_A0, I_AUP, I_KK, I_KA, I_RK, I_GNW, I_GNB, I_SINK, I_WBRR, I_WBRA, I_WOUT, NIN };
#ifndef MK_N_LAUNCHES
#define MK_N_LAUNCHES 1
#endif
constexpr int N_PHASES = 12;
#ifndef MK_PLAN
#define MK_PLAN {{0, N_PHASES}}
#endif
#ifndef MK_PROBE_FLAGS
#define MK_PROBE_FLAGS 0
#endif
constexpr int N_LAUNCHES = MK_N_LAUNCHES;
constexpr size_t MiB = 1u << 20;
constexpr size_t WS_CTL = 0, CTL_ZERO_BYTES = 1 * MiB;
constexpr size_t WS_ADA = 512 * 1024;
constexpr size_t WS_BSUM = 2 * MiB;
constexpr size_t WS_BP4 = 984 * MiB;
constexpr size_t WS_WINT = 4 * MiB;
constexpr size_t WS_WBRR = 15 * MiB, WS_WBRA = 16 * MiB, WS_WOUT = 17 * MiB, WS_WLORA = 19 * MiB;
constexpr size_t WS_H = 24 * MiB;
constexpr size_t WS_PA = 152 * MiB;
constexpr size_t WS_PR = 312 * MiB;
constexpr size_t WS_KD1 = 568 * MiB;
constexpr size_t WS_LA = 600 * MiB;
constexpr size_t WS_R = 632 * MiB, WS_K = 696 * MiB, WS_V = 760 * MiB, WS_G = 824 * MiB, WS_KK = 888 * MiB;
constexpr size_t WS_MG = 568 * MiB;
constexpr size_t WS_PG = 312 * MiB;
constexpr size_t WS_BR = 568 * MiB;
constexpr size_t WS_BA = 824 * MiB;
constexpr size_t WS_KB = 952 * MiB, WS_VB = 968 * MiB;
constexpr size_t WS_EDGE = 992 * MiB;
constexpr size_t WS_END = 1024 * MiB;
constexpr int CW_BAR = 4096;
constexpr int RING_BYTES = 155648, LDSCTL_OFF = RING_BYTES, MISC_OFF = LDSCTL_OFF + 320, LDS_BYTES = 163840;

__device__ __forceinline__ float bflo(unsigned w) { return __builtin_bit_cast(float, w << 16); }
__device__ __forceinline__ float bfhi(unsigned w) { return __builtin_bit_cast(float, w & 0xffff0000u); }
__device__ __forceinline__ float bf2f(bf16 u) { return __builtin_bit_cast(float, (unsigned)u << 16); }
__device__ __forceinline__ void unpack8(const v4u q, float* f) { f[0] = bflo(q.x); f[1] = bfhi(q.x); f[2] = bflo(q.y); f[3] = bfhi(q.y); f[4] = bflo(q.z); f[5] = bfhi(q.z); f[6] = bflo(q.w); f[7] = bfhi(q.w); }
__device__ __forceinline__ unsigned cvtpk_c(float lo, float hi);
__device__ __forceinline__ v4u pack8(const float* f) { v4u o; o.x = cvtpk_c(f[0], f[1]); o.y = cvtpk_c(f[2], f[3]); o.z = cvtpk_c(f[4], f[5]); o.w = cvtpk_c(f[6], f[7]); return o; }
__device__ __forceinline__ float sigmoidf_(float x) { return __builtin_amdgcn_rcpf(1.0f + __expf(-x)); }
__device__ __forceinline__ float wave_sum(float v) {
#pragma unroll
    for (int o = 1; o < 64; o <<= 1) v += __shfl_xor(v, o);
    return v;
}
__device__ __forceinline__ void transpose_item(const float* W, int K, int N, bf16* WT, int ldwt, int row_off, int kcol_off, LAS float* scr, int item, int lane) {
    const int nblk = N / 32, kb = item / nblk, nb = item % nblk, k0 = 64 * kb, n0 = 32 * nb;
#pragma unroll 8
    for (int i = 0; i < 32; ++i) { const int kk = 2 * i + (lane >> 5); scr[kk * 33 + (lane & 31)] = W[(size_t)(k0 + kk) * N + n0 + (lane & 31)]; }
    LDS_WAIT(); asm volatile("" ::: "memory");
    const int c = lane & 7;
#pragma unroll
    for (int j = 0; j < 4; ++j) { const int n = (lane >> 3) + 8 * j; const LAS float* s = scr + (8 * c) * 33 + n;
        v4u o; o.x = pk2(s[0 * 33], s[1 * 33]); o.y = pk2(s[2 * 33], s[3 * 33]); o.z = pk2(s[4 * 33], s[5 * 33]); o.w = pk2(s[6 * 33], s[7 * 33]);
        *(GAS v4u*)(WT + (size_t)(row_off + n0 + n) * ldwt + kcol_off + k0 + 8 * c) = o; }
    LDS_WAIT(); asm volatile("" ::: "memory");
}

typedef unsigned u32x2_t __attribute__((ext_vector_type(2)));
typedef float f32x2_c __attribute__((ext_vector_type(2))); typedef __bf16 bf16x2_c __attribute__((ext_vector_type(2)));
__device__ __forceinline__ unsigned cvtpk_c(float lo, float hi) { const f32x2_c v = {lo, hi}; const bf16x2_c b = __builtin_convertvector(v, bf16x2_c); return __builtin_bit_cast(unsigned, b); }
__device__ __forceinline__ bf16x8 ldsfrag_perm(const LAS unsigned char* p) { const u32x2_t a = *(const LAS u32x2_t*)p, b = *(const LAS u32x2_t*)(p + 16); return __builtin_bit_cast(bf16x8, (v4u){a.x, a.y, b.x, b.y}); }
template <int CTRL> __device__ __forceinline__ float dppf(float v) { return __builtin_bit_cast(float, __builtin_amdgcn_update_dpp(0, __builtin_bit_cast(int, v), CTRL, 0xf, 0xf, true)); }
struct Args { const float* in[NIN]; float* out; unsigned char* ws; int ph_lo, ph_hi, li, pad; };

#define PTRS const int G = gridDim.x, bx = blockIdx.x; const int vcu = (G % 8 == 0) ? (bx % 8) * (G / 8) + bx / 8 : bx; const int gw = vcu * NWAVES + wave, NGW = G * NWAVES; (void)gw; (void)NGW; const float* x = args.in[I_X]; const float* cin = args.in[I_C]; const float* wada = args.in[I_WADA]; const float* bada = args.in[I_BADA]; const float* gpre = args.in[I_GPRE]; const float* gpost = args.in[I_GPOST]; const float* win = args.in[I_WIN]; const float* mu = args.in[I_MU]; const float* w0 = args.in[I_W0]; const float* wup = args.in[I_WUP]; const float* a0 = args.in[I_A0]; const float* aup = args.in[I_AUP]; const float* k_k = args.in[I_KK]; const float* k_a = args.in[I_KA]; const float* r_k = args.in[I_RK]; const float* gnw = args.in[I_GNW]; const float* gnb = args.in[I_GNB]; const float* sink = args.in[I_SINK]; const float* wbrr = args.in[I_WBRR]; const float* wbra = args.in[I_WBRA]; const float* wout = args.in[I_WOUT]; float* out = args.out; float* ADA = (float*)(ws + WS_ADA); float* BSUM = (float*)(ws + WS_BSUM); float* BP4 = (float*)(ws + WS_BP4); (void)BSUM; bf16* WinT = (bf16*)(ws + WS_WINT); bf16* WbrrT = (bf16*)(ws + WS_WBRR); bf16* WbraT = (bf16*)(ws + WS_WBRA); bf16* WoutT = (bf16*)(ws + WS_WOUT); bf16* WloraT = (bf16*)(ws + WS_WLORA); bf16* Hb = (bf16*)(ws + WS_H); bf16* MG = (bf16*)(ws + WS_MG); bf16* PA = (bf16*)(ws + WS_PA); bf16* PR = (bf16*)(ws + WS_PR); bf16* RAW = (bf16*)(ws + WS_PR); bf16* PGT = (bf16*)(ws + WS_PG); bf16* OUTB = (bf16*)(ws + WS_PR); bf16* KD1 = (bf16*)(ws + WS_KD1); bf16* LA = (bf16*)(ws + WS_LA); bf16* Rb = (bf16*)(ws + WS_R); bf16* Kb = (bf16*)(ws + WS_K); bf16* Vb = (bf16*)(ws + WS_V); bf16* Gb = (bf16*)(ws + WS_G); bf16* KKb = (bf16*)(ws + WS_KK); bf16* KB = (bf16*)(ws + WS_KB); bf16* VB = (bf16*)(ws + WS_VB); bf16* EDGE = (bf16*)(ws + WS_EDGE); bf16* BR = (bf16*)(ws + WS_BR); bf16* BA = (bf16*)(ws + WS_BA);
__global__ void __launch_bounds__(NWAVES * 64, 2) mk_fwd(Args args) {
    extern __shared__ __attribute__((aligned(16))) unsigned char lds_raw[];
    LAS unsigned char* lds = (LAS unsigned char*)lds_raw;
    volatile LAS unsigned* MISC = (volatile LAS unsigned*)(lds + MISC_OFF);
    const int tid = threadIdx.x, lane = tid & 63, wave = __builtin_amdgcn_readfirstlane(tid >> 6);
    unsigned char* ws = args.ws;
    gu32* ctl = (gu32*)(ws + WS_CTL);
    for (int u = tid; u < (LDS_BYTES - LDSCTL_OFF) / 4; u += NWAVES * 64) ((LAS unsigned*)(lds + LDSCTL_OFF))[u] = 0u;
    __syncthreads();
    XcdBarrier bar; bar.bar = (unsigned*)(ctl + CW_BAR); bar.x = 0; bar.st = nullptr;
    const bool use_bar = (args.ph_hi - args.ph_lo) > 1;
    if (use_bar) bar = xcd_barrier_post((unsigned*)(ctl + CW_BAR) + args.li * XCD_BAR_WORDS, MISC + 8);
#define GRID_BAR() do { if (use_bar) xcd_barrier(bar); } while (0)
#define IN(k) (args.ph_lo <= (k) && (k) < args.ph_hi)
#define BOTH(k) (IN(k) && IN((k) + 1))
    if (IN(0)) { PTRS
        LAS float* scr = (LAS float*)(lds + wave * 16384);
        constexpr int I_IN = 16 * 176, I_BRR = 8 * 32, I_OUT = 16 * 32, I_LORA = 64, NT = I_IN + 2 * I_BRR + I_OUT + I_LORA;
        for (int it = gw; it < NT; it += NGW) {
            int r = it;
            if (r < I_IN) { transpose_item(win, 1024, 5632, WinT, 1024, 0, 0, scr, r, lane); continue; } r -= I_IN;
            if (r < I_BRR) { transpose_item(wbrr, 512, 1024, WbrrT, 512, 0, 0, scr, r, lane); continue; } r -= I_BRR;
            if (r < I_BRR) { transpose_item(wbra, 512, 1024, WbraT, 512, 0, 0, scr, r, lane); continue; } r -= I_BRR;
            if (r < I_OUT) { transpose_item(wout, 1024, 1024, WoutT, 1024, 0, 0, scr, r, lane); continue; } r -= I_OUT;
            { const int mat = r >> 4, nb = r & 15, half = mat >> 1, dd = mat & 1; const float* W = (half ? aup : wup) + (size_t)dd * 64 * 512;
              bf16* WL = WloraT + (size_t)half * 1024 * 128;
              transpose_item(W, 64, 512, WL, 128, dd * 512, dd * 64, scr, nb, lane);
#pragma unroll
              for (int i = 0; i < 4; ++i) { const int q = lane + 64 * i, row = q >> 3, chunk = (q & 7) + (dd ? 0 : 8);
                  *(GAS v4u*)(WL + (size_t)(dd * 512 + nb * 32 + row) * 128 + chunk * 8) = (v4u){0u, 0u, 0u, 0u}; } }
        }
        for (int it = gw; it < 1536; it += NGW) {
            const int nblk = it % 48, r_ = it / 48, bg = r_ & 7, kq = r_ >> 3, n = nblk * 64 + lane, b0 = bg * 4, kbase = kq * 256;
#pragma unroll
            for (int bb = 0; bb < 4; ++bb)
#pragma unroll
                for (int kk = 0; kk < 4; ++kk) { const int k = lane + 64 * kk; const float cv = cin[(b0 + bb) * 1024 + kbase + k]; scr[k * 4 + bb] = cv * sigmoidf_(cv); }
            LDS_WAIT(); asm volatile("" ::: "memory");
            float acc[4] = {0.f, 0.f, 0.f, 0.f};
#pragma unroll 32
            for (int k = 0; k < 256; ++k) { const float wv = wada[(size_t)(kbase + k) * 3072 + n]; const f32x4 s = *(const LAS f32x4*)(scr + k * 4);
                acc[0] += s[0] * wv; acc[1] += s[1] * wv; acc[2] += s[2] * wv; acc[3] += s[3] * wv; }
            const float bn = kq == 0 ? bada[n] : 0.f;
#pragma unroll
            for (int bb = 0; bb < 4; ++bb) atomicAdd(ADA + (b0 + bb) * 3072 + n, acc[bb] + bn);
            LDS_WAIT(); asm volatile("" ::: "memory");
        }
        if (BOTH(0)) GRID_BAR();
    }
    if (IN(1)) { PTRS
        {
            f32x4 v[4], vn[4];
#define P1_LOAD(mm, V) do { const GAS f32x4* xr_ = (const GAS f32x4*)(x + (size_t)(mm) * DM) + lane; _Pragma("unroll") for (int j = 0; j < 4; ++j) V[j] = xr_[64 * j]; } while (0)
            if (gw < M) P1_LOAD(gw, vn);
            for (int m = gw; m < M; m += NGW) {
                const int b = m >> 11;
#pragma unroll
                for (int j = 0; j < 4; ++j) v[j] = vn[j];
                if (m + NGW < M) P1_LOAD(m + NGW, vn);
                float s = 0.f;
#pragma unroll
                for (int j = 0; j < 4; ++j) s += (v[j].x * v[j].x + v[j].y * v[j].y) + (v[j].z * v[j].z + v[j].w * v[j].w);
                const float rinv = 1.0f / sqrtf(wave_sum(s) * (1.f / DM) + 1e-6f);
                GAS unsigned long long* o8 = (GAS unsigned long long*)(Hb + (size_t)m * DM) + lane;
#pragma unroll
                for (int j = 0; j < 4; ++j) { const int c = 4 * (lane + 64 * j);
                    const f32x4 gp = *(const f32x4*)(gpre + c), sh = *(const f32x4*)(ADA + b * 3072 + c), sc = *(const f32x4*)(ADA + b * 3072 + 1024 + c);
                    const f32x4 hh = v[j] * rinv * gp * (sc + 1.0f) + sh;
                    o8[64 * j] = (unsigned long long)cvtpk_c(hh.x, hh.y) | ((unsigned long long)cvtpk_c(hh.z, hh.w) << 32); }
            }
#undef P1_LOAD
        }
        if (BOTH(1)) GRID_BAR();
    }
    if (IN(2)) { PTRS
        pg8::Gemm g{Hb, WinT, M, 3584, 1024, 1024}; pg8::StaticOrder S; S.init(M, 3584, G, bx);
        pg8::EpiShift E{Rb, LA, PA, EDGE, mu, lds + pg8::STAGE_BYTES, M};
        pg8::gemm_phase<pg8::EpiShift, pg8::StaticOrder, true, true>(lds, g, S, E);
        if (BOTH(2)) GRID_BAR();
    }
    if (IN(3)) { PTRS
        {
            const v4u zero4 = (v4u){0u, 0u, 0u, 0u};
            for (int it = gw; it < 2 * (M / 256); it += NGW) {
                const int pm = it >> 1, e = it & 1, m = pm * 256 + (e ? 255 : 0), tseg = pm & 7;
                const bf16* ec = EDGE + ((size_t)pm * 4 + (e ? 3 : 0)) * RCOLS;
                const bf16* ep = e ? EDGE + ((size_t)pm * 4 + 2) * RCOLS : EDGE + ((size_t)(pm - 1) * 4 + 3) * RCOLS;
                const bf16* en = e ? EDGE + ((size_t)(pm + 1) * 4 + 0) * RCOLS : EDGE + ((size_t)pm * 4 + 1) * RCOLS;
                const bool hasp = e || tseg > 0, hasn = !e || tseg < 7;
#pragma unroll
                for (int i = 0; i < 5; ++i) {
                    if (i == 4 && lane >= 32) break;
                    const int c = 8 * (lane + 64 * i);
                    const v4u cu = *(const v4u*)(ec + c), pv = hasp ? *(const v4u*)(ep + c) : zero4, nx = hasn ? *(const v4u*)(en + c) : zero4;
                    const f32x4 m0a = *(const f32x4*)(mu + c), m0b = *(const f32x4*)(mu + c + 4), m1a = *(const f32x4*)(mu + RCOLS + c), m1b = *(const f32x4*)(mu + RCOLS + c + 4);
                    const float mm0[8] = {m0a.x, m0a.y, m0a.z, m0a.w, m0b.x, m0b.y, m0b.z, m0b.w}, mm1[8] = {m1a.x, m1a.y, m1a.z, m1a.w, m1b.x, m1b.y, m1b.z, m1b.w};
                    float p[8], pp[8], pn[8], o[8];
                    unpack8(cu, p); unpack8(pv, pp); unpack8(nx, pn);
#pragma unroll
                    for (int e8 = 0; e8 < 8; ++e8) o[e8] = p[e8] + mm0[e8] * (pp[e8] - p[e8]) + mm1[e8] * (pn[e8] - p[e8]);
                    if (i == 0) { *(v4u*)(Rb + (size_t)m * RW + c) = pack8(o); }
                    else if (i == 1) { const int cc = c - 512;
                        *(v4u*)(Kb + (size_t)m * RW + cc) = pack8(o);
                        const f32x4 ka_ = *(const f32x4*)(k_k + cc), kb_ = *(const f32x4*)(k_k + cc + 4);
                        const float kkw[8] = {ka_.x, ka_.y, ka_.z, ka_.w, kb_.x, kb_.y, kb_.z, kb_.w};
                        float kr[8]; float ss = 0.f;
#pragma unroll
                        for (int e8 = 0; e8 < 8; ++e8) { kr[e8] = o[e8] * kkw[e8]; ss += kr[e8] * kr[e8]; }
                        ss += __shfl_xor(ss, 1); ss += __shfl_xor(ss, 2); ss += __shfl_xor(ss, 4);
                        const float inv = 1.0f / fmaxf(sqrtf(ss), 1e-12f);
#pragma unroll
                        for (int e8 = 0; e8 < 8; ++e8) kr[e8] *= inv;
                        *(v4u*)(KKb + (size_t)m * RW + cc) = pack8(kr); }
                    else if (i == 2) { *(v4u*)(Vb + (size_t)m * RW + (c - 1024)) = pack8(o); }
                    else if (i == 3) { *(v4u*)(Gb + (size_t)m * RW + (c - 1536)) = pack8(o); }
                    else { if (lane < 16) {
#pragma unroll
                            for (int e8 = 0; e8 < 8; ++e8) o[e8] = 1.0f - 2.0f * __builtin_amdgcn_rcpf(1.0f + __expf(2.0f * o[e8])); }
                        *(v4u*)(LA + (size_t)m * 256 + (c - 2048)) = pack8(o); }
                }
            }
            const int cc = 8 * lane;
            const f32x4 ka_ = *(const f32x4*)(k_k + cc), kb_ = *(const f32x4*)(k_k + cc + 4);
            const float kkw[8] = {ka_.x, ka_.y, ka_.z, ka_.w, kb_.x, kb_.y, kb_.z, kb_.w};
            v4u kq = zero4, kqn = zero4;
            if (gw < M) kqn = *(const v4u*)(Kb + (size_t)gw * RW + cc);
            for (int m = gw; m < M; m += NGW) {
                kq = kqn;
                if (m + NGW < M) kqn = *(const v4u*)(Kb + (size_t)(m + NGW) * RW + cc);
                const int tr = m & 255;
                if (tr == 0 || tr == 255) continue;
                float kf[8], kr[8]; float ss = 0.f;
                unpack8(kq, kf);
#pragma unroll
                for (int e8 = 0; e8 < 8; ++e8) { kr[e8] = kf[e8] * kkw[e8]; ss += kr[e8] * kr[e8]; }
                ss += dppf<0xB1>(ss); ss += dppf<0x4E>(ss); ss += dppf<0x141>(ss);
                const float inv = 1.0f / fmaxf(sqrtf(ss), 1e-12f);
#pragma unroll
                for (int e8 = 0; e8 < 8; ++e8) kr[e8] *= inv;
                *(v4u*)(KKb + (size_t)m * RW + cc) = pack8(kr);
            }
        }
        {
            LAS unsigned char* scr8 = lds + wave * 16384;
            for (int u = gw; u < 2048; u += NGW) {
                const int b = u >> 6, kvh = (u >> 5) & 1, tb = u & 31;
                const bf16* srck = PA + ((size_t)b * SEQ + tb * 64 + lane) * ACOLS + 512 + kvh * 64;
                const size_t tile0 = ((size_t)(b * 2 + kvh) * 64 + 2 * tb);
#pragma unroll
                for (int j8 = 0; j8 < 8; ++j8) *(LAS v4u*)(scr8 + lane * 144 + 16 * j8) = *(const v4u*)(srck + 8 * j8);
                LDS_WAIT(); asm volatile("" ::: "memory");
#pragma unroll
                for (int tt = 0; tt < 2; ++tt)
#pragma unroll
                    for (int ks = 0; ks < 4; ++ks) *(v4u*)(KB + (((tile0 + tt) * 4 + ks) * 64 + lane) * 8) = *(const LAS v4u*)(scr8 + (32 * tt + (lane & 31)) * 144 + (16 * ks + 8 * (lane >> 5)) * 2);
                LDS_WAIT(); asm volatile("" ::: "memory");
                LAS unsigned short* tile = (LAS unsigned short*)scr8;
                const bf16* srcv = srck + 128;
#pragma unroll
                for (int j8 = 0; j8 < 8; ++j8) { const v4u qv = *(const v4u*)(srcv + 8 * j8); LAS unsigned* dst = (LAS unsigned*)(tile + lane * 66 + 8 * j8);
                    dst[0] = qv.x; dst[1] = qv.y; dst[2] = qv.z; dst[3] = qv.w; }
                LDS_WAIT(); asm volatile("" ::: "memory");
#pragma unroll
                for (int tt = 0; tt < 2; ++tt)
#pragma unroll
                    for (int mb = 0; mb < 2; ++mb)
#pragma unroll
                        for (int k2 = 0; k2 < 2; ++k2) { unsigned w[4];
#pragma unroll
                            for (int e = 0; e < 4; ++e) { const int j0 = 2 * e, key0 = 32 * tt + 16 * k2 + 8 * (j0 >> 2) + 4 * (lane >> 5) + (j0 & 3);
                                const unsigned lo16 = tile[key0 * 66 + 32 * mb + (lane & 31)], hi16 = tile[(key0 + 1) * 66 + 32 * mb + (lane & 31)]; w[e] = lo16 | (hi16 << 16); }
                            *(v4u*)(VB + ((((tile0 + tt) * 2 + mb) * 2 + k2) * 64 + lane) * 8) = (v4u){w[0], w[1], w[2], w[3]}; }
                LDS_WAIT(); asm volatile("" ::: "memory");
            }
        }
        if (BOTH(3)) GRID_BAR();
    }
    if (IN(4)) { PTRS
        pg8::Gemm g{LA, WloraT, M, 2048, 128, 256, 4, 256}; pg8::StaticOrder S; S.init(M, 2048, G, bx);
        pg8::EpiLora E{RAW, w0, a0};
        pg8::gemm_phase<pg8::EpiLora, pg8::StaticOrder, true, true>(lds, g, S, E);
        if (BOTH(4)) GRID_BAR();
    }
    if (IN(6)) { PTRS
        typedef float f32x16 __attribute__((ext_vector_type(16)));
#define MF(a, b, c) __builtin_amdgcn_mfma_f32_32x32x16_bf16(a, b, c, 0, 0, 0)
#define ACCF(x, s) __builtin_bit_cast(bf16x8, (v4u){cvtpk_c((x)[8 * (s) + 0], (x)[8 * (s) + 1]), cvtpk_c((x)[8 * (s) + 2], (x)[8 * (s) + 3]), cvtpk_c((x)[8 * (s) + 4], (x)[8 * (s) + 5]), cvtpk_c((x)[8 * (s) + 6], (x)[8 * (s) + 7])})
#define LDN(img, pitch, rowb, k0) (*(const LAS bf16x8*)((img) + ((rowb) + q) * (pitch) + ((k0) + 8 * hh) * 2))
#define LDP(img, pitch, rowb, k0) ldsfrag_perm((img) + ((rowb) + q) * (pitch) + ((k0) + 4 * hh) * 2)
#define ZERO16(x) do { _Pragma("unroll") for (int r_ = 0; r_ < 16; ++r_) (x)[r_] = 0.f; } while (0)
#define MMAA(X, Y, Cacc) do { const bf16x8 xa_ = ACCF(X, 0), xb_ = ACCF(X, 1), ya_ = ACCF(Y, 0), yb_ = ACCF(Y, 1); Cacc = MF(xa_, ya_, Cacc); Cacc = MF(xb_, yb_, Cacc); } while (0)
#define PROGW(k) ((volatile LAS unsigned*)(lds + LDSCTL_OFF + 1024 + (k) * 64))
#define SPIN_UNTIL(cond) do { while (!(cond)) __builtin_amdgcn_s_sleep(1); asm volatile("" ::: "memory"); } while (0)
        constexpr int NCH = SEQ / 32;
        const int q = lane & 31, hh = lane >> 5;
        const bool run_scan = !(args.pad & 1);
        if (wave < 4 && run_scan) {
            const int sl = wave >> 1, ib = wave & 1;
            const int s = 2 * vcu + sl; const int d = s & 1, bh = s >> 1, b = bh >> 3, h = bh & 7;
            LAS unsigned char* sbase = lds + sl * 57856;
            LAS unsigned char* VT0 = lds + 115712 + wave * 5120;
            const LAS unsigned char* FR = lds + 136192 + sl * 8192;
            volatile LAS unsigned* progE = PROGW(wave); volatile LAS unsigned* ptE = PROGW(wave ^ 1); volatile LAS unsigned* progM = PROGW(4 + wave); volatile LAS unsigned* ptM = PROGW(4 + (wave ^ 1));
            volatile LAS unsigned* progF = PROGW(8 + wave); volatile LAS unsigned* progH = PROGW(12 + sl);
            const int cp = lane & 15, tq = lane >> 4;
            bf16* pY = RAW + d * 512 + h * 64 + ib * 32 + q;
            const unsigned tsel = d ? (unsigned)(3 - tq) : (unsigned)tq;
            const unsigned offS = tsel * 8u * 4096u + 64u * ib + 4u * cp, offT = tsel * 8u * 1024u + 64u * ib + 4u * cp;
            const unsigned oS = (unsigned)((d * 512 + h * 64) * 2), oT = (unsigned)(h * 128);
            unsigned pf[5][8], vq[8];
#define PF_TOK(cc, tl) ((unsigned)(b * SEQ + (d ? (SEQ - 1 - 32 * (cc) - (tl) - 24) : (32 * (cc) + (tl)))))
#define PF_ISSUE(cc, T0, T1) do { unsigned vS_ = offS, vT_ = offT; asm volatile("" : "+v"(vS_), "+v"(vT_));        \
            _Pragma("unroll") for (int tl = (T0); tl < (T1); ++tl) { const unsigned m0 = PF_TOK(cc, tl); \
                pf[0][tl] = *(const unsigned*)((ws + ((unsigned)WS_PR + oS + m0 * 4096u)) + vS_); pf[1][tl] = *(const unsigned*)((ws + ((unsigned)WS_PR + 2048u + oS + m0 * 4096u)) + vS_); pf[2][tl] = *(const unsigned*)((ws + ((unsigned)WS_KK + oT + m0 * 1024u)) + vT_); \
                pf[3][tl] = *(const unsigned*)((ws + ((unsigned)WS_K + oT + m0 * 1024u)) + vT_); pf[4][tl] = *(const unsigned*)((ws + ((unsigned)WS_R + oT + m0 * 1024u)) + vT_); } } while (0)
            PF_ISSUE(0, 0, 8);
            { unsigned vT_ = offT; asm volatile("" : "+v"(vT_));
#pragma unroll
              for (int tl = 0; tl < 8; ++tl) { const unsigned m0 = PF_TOK(0, tl); vq[tl] = *(const unsigned*)((ws + ((unsigned)WS_V + oT + m0 * 1024u)) + vT_); } }
            f32x16 H0a, H0b; ZERO16(H0a); ZERO16(H0b);
            for (int it = 0; it <= NCH; ++it) {
                if (it < NCH) {
                    LAS unsigned char* KQ = sbase + (it & 1) * 28928, *RQ = KQ + 4608, *KKI = KQ + 9216, *BKI = KQ + 13824, *KCT = KQ + 18432, *BCT = KQ + 23552; LAS float* GC = (LAS float*)(KQ + 28672);
                    LAS unsigned char* VTI = VT0 + (it & 1) * 2560;
                    if (it >= 2) SPIN_UNTIL(*progH + 1u >= (unsigned)it && *ptM + 1u >= (unsigned)it);
                    {
                    const float ka0 = k_a[h * 64 + 32 * ib + 2 * cp], ka1 = k_a[h * 64 + 32 * ib + 2 * cp + 1];
                    const float rk0 = r_k[h * 64 + 32 * ib + 2 * cp], rk1 = r_k[h * 64 + 32 * ib + 2 * cp + 1];
                    const int cn = it + 1 < NCH ? it + 1 : it;
                    unsigned nS_ = offS, nT_ = offT; asm volatile("" : "+v"(nS_), "+v"(nT_));
                    float t0 = 0.f, t1 = 0.f;
#pragma unroll
                    for (int tl = 0; tl < 8; ++tl) { t0 += bflo(pf[0][tl]); t1 += bfhi(pf[0][tl]); }
                    t0 *= -0.6065306597f; t1 *= -0.6065306597f;
                    float o0, o1, tot0, tot1;
                    {   const auto a0_ = __builtin_amdgcn_permlane16_swap(__float_as_uint(t0), __float_as_uint(t0), false, false), a1_ = __builtin_amdgcn_permlane16_swap(__float_as_uint(t1), __float_as_uint(t1), false, false);
                        const float n0 = (tq & 1) ? __uint_as_float(a0_[0]) : __uint_as_float(a0_[1]), n1 = (tq & 1) ? __uint_as_float(a1_[0]) : __uint_as_float(a1_[1]);
                        const float p0 = t0 + n0, p1 = t1 + n1;
                        const auto b0_ = __builtin_amdgcn_permlane32_swap(__float_as_uint(p0), __float_as_uint(p0), false, false), b1_ = __builtin_amdgcn_permlane32_swap(__float_as_uint(p1), __float_as_uint(p1), false, false);
                        const float q0 = (tq & 2) ? __uint_as_float(b0_[0]) : __uint_as_float(b0_[1]), q1 = (tq & 2) ? __uint_as_float(b1_[0]) : __uint_as_float(b1_[1]);
                        o0 = ((tq & 1) ? n0 : 0.f) + ((tq & 2) ? q0 : 0.f); o1 = ((tq & 1) ? n1 : 0.f) + ((tq & 2) ? q1 : 0.f); tot0 = p0 + q0; tot1 = p1 + q1; }
                    const float gC0 = __expf(tot0), gC1 = __expf(tot1);
                    float L0 = o0, L1 = o1; float eLp0 = __expf(L0), eLp1 = __expf(L1);
                    if (tq == 0) { GC[32 * ib + 2 * cp] = gC0; GC[32 * ib + 2 * cp + 1] = gC1; }
                    float bpk = 0.f;
#pragma unroll
                    for (int t2 = 0; t2 < 4; ++t2) {
                        float kc0[2], kc1[2], bc0[2], bc1[2];
#pragma unroll
                        for (int e = 0; e < 2; ++e) { const int tl = 2 * t2 + e, tau = 8 * tq + tl;
                            const float sg0 = bflo(pf[0][tl]), sg1 = bfhi(pf[0][tl]), a0_ = bflo(pf[1][tl]), a1_ = bfhi(pf[1][tl]), kk0 = bflo(pf[2][tl]), kk1 = bfhi(pf[2][tl]);
                            const float k0_ = bflo(pf[3][tl]), k1_ = bfhi(pf[3][tl]), r0_ = bflo(pf[4][tl]), r1_ = bfhi(pf[4][tl]);
                            L0 += -0.6065306597f * sg0; L1 += -0.6065306597f * sg1;
                            const float eL0 = __expf(L0), eL1 = __expf(L1), en0 = __builtin_amdgcn_rcpf(eL0), en1 = __builtin_amdgcn_rcpf(eL1);
                            const float kd0 = k0_ * (1.0f + (a0_ - 1.0f) * ka0), kd1 = k1_ * (1.0f + (a1_ - 1.0f) * ka1);
                            const float kkf0 = kd0 * en0, kkf1 = kd1 * en1, bkf0 = kk0 * a0_ * en0, bkf1 = kk1 * a1_ * en1;
                            {
                                float bp = r0_ * kd0 * rk0 + r1_ * kd1 * rk1;
                                bp += __shfl_xor(bp, 1); bp += __shfl_xor(bp, 2); bp += __shfl_xor(bp, 4); bp += __shfl_xor(bp, 8);
                                bpk = (cp == tl) ? bp : bpk; }
                            ((LAS unsigned*)KQ)[tau * 36 + 16 * ib + cp] = pg8::cvt_pk_bf16(kk0 * eLp0, kk1 * eLp1); ((LAS unsigned*)RQ)[tau * 36 + 16 * ib + cp] = pg8::cvt_pk_bf16(r0_ * eL0, r1_ * eL1);
                            ((LAS unsigned*)KKI)[tau * 36 + 16 * ib + cp] = pg8::cvt_pk_bf16(kkf0, kkf1); ((LAS unsigned*)BKI)[tau * 36 + 16 * ib + cp] = pg8::cvt_pk_bf16(bkf0, bkf1);
                            kc0[e] = kkf0 * gC0; kc1[e] = kkf1 * gC1; bc0[e] = -bkf0 * gC0; bc1[e] = -bkf1 * gC1;
                            eLp0 = eL0; eLp1 = eL1;
                            { const unsigned m0 = PF_TOK(cn, tl);
                              pf[0][tl] = *(const unsigned*)((ws + ((unsigned)WS_PR + oS + m0 * 4096u)) + nS_); pf[1][tl] = *(const unsigned*)((ws + ((unsigned)WS_PR + 2048u + oS + m0 * 4096u)) + nS_); pf[2][tl] = *(const unsigned*)((ws + ((unsigned)WS_KK + oT + m0 * 1024u)) + nT_);
                              pf[3][tl] = *(const unsigned*)((ws + ((unsigned)WS_K + oT + m0 * 1024u)) + nT_); pf[4][tl] = *(const unsigned*)((ws + ((unsigned)WS_R + oT + m0 * 1024u)) + nT_); } }
                        const int sp = 4 * tq + t2;
                        const int j0 = 32 * ib + 2 * cp;
                        ((LAS unsigned*)KCT)[j0 * 20 + sp] = pg8::cvt_pk_bf16(kc0[0], kc0[1]); ((LAS unsigned*)KCT)[(j0 + 1) * 20 + sp] = pg8::cvt_pk_bf16(kc1[0], kc1[1]);
                        ((LAS unsigned*)BCT)[j0 * 20 + sp] = pg8::cvt_pk_bf16(bc0[0], bc0[1]); ((LAS unsigned*)BCT)[(j0 + 1) * 20 + sp] = pg8::cvt_pk_bf16(bc1[0], bc1[1]);
                    }
                    if (cp < 8) { const int tt_ = 32 * it + 8 * tq + cp; const size_t mt_ = (size_t)b * SEQ + (d ? (SEQ - 1 - tt_) : tt_); BP4[((size_t)(d * 2 + ib) * M + mt_) * 8 + h] = bpk; }
#pragma unroll
                    for (int t2 = 0; t2 < 4; ++t2) { const int sp = 4 * tq + t2; const unsigned va = vq[2 * t2], vb = vq[2 * t2 + 1];
                        ((LAS unsigned*)VTI)[(2 * cp) * 20 + sp] = (va & 0xffffu) | (vb << 16); ((LAS unsigned*)VTI)[(2 * cp + 1) * 20 + sp] = (va >> 16) | (vb & 0xffff0000u); }
#pragma unroll
                    for (int tl = 0; tl < 8; ++tl) { const unsigned m0 = PF_TOK(cn, tl); vq[tl] = *(const unsigned*)((ws + ((unsigned)WS_V + oT + m0 * 1024u)) + nT_); }
                }
                    asm volatile("s_waitcnt lgkmcnt(0)" ::: "memory");
                    *progE = (unsigned)(it + 1);
                }
                if (it >= 1) {
                    const int c = it - 1;
                    const LAS unsigned char* KQ = sbase + (c & 1) * 28928, *RQ = KQ + 4608, *KCT = KQ + 18432, *BCT = KQ + 23552; const LAS float* GC = (const LAS float*)(KQ + 28672);
                    const LAS unsigned char* VTI = VT0 + (c & 1) * 2560;
                    SPIN_UNTIL(*ptE >= (unsigned)(c + 1));
                    f32x16 Zacc, Yacc, U; ZERO16(Zacc); ZERO16(Yacc); ZERO16(U);
                    const bf16x8 h0f0 = ACCF(H0a, 0), h0f1 = ACCF(H0a, 1), h0f2 = ACCF(H0b, 0), h0f3 = ACCF(H0b, 1);
                    Zacc = MF(LDP(KQ, 144, 0, 0), h0f0, Zacc); Zacc = MF(LDP(KQ, 144, 0, 16), h0f1, Zacc); Zacc = MF(LDP(KQ, 144, 0, 32), h0f2, Zacc); Zacc = MF(LDP(KQ, 144, 0, 48), h0f3, Zacc);
                    Yacc = MF(LDP(RQ, 144, 0, 0), h0f0, Yacc); Yacc = MF(LDP(RQ, 144, 0, 16), h0f1, Yacc); Yacc = MF(LDP(RQ, 144, 0, 32), h0f2, Yacc); Yacc = MF(LDP(RQ, 144, 0, 48), h0f3, Yacc);
#pragma unroll
                    for (int r_ = 0; r_ < 16; ++r_) { const int row_ = (r_ & 3) + 8 * (r_ >> 2) + 4 * hh; H0a[r_] *= GC[row_]; H0b[r_] *= GC[32 + row_]; }
                    H0a = MF(LDN(KCT, 80, 0, 0), LDN(VTI, 80, 0, 0), H0a); H0a = MF(LDN(KCT, 80, 0, 16), LDN(VTI, 80, 0, 16), H0a);
                    H0b = MF(LDN(KCT, 80, 32, 0), LDN(VTI, 80, 0, 0), H0b); H0b = MF(LDN(KCT, 80, 32, 16), LDN(VTI, 80, 0, 16), H0b);
                    SPIN_UNTIL(*progH >= (unsigned)(c + 1));
                    bf16x8 fr[8];
#pragma unroll
                    for (int f = 0; f < 8; ++f) fr[f] = *(const LAS bf16x8*)(FR + f * 1024 + lane * 16);
                    asm volatile("s_waitcnt lgkmcnt(0)" ::: "memory");
                    *progF = (unsigned)(c + 1);
                    Zacc = MF(fr[2], LDP(VTI, 80, 0, 0), Zacc); Zacc = MF(fr[3], LDP(VTI, 80, 0, 16), Zacc);
                    Yacc = MF(fr[4], LDP(VTI, 80, 0, 0), Yacc); Yacc = MF(fr[5], LDP(VTI, 80, 0, 16), Yacc);
                    U = MF(fr[0], ACCF(Zacc, 0), U); U = MF(fr[1], ACCF(Zacc, 1), U);
                    { const bf16x8 u0 = ACCF(U, 0), u1 = ACCF(U, 1);
                      Yacc = MF(fr[6], u0, Yacc); Yacc = MF(fr[7], u1, Yacc);
#pragma unroll
                      for (int r_ = 0; r_ < 16; ++r_) { const int tt = 32 * c + (r_ & 3) + 8 * (r_ >> 2) + 4 * hh; const size_t m = (size_t)b * SEQ + (d ? (SEQ - 1 - tt) : tt);
                          pY[m * 2048] = (bf16)(cvtpk_c(Yacc[r_], 0.f) & 0xffffu); }
                      H0a = MF(LDP(BCT, 80, 0, 0), u0, H0a); H0a = MF(LDP(BCT, 80, 0, 16), u1, H0a);
                      H0b = MF(LDP(BCT, 80, 32, 0), u0, H0b); H0b = MF(LDP(BCT, 80, 32, 16), u1, H0b); }
                    asm volatile("s_waitcnt lgkmcnt(0)" ::: "memory");
                    *progM = (unsigned)(c + 1);
                }
            }
#undef PF_ISSUE
#undef PF_TOK
        } else if (wave < 6 && run_scan) {
            const int sl = wave - 4;
            const LAS unsigned char* sbase = lds + sl * 57856;
            LAS unsigned char* FR = lds + 136192 + sl * 8192;
            volatile LAS unsigned* pE0 = PROGW(2 * sl), *pE1 = PROGW(2 * sl + 1), *pF0 = PROGW(8 + 2 * sl), *pF1 = PROGW(8 + 2 * sl + 1); volatile LAS unsigned* progH = PROGW(12 + sl);
            for (int c = 0; c < NCH; ++c) {
                const LAS unsigned char* KQ = sbase + (c & 1) * 28928, *RQ = KQ + 4608, *KKI = KQ + 9216, *BKI = KQ + 13824;
                SPIN_UNTIL(*pE0 >= (unsigned)(c + 1) && *pE1 >= (unsigned)(c + 1));
                f32x16 Rm, P, Pt, Rt, Aa, Ar, Ab;
                ZERO16(P); ZERO16(Pt); ZERO16(Aa); ZERO16(Ar); ZERO16(Ab);
#pragma unroll
                for (int ks = 0; ks < 4; ++ks) { const bf16x8 fb = LDN(BKI, 144, 0, 16 * ks), fq = LDN(KQ, 144, 0, 16 * ks), fk = LDN(KKI, 144, 0, 16 * ks), frq = LDN(RQ, 144, 0, 16 * ks);
                    P = MF(fb, fq, P); Pt = MF(fq, fb, Pt); Aa = MF(fk, fq, Aa); Ar = MF(fk, frq, Ar); Ab = MF(fb, frq, Ab); }
#pragma unroll
                for (int r_ = 0; r_ < 16; ++r_) { const int row_ = (r_ & 3) + 8 * (r_ >> 2) + 4 * hh; P[r_] = row_ < q ? -P[r_] : 0.f; Pt[r_] = row_ > q ? -Pt[r_] : 0.f; Rm[r_] = P[r_] + (row_ == q ? 1.0f : 0.f); Rt[r_] = Pt[r_] + (row_ == q ? 1.0f : 0.f);
                    Aa[r_] = row_ < q ? Aa[r_] : 0.f; Ar[r_] = row_ <= q ? Ar[r_] : 0.f; Ab[r_] = row_ <= q ? -Ab[r_] : 0.f; }
                const bf16x8 fa0 = ACCF(Aa, 0), fa1 = ACCF(Aa, 1), fr0 = ACCF(Ar, 0), fr1 = ACCF(Ar, 1), fb0 = ACCF(Ab, 0), fb1 = ACCF(Ab, 1);
#pragma unroll
                for (int k = 0; k < 4; ++k) {
                    f32x16 P2; ZERO16(P2); MMAA(Pt, P, P2);
                    MMAA(Rt, P2, Rm);
                    if (k < 3) { f32x16 P2t; ZERO16(P2t); MMAA(P, Pt, P2t); MMAA(P2, Rt, Rt); Pt = P2t; }
                    P = P2;
                }
                const bf16x8 ft0 = ACCF(Rm, 0), ft1 = ACCF(Rm, 1);
                asm volatile("s_waitcnt lgkmcnt(0)" ::: "memory");
                if (c >= 1) SPIN_UNTIL(*pF0 >= (unsigned)c && *pF1 >= (unsigned)c);
                *(LAS bf16x8*)(FR + 0 * 1024 + lane * 16) = ft0; *(LAS bf16x8*)(FR + 1 * 1024 + lane * 16) = ft1; *(LAS bf16x8*)(FR + 2 * 1024 + lane * 16) = fa0; *(LAS bf16x8*)(FR + 3 * 1024 + lane * 16) = fa1;
                *(LAS bf16x8*)(FR + 4 * 1024 + lane * 16) = fr0; *(LAS bf16x8*)(FR + 5 * 1024 + lane * 16) = fr1; *(LAS bf16x8*)(FR + 6 * 1024 + lane * 16) = fb0; *(LAS bf16x8*)(FR + 7 * 1024 + lane * 16) = fb1;
                asm volatile("s_waitcnt lgkmcnt(0)" ::: "memory");
                *progH = (unsigned)(c + 1);
            }
        }
        if (!(args.pad & 2)) {
            const int b = vcu >> 3, kvh = (vcu >> 2) & 1, qseg = vcu & 3;
            const bf16* kb0 = KB + ((size_t)(b * 2 + kvh) * 64) * 4 * 64 * 8 + lane * 8;
            const bf16* vb0 = VB + ((size_t)(b * 2 + kvh) * 64) * 4 * 64 * 8 + lane * 8;
            LAS unsigned* qctr = (LAS unsigned*)(lds + LDSCTL_OFF + 1024 + 14 * 64);
#define ATT_LOAD(kt_, KF, VF) do { _Pragma("unroll") for (int ks = 0; ks < 4; ++ks) KF[ks] = *(const bf16x8*)(kb0 + (size_t)((kt_) * 4 + ks) * 512); \
                _Pragma("unroll") for (int mb = 0; mb < 2; ++mb) _Pragma("unroll") for (int k2 = 0; k2 < 2; ++k2) VF[mb][k2] = *(const bf16x8*)(vb0 + (size_t)((kt_) * 4 + mb * 2 + k2) * 512); } while (0)
            for (;;) {
                unsigned e_ = 0; if (lane == 0) e_ = __hip_atomic_fetch_add(qctr, 1u, __ATOMIC_RELAXED, __HIP_MEMORY_SCOPE_WORKGROUP);
                const int e = __builtin_amdgcn_readfirstlane((int)e_);
                if (e >= 64) break;
                const int g = e & 3, qb = qseg * 16 + (e >> 2), hq = kvh * 4 + g;
                const int t = 32 * qb + q;
                const float slope = exp2f(-(float)(hq + 1));
                bf16* qrow = PA + ((size_t)b * SEQ + t) * ACOLS + hq * 64;
                bf16x8 qf[4];
#pragma unroll
                for (int ks = 0; ks < 4; ++ks) qf[ks] = *(const bf16x8*)(qrow + 16 * ks + 8 * hh);
                float mrun = sink[hq], lrun = 1.0f;
                f32x16 O0, O1; ZERO16(O0); ZERO16(O1);
                const int kt0 = qb - 4 < 0 ? 0 : qb - 4, kt1 = qb + 4 > 63 ? 63 : qb + 4;
                float nb[16];
#pragma unroll
                for (int r = 0; r < 16; ++r) nb[r] = slope * (float)(q - 4 * hh - ((r & 3) + 8 * (r >> 2)));
                bf16x8 kfA[4], vfA[2][2], kfB[4], vfB[2][2];
#define ATT_TILE(kt_, KF, VF) do { \
                    f32x16 acc; ZERO16(acc); \
                    _Pragma("unroll") for (int ks = 0; ks < 4; ++ks) acc = MF(KF[ks], qf[ks], acc); \
                      \
                    const int dlt = qb - (kt_); float sc[16]; float mx = -1e30f; \
                    if (dlt > 0) { _Pragma("unroll") for (int r = 0; r < 16; ++r) sc[r] = acc[r] * 0.125f - nb[r]; \
                        if (dlt == 4) { _Pragma("unroll") for (int r = 0; r < 16; ++r) sc[r] = nb[r] <= 0.f ? sc[r] : -1e30f; } } \
                    else if (dlt < 0) { _Pragma("unroll") for (int r = 0; r < 16; ++r) sc[r] = acc[r] * 0.125f + nb[r]; \
                        if (dlt == -4) { _Pragma("unroll") for (int r = 0; r < 16; ++r) sc[r] = nb[r] >= 0.f ? sc[r] : -1e30f; } } \
                    else { _Pragma("unroll") for (int r = 0; r < 16; ++r) sc[r] = acc[r] * 0.125f - fabsf(nb[r]); } \
                    const float coff = slope * 32.0f * (float)(dlt < 0 ? -dlt : dlt); \
                    _Pragma("unroll") for (int r = 0; r < 16; ++r) mx = fmaxf(mx, sc[r]); \
                    { const auto rr_ = __builtin_amdgcn_permlane32_swap(__float_as_uint(mx), __float_as_uint(mx), false, false); mx = fmaxf(__uint_as_float(rr_[0]), __uint_as_float(rr_[1])) - coff; }     \
                    const float mn = fmaxf(mrun, mx), alpha = __expf(mrun - mn); mrun = mn; \
                    const float sh = mn + coff; float rs = 0.f; \
                    _Pragma("unroll") for (int r = 0; r < 16; ++r) { sc[r] = __expf(sc[r] - sh); rs += sc[r]; } \
                    lrun = lrun * alpha + rs;                                  \
                    bf16x8 pb[2]; \
                    _Pragma("unroll") for (int k2 = 0; k2 < 2; ++k2) pb[k2] = __builtin_bit_cast(bf16x8, (v4u){cvtpk_c(sc[8 * k2 + 0], sc[8 * k2 + 1]), cvtpk_c(sc[8 * k2 + 2], sc[8 * k2 + 3]), cvtpk_c(sc[8 * k2 + 4], sc[8 * k2 + 5]), cvtpk_c(sc[8 * k2 + 6], sc[8 * k2 + 7])}); \
                    if (__ballot(alpha != 1.0f) != 0ull) { _Pragma("unroll") for (int r = 0; r < 16; ++r) { O0[r] *= alpha; O1[r] *= alpha; } } \
                    _Pragma("unroll") for (int k2 = 0; k2 < 2; ++k2) { O0 = MF(VF[0][k2], pb[k2], O0); O1 = MF(VF[1][k2], pb[k2], O1); } } while (0)
                ATT_LOAD(kt0, kfA, vfA);
                for (int kt = kt0; kt <= kt1; kt += 2) {
                    if (kt + 1 <= kt1) ATT_LOAD(kt + 1, kfB, vfB);
                    ATT_TILE(kt, kfA, vfA);
                    if (kt + 1 <= kt1) {
                        if (kt + 2 <= kt1) ATT_LOAD(kt + 2, kfA, vfA);
                        ATT_TILE(kt + 1, kfB, vfB);
                    }
                }
#undef ATT_TILE
                { const auto rr_ = __builtin_amdgcn_permlane32_swap(__float_as_uint(lrun), __float_as_uint(lrun), false, false); lrun = __uint_as_float(rr_[0]) + __uint_as_float(rr_[1]) - __expf(sink[hq] - mrun); }
                const float inv = __builtin_amdgcn_rcpf(lrun);
                const bf16* grow = PA + ((size_t)b * SEQ + t) * ACOLS + 768 + hq * 64;
#pragma unroll
                for (int mb = 0; mb < 2; ++mb)
#pragma unroll
                    for (int r4 = 0; r4 < 4; ++r4) { const int dd = mb * 32 + 8 * r4 + 4 * hh;
                        const uint2 gq = *(const uint2*)(grow + dd);
                        const float g0 = bflo(gq.x), g1 = bfhi(gq.x), g2 = bflo(gq.y), g3 = bfhi(gq.y);
                        const float o0 = (mb ? O1[4 * r4 + 0] : O0[4 * r4 + 0]) * inv, o1 = (mb ? O1[4 * r4 + 1] : O0[4 * r4 + 1]) * inv, o2 = (mb ? O1[4 * r4 + 2] : O0[4 * r4 + 2]) * inv, o3 = (mb ? O1[4 * r4 + 3] : O0[4 * r4 + 3]) * inv;
                        *(uint2*)(qrow + dd) = make_uint2(cvtpk_c(o0 * g0 * pg8::sigm(g0), o1 * g1 * pg8::sigm(g1)), cvtpk_c(o2 * g2 * pg8::sigm(g2), o3 * g3 * pg8::sigm(g3))); }
            }
#undef ATT_LOAD
        }
#undef MF
#undef ACCF
#undef LDN
#undef LDP
#undef ZERO16
#undef MMAA
#undef PROGW
#undef SPIN_UNTIL
        if (BOTH(6)) GRID_BAR();
    }
    if (IN(7)) { PTRS
        {
            const int c0 = 8 * lane;
            v4u q8[4], q8n[4]; float bsn = 0.f;
#define P7_LOAD(mm, Q, B) do { const bf16* rr_ = RAW + (size_t)(mm) * 2048 + c0; Q[0] = *(const v4u*)(rr_); Q[1] = *(const v4u*)(rr_ + 512); \
                Q[2] = *(const v4u*)(Vb + (size_t)(mm) * RW + c0); Q[3] = *(const v4u*)(Gb + (size_t)(mm) * RW + c0); { const size_t bi_ = (size_t)(mm) * 8 + (lane >> 3); B = (BP4[bi_] + BP4[(size_t)M * 8 + bi_]) + (BP4[(size_t)2 * M * 8 + bi_] + BP4[(size_t)3 * M * 8 + bi_]); } } while (0)
            const f32x4 gwa = *(const f32x4*)(gnw + c0), gwb = *(const f32x4*)(gnw + c0 + 4), gba = *(const f32x4*)(gnb + c0), gbb = *(const f32x4*)(gnb + c0 + 4);
            const float gw8[8] = {gwa.x, gwa.y, gwa.z, gwa.w, gwb.x, gwb.y, gwb.z, gwb.w}, gb8[8] = {gba.x, gba.y, gba.z, gba.w, gbb.x, gbb.y, gbb.z, gbb.w};
            if (gw < M) P7_LOAD(gw, q8n, bsn);
            for (int m = gw; m < M; m += NGW) {
#pragma unroll
                for (int i = 0; i < 4; ++i) q8[i] = q8n[i];
                const float bs = bsn;
                if (m + NGW < M) P7_LOAD(m + NGW, q8n, bsn);
                float y0[8], y1[8], vf[8], gf[8], y[8];
                unpack8(q8[0], y0); unpack8(q8[1], y1); unpack8(q8[2], vf); unpack8(q8[3], gf);
                float s = 0.f;
#pragma unroll
                for (int e = 0; e < 8; ++e) { y[e] = y0[e] + y1[e]; s += y[e]; }
                s += __shfl_xor(s, 1); s += __shfl_xor(s, 2); s += __shfl_xor(s, 4);
                const float mean = s * (1.f / 64.f); float qq = 0.f;
#pragma unroll
                for (int e = 0; e < 8; ++e) { const float dd = y[e] - mean; qq += dd * dd; }
                qq += __shfl_xor(qq, 1); qq += __shfl_xor(qq, 2); qq += __shfl_xor(qq, 4);
                const float rstd = 1.0f / sqrtf(qq * (1.f / 64.f) + 64e-5f);
                float r[8];
#pragma unroll
                for (int e = 0; e < 8; ++e) { const float yn = (y[e] - mean) * rstd * gw8[e] + gb8[e]; r[e] = (yn + bs * vf[e]) * gf[e] * sigmoidf_(gf[e]); }
                *(v4u*)(Vb + (size_t)m * RW + c0) = pack8(r);
            }
#undef P7_LOAD
        }
        if (BOTH(7)) GRID_BAR();
    }
    if (IN(8)) { PTRS
        { pg8::Gemm g{Hb, WinT + (size_t)3584 * 1024, M, 2048, 1024, 1024}; pg8::StaticOrder S; S.init(M, 2048, G, bx);
          pg8::EpiFrag E{PGT, 8};
          pg8::gemm_phase<pg8::EpiFrag, pg8::StaticOrder, true, true>(lds, g, S, E); }
        if (BOTH(8)) GRID_BAR();
    }
    if (IN(9)) { PTRS
        { pg8::Gemm g{Vb, WbrrT, M, 1024, 512, 512}; pg8::StaticOrder S; S.init(M, 1024, G, bx);
          pg8::EpiGate<0> E{MG, PGT, Hb};
          pg8::gemm_phase<pg8::EpiGate<0>, pg8::StaticOrder, true, true>(lds, g, S, E); }
        { pg8::Gemm g{PA, WbraT, M, 1024, 512, ACOLS}; pg8::StaticOrder S; S.init(M, 1024, G, bx);
          pg8::EpiGate<1> E{MG, PGT, Hb};
          pg8::gemm_phase<pg8::EpiGate<1>, pg8::StaticOrder, true, true>(lds, g, S, E); }
        if (BOTH(9)) GRID_BAR();
    }
    if (IN(10)) { PTRS
        pg8::Gemm g{MG, WoutT, M, 1024, 1024, 1024}; pg8::StaticOrder S; S.init(M, 1024, G, bx);
        pg8::EpiRoute E{OUTB, OUTB, 1024, 1024, 1 << 20};
        pg8::gemm_phase<pg8::EpiRoute, pg8::StaticOrder, true, true>(lds, g, S, E);
        if (BOTH(10)) GRID_BAR();
    }
    if (IN(11)) { PTRS
        {
            v4u oq[2], oqn[2]; f32x4 xq[4], xqn[4];
#define P11_LOAD(mm, O, X) do { _Pragma("unroll") for (int j = 0; j < 2; ++j) { O[j] = *(const v4u*)(OUTB + (size_t)(mm) * 1024 + 8 * (lane + 64 * j)); \
                X[2 * j] = *(const f32x4*)(x + (size_t)(mm) * DM + 8 * (lane + 64 * j)); X[2 * j + 1] = *(const f32x4*)(x + (size_t)(mm) * DM + 8 * (lane + 64 * j) + 4); } } while (0)
            if (gw < M) P11_LOAD(gw, oqn, xqn);
            for (int m = gw; m < M; m += NGW) {
                const int b = m >> 11;
#pragma unroll
                for (int j = 0; j < 2; ++j) { oq[j] = oqn[j]; xq[2 * j] = xqn[2 * j]; xq[2 * j + 1] = xqn[2 * j + 1]; }
                if (m + NGW < M) P11_LOAD(m + NGW, oqn, xqn);
                float o[2][8]; float s = 0.f;
#pragma unroll
                for (int j = 0; j < 2; ++j) { unpack8(oq[j], o[j]);
#pragma unroll
                    for (int e = 0; e < 8; ++e) s += o[j][e] * o[j][e]; }
                const float rinv = 1.0f / sqrtf(wave_sum(s) * (1.f / DM) + 1e-6f);
#pragma unroll
                for (int j = 0; j < 2; ++j) { const int c = 8 * (lane + 64 * j);
#pragma unroll
                    for (int hlf = 0; hlf < 2; ++hlf) { const int cc = c + 4 * hlf;
                        const f32x4 gp = *(const f32x4*)(gpost + cc), gt = *(const f32x4*)(ADA + b * 3072 + 2048 + cc);
                        f32x4 ov; ov.x = o[j][4 * hlf + 0]; ov.y = o[j][4 * hlf + 1]; ov.z = o[j][4 * hlf + 2]; ov.w = o[j][4 * hlf + 3];
                        *(f32x4*)(out + (size_t)m * DM + cc) = xq[2 * j + hlf] + gt * (ov * rinv * gp); } }
            }
#undef P11_LOAD
        }
    }
#undef IN
#undef BOTH
#undef GRID_BAR
}

extern "C" void kernel_launch(void* const* d_in, const int* in_sizes, int n_in, void* d_out, int out_size, void* d_ws, size_t ws_size, hipStream_t stream) {
    static int grid = 0;
    if (grid == 0) {
        if (n_in != NIN || in_sizes[0] != M * DM || out_size != M * DM || ws_size < WS_END) { fprintf(stderr, "kernel_launch: unexpected shapes: n_in %d in0 %d out %d ws %zu (need %zu)\n", n_in, n_in > 0 ? in_sizes[0] : -1, out_size, ws_size, (size_t)WS_END); grid = -1; return; }
        int dev = 0, cus = 0;
        if (hipGetDevice(&dev) != hipSuccess || hipDeviceGetAttribute(&cus, hipDeviceAttributeMultiprocessorCount, dev) != hipSuccess) { fprintf(stderr, "kernel_launch: device query failed\n"); grid = -1; return; }
        if (hipFuncSetAttribute((const void*)mk_fwd, hipFuncAttributeMaxDynamicSharedMemorySize, LDS_BYTES) != hipSuccess) { fprintf(stderr, "kernel_launch: hipFuncSetAttribute failed\n"); grid = -1; return; }
        (void)hipGetLastError();
        grid = cus;
        if (grid != 256) fprintf(stderr, "kernel_launch: %d CUs (built for 256)\n", grid);
    }
    if (grid < 0) return;
    if (hipMemsetAsync((char*)d_ws + WS_CTL, 0, CTL_ZERO_BYTES, stream) != hipSuccess) { fprintf(stderr, "kernel_launch: memset failed\n"); return; }
    Args a{};
    for (int i = 0; i < NIN; ++i) a.in[i] = (const float*)d_in[i];
    a.out = (float*)d_out; a.ws = (unsigned char*)d_ws;
    static const int plan[][2] = MK_PLAN;
    const int nl = (int)(sizeof(plan) / sizeof(plan[0]));
    for (int li = 0; li < nl; ++li) {
        a.ph_lo = plan[li][0]; a.ph_hi = plan[li][1]; a.li = li; a.pad = (li < nl - 1) ? MK_PROBE_FLAGS : 0;
        hipLaunchKernelGGL(mk_fwd, dim3(grid), dim3(NWAVES * 64), LDS_BYTES, stream, a);
        const hipError_t le = hipPeekAtLastError();
        if (le != hipSuccess) { fprintf(stderr, "kernel_launch: launch %d failed: %s\n", li, hipGetErrorName(le)); break; }
    }
}
```

```cpp
#include <hip/hip_runtime.h>
#include <cstdio>
#include <cstdint>
namespace pg8 {
#define PG8_LAS __attribute__((address_space(3)))
typedef unsigned short bf16_t;
typedef short bf16x8 __attribute__((ext_vector_type(8)));
typedef float f32x4 __attribute__((ext_vector_type(4)));
typedef unsigned u32x4 __attribute__((ext_vector_type(4)));
constexpr int BM = 256, BK = 64, HALF = 128, HTB = HALF * BK * 2  , STAGE_BYTES = 8 * HTB, NXCD = 8, WGM = 8;

__host__ __device__ __forceinline__ int lds_byte(int r, int c) { const int st = (r >> 4) * 2 + (c >> 5), rr = r & 15, cc = c & 31, ob = rr * 64 + cc * 2; return st * 1024 + (ob ^ (((ob >> 9) & 1) << 5)); }
__host__ __device__ __forceinline__ void stage_rc(int b, int& R, int& C) { const int st = b / 1024, sb = b % 1024, swz = sb ^ (((sb >> 9) & 1) << 5); R = (st >> 1) * 16 + swz / 64; C = (st & 1) * 32 + (swz % 64) / 2; }
__host__ __device__ __forceinline__ int perm32(int rho) { const int n = rho >> 4, i = rho & 15; return 8 * (i >> 2) + 4 * n + (i & 3); }

struct Unit { int pm, pn; };
struct Gemm { const bf16_t* A; const bf16_t* Bt; int M, N, K, lda; int asplit_pn, asplit_off; };

struct StaticOrder {
    int nM, nN, nwg, G, c;
    __host__ __device__ void init(int M, int N, int G_, int c_) { nM = M / BM; nN = N / BM; nwg = nM * nN; G = G_; c = c_; }
    __host__ __device__ bool next(int i, Unit& u) const {
        const long L = (long)i * G + c; if (L >= nwg) return false;
        int wgid = (int)L; { const int q = nwg / NXCD, r = nwg % NXCD, xcd = wgid % NXCD, off = wgid / NXCD; wgid = (xcd < r ? xcd * (q + 1) : r * (q + 1) + (xcd - r) * q) + off; }
        const int nig = WGM * nN, gid = wgid / nig, fm = gid * WGM, gsz = (nM - fm) < WGM ? (nM - fm) : WGM;
        u.pm = fm + ((wgid % nig) % gsz); u.pn = (wgid % nig) / gsz; return true;
    }
    __device__ __forceinline__ void a_ready(const Unit&) const {}
    __device__ __forceinline__ void done(const Unit&) const {}
};

__device__ __forceinline__ unsigned cvt_pk_bf16(float lo, float hi) { unsigned r; asm volatile("v_cvt_pk_bf16_f32 %0, %1, %2" : "=v"(r) : "v"(lo), "v"(hi)); return r; }
typedef float f32x2 __attribute__((ext_vector_type(2)));
__device__ __forceinline__ f32x2 gelu_pk(f32x2 v) {
    const f32x2 av = __builtin_elementwise_abs(v), d = av * 0.2316418882f + 1.0f;
    f32x2 t; t.x = __builtin_amdgcn_rcpf(d.x); t.y = __builtin_amdgcn_rcpf(d.y);
    f32x2 q = t * 0.5307027145f + (-0.7265760135f); q = q * t + 0.7107068705f; q = q * t + (-0.142248368f); q = q * t + 0.127414796f; q = q * t;
    const f32x2 s = (v * v) * (-0.72134752044f);
    f32x2 e; e.x = __builtin_amdgcn_exp2f(s.x); e.y = __builtin_amdgcn_exp2f(s.y);
    const f32x2 m = v * (q * e), r = v - m;
    f32x2 o; o.x = v.x < 0.f ? m.x : r.x; o.y = v.y < 0.f ? m.y : r.y; return o;
}

template <int ACT  > struct EpiBf16 {
    static constexpr bool PERM = true, AFTER_DRAIN = false; static_assert(ACT == 0 || ACT == 1, "EpiBf16: ACT is 0 (none) or 1 (gelu_pk)");
    bf16_t* O; int ldc; const float* bias; int split_cols; size_t split_stride; float scale0;
    __device__ __forceinline__ void operator()(const f32x4 (&acc)[2][2][4][2], const Unit& u, int wr, int wc, int fr, int fq) const {
        const int row0 = u.pm * BM + wr * 64 + fr; int colt = u.pn * BM; bf16_t* base = O;
        float sc = 1.f; if (split_cols) { const int t = colt / split_cols; base += (size_t)t * split_stride; colt -= t * split_cols; if (t == 0) sc = scale0; }
        const int col0 = colt + wc * 32 + 8 * fq, bcol0 = u.pn * BM + wc * 32 + 8 * fq;
        f32x4 bv[2][2];
#pragma unroll
        for (int bj = 0; bj < 2; ++bj)
#pragma unroll
            for (int n = 0; n < 2; ++n) bv[bj][n] = bias ? *(const f32x4*)(bias + bcol0 + bj * HALF + 4 * n) : (f32x4){0.f, 0.f, 0.f, 0.f};
#pragma unroll
        for (int ai = 0; ai < 2; ++ai)
#pragma unroll
            for (int m = 0; m < 4; ++m) { bf16_t* rowp = base + (size_t)(row0 + ai * HALF + m * 16) * ldc + col0;
#pragma unroll
                for (int bj = 0; bj < 2; ++bj) { f32x4 v0 = acc[ai][bj][m][0] + bv[bj][0], v1 = acc[ai][bj][m][1] + bv[bj][1];
                    if (ACT == 1) { f32x2 a = gelu_pk((f32x2){v0[0], v0[1]}), b = gelu_pk((f32x2){v0[2], v0[3]}), c = gelu_pk((f32x2){v1[0], v1[1]}), d = gelu_pk((f32x2){v1[2], v1[3]});
                        v0 = (f32x4){a.x, a.y, b.x, b.y}; v1 = (f32x4){c.x, c.y, d.x, d.y}; }
                    v0 = v0 * sc; v1 = v1 * sc; u32x4 w; w.x = cvt_pk_bf16(v0[0], v0[1]); w.y = cvt_pk_bf16(v0[2], v0[3]); w.z = cvt_pk_bf16(v1[0], v1[1]); w.w = cvt_pk_bf16(v1[2], v1[3]);
                    *(u32x4*)(rowp + bj * HALF) = w; } }
    }
};
template <class Epi, class Sched, bool ALIGN_EPI = false, bool SP2 = false>
__device__ __forceinline__ void gemm_phase(PG8_LAS unsigned char* lds, const Gemm g, const Sched& S, const Epi& E) {
    const int tid = threadIdx.x, wid = __builtin_amdgcn_readfirstlane(tid >> 6), lane = tid & 63, wr = wid >> 2, wc = wid & 3, fr = lane & 15, fq = lane >> 4;
    const int K = g.K, nt = K / BK;
    unsigned voffA[2], voffB[2];
#pragma unroll
    for (int i = 0; i < 2; ++i) { int R, C; stage_rc(tid * 16 + i * 8192, R, C); const int Rb = Epi::PERM ? ((R & ~31) + perm32(R & 31)) : R;
        voffA[i] = (unsigned)(R * g.lda + C) * 2u; voffB[i] = (unsigned)(Rb * K + C) * 2u; }
    const size_t kstep = (size_t)(BK * 2);
    const size_t hstepB = (size_t)HALF * K * 2, hstepA = (size_t)HALF * g.lda * 2;
    const size_t tstepB = 2 * hstepB, tstepA = 2 * hstepA;
    const unsigned ldsw = (unsigned)wid * 1024u;
    const int aoff = lds_byte(wr * 64 + fr, fq * 8), boff = lds_byte(wc * 32 + fr, fq * 8);
#define PG8_SA(b, h) (((b) * 2 + (h)) * HTB)
#define PG8_SB(b, h) ((4 + (b) * 2 + (h)) * HTB)
#define PG8_STAGE(bufoff, gbase, voff) do { _Pragma("unroll") for (int _i = 0; _i < 2; ++_i) \
        __builtin_amdgcn_global_load_lds((const unsigned*)((const char*)(gbase) + (voff)[_i]), (PG8_LAS unsigned*)(lds + (bufoff) + ldsw + _i * 8192), 16, 0, 0); } while (0)
#define PG8_LDA(dst, b, h) do { _Pragma("unroll") for (int m = 0; m < 4; ++m) _Pragma("unroll") for (int k = 0; k < 2; ++k) dst[m][k] = *(const PG8_LAS bf16x8*)(lds + PG8_SA(b, h) + aoff + m * 2048 + k * 1024); } while (0)
#define PG8_LDB(dst, b, h) do { _Pragma("unroll") for (int n = 0; n < 2; ++n) _Pragma("unroll") for (int k = 0; k < 2; ++k) dst[n][k] = *(const PG8_LAS bf16x8*)(lds + PG8_SB(b, h) + boff + n * 2048 + k * 1024); } while (0)
#define PG8_MMA(ai, bj, At, Bt) do { __builtin_amdgcn_s_setprio(1); _Pragma("unroll") for (int m = 0; m < 4; ++m) _Pragma("unroll") for (int n = 0; n < 2; ++n) _Pragma("unroll") for (int k = 0; k < 2; ++k) \
        acc[ai][bj][m][n] = __builtin_amdgcn_mfma_f32_16x16x32_bf16(Bt[n][k], At[m][k], acc[ai][bj][m][n], 0, 0, 0); __builtin_amdgcn_s_setprio(0); } while (0)
#define PG8_WAIT_V(n) asm volatile("s_waitcnt vmcnt(" #n ")" ::: "memory")
#define PG8_WAIT_L(n) asm volatile("s_waitcnt lgkmcnt(" #n ")" ::: "memory")
#define PG8_BAR __builtin_amdgcn_s_barrier()
#define PG8_SCHED __builtin_amdgcn_sched_barrier(0)
    Unit cur, nxt; int ui = 0;
    if (!S.next(0, cur)) return;
    f32x4 acc[2][2][4][2];
#pragma unroll
    for (int a = 0; a < 2; ++a)
#pragma unroll
        for (int b = 0; b < 2; ++b)
#pragma unroll
            for (int m = 0; m < 4; ++m)
#pragma unroll
                for (int n = 0; n < 2; ++n) acc[a][b][m][n] = (f32x4){0.f, 0.f, 0.f, 0.f};
    bf16x8 At[4][2], B0[2][2], B1[2][2];
    const char* cA = (const char*)g.A + (size_t)cur.pm * tstepA + (cur.pn >= g.asplit_pn ? g.asplit_off : 0); const char* cB = (const char*)g.Bt + (size_t)cur.pn * tstepB;
    S.a_ready(cur);
    if constexpr (SP2) {
        PG8_STAGE(PG8_SB(0, 0), cB, voffB); PG8_STAGE(PG8_SB(0, 1), cB + hstepB, voffB); PG8_STAGE(PG8_SA(0, 0), cA, voffA); PG8_STAGE(PG8_SA(0, 1), cA + hstepA, voffA);
        if (wr == 1) PG8_BAR;
        PG8_WAIT_V(2); PG8_BAR;
        PG8_STAGE(PG8_SB(1, 0), cB + kstep, voffB); PG8_STAGE(PG8_SA(1, 0), cA + kstep, voffA); PG8_STAGE(PG8_SB(1, 1), cB + hstepB + kstep, voffB);
        PG8_WAIT_V(6); PG8_BAR;
    } else {
        PG8_STAGE(PG8_SB(0, 0), cB, voffB); PG8_STAGE(PG8_SA(0, 0), cA, voffA); PG8_STAGE(PG8_SB(0, 1), cB + hstepB, voffB); PG8_STAGE(PG8_SA(0, 1), cA + hstepA, voffA);
        if (wr == 1) PG8_BAR;
        PG8_WAIT_V(4); PG8_BAR;
        PG8_STAGE(PG8_SB(1, 0), cB + kstep, voffB); PG8_STAGE(PG8_SA(1, 0), cA + kstep, voffA); PG8_STAGE(PG8_SB(1, 1), cB + hstepB + kstep, voffB);
        PG8_WAIT_V(6); PG8_BAR;
    }
    for (;;) {
        const bool has_next = S.next(ui + 1, nxt);
        const char* nA = has_next ? (const char*)g.A + (size_t)nxt.pm * tstepA + (nxt.pn >= g.asplit_pn ? g.asplit_off : 0) : cA; const char* nB = has_next ? (const char*)g.Bt + (size_t)nxt.pn * tstepB : cB;
        for (int t = 0; t < nt; t += 2) {
            const bool last = (t == nt - 2);
            const char* a1 = cA + (size_t)(t + 1) * kstep;
            const char* a2 = last ? nA : cA + (size_t)(t + 2) * kstep; const char* b2 = last ? nB : cB + (size_t)(t + 2) * kstep;
            const char* a3 = a2 + kstep; const char* b3 = b2 + kstep;
            if (last && has_next) S.a_ready(nxt);
            if constexpr (SP2) {
            PG8_LDB(B0, 0, 0); PG8_LDB(B1, 0, 1); PG8_SCHED; PG8_LDA(At, 0, 0); PG8_STAGE(PG8_SA(1, 1), a1 + hstepA, voffA);
            PG8_WAIT_V(8); PG8_WAIT_L(0); PG8_BAR; PG8_MMA(0, 0, At, B0); PG8_MMA(0, 1, At, B1); PG8_BAR; PG8_SCHED;
            PG8_LDA(At, 0, 1); PG8_STAGE(PG8_SB(0, 0), b2, voffB); PG8_STAGE(PG8_SB(0, 1), b2 + hstepB, voffB); PG8_STAGE(PG8_SA(0, 0), a2, voffA);
            PG8_WAIT_V(8); PG8_WAIT_L(0); PG8_BAR; PG8_MMA(1, 0, At, B0); PG8_MMA(1, 1, At, B1); PG8_BAR; PG8_SCHED;
            PG8_LDB(B0, 1, 0); PG8_LDB(B1, 1, 1); PG8_SCHED; PG8_LDA(At, 1, 0); PG8_STAGE(PG8_SA(0, 1), a2 + hstepA, voffA);
            PG8_WAIT_V(8); PG8_WAIT_L(0); PG8_BAR; PG8_MMA(0, 0, At, B0); PG8_MMA(0, 1, At, B1); PG8_BAR; PG8_SCHED;
            PG8_LDA(At, 1, 1); PG8_STAGE(PG8_SB(1, 0), b3, voffB); PG8_STAGE(PG8_SB(1, 1), b3 + hstepB, voffB); PG8_STAGE(PG8_SA(1, 0), a3, voffA);
            PG8_WAIT_V(8); PG8_WAIT_L(0); PG8_BAR; PG8_MMA(1, 0, At, B0); PG8_MMA(1, 1, At, B1); PG8_BAR; PG8_SCHED;
            } else {
            PG8_LDB(B0, 0, 0); PG8_SCHED; PG8_LDA(At, 0, 0); PG8_STAGE(PG8_SA(1, 1), a1 + hstepA, voffA);
            PG8_WAIT_L(8); PG8_BAR; PG8_WAIT_L(0); PG8_MMA(0, 0, At, B0); PG8_BAR; PG8_SCHED;
            PG8_LDB(B1, 0, 1); PG8_STAGE(PG8_SB(0, 0), b2, voffB);
            PG8_BAR; PG8_WAIT_L(0); PG8_MMA(0, 1, At, B1); PG8_BAR;
            PG8_LDA(At, 0, 1); PG8_STAGE(PG8_SA(0, 0), a2, voffA);
            PG8_BAR; PG8_WAIT_L(0); PG8_MMA(1, 0, At, B0); PG8_BAR; PG8_SCHED;
            PG8_STAGE(PG8_SB(0, 1), b2 + hstepB, voffB);
            PG8_WAIT_V(6); PG8_BAR; PG8_MMA(1, 1, At, B1); PG8_BAR;
            PG8_LDB(B0, 1, 0); PG8_SCHED; PG8_LDA(At, 1, 0); PG8_STAGE(PG8_SA(0, 1), a2 + hstepA, voffA);
            PG8_WAIT_L(8); PG8_BAR; PG8_WAIT_L(0); PG8_MMA(0, 0, At, B0); PG8_BAR; PG8_SCHED;
            PG8_LDB(B1, 1, 1); PG8_STAGE(PG8_SB(1, 0), b3, voffB);
            PG8_BAR; PG8_WAIT_L(0); PG8_MMA(0, 1, At, B1); PG8_BAR;
            PG8_LDA(At, 1, 1); PG8_STAGE(PG8_SA(1, 0), a3, voffA);
            PG8_BAR; PG8_WAIT_L(0); PG8_MMA(1, 0, At, B0); PG8_BAR; PG8_SCHED;
            PG8_STAGE(PG8_SB(1, 1), b3 + hstepB, voffB);
            PG8_WAIT_V(6); PG8_BAR; PG8_MMA(1, 1, At, B1); PG8_BAR;
            }
        }
        if constexpr (ALIGN_EPI) { if (wr == 0) PG8_BAR; }
        if constexpr (!Epi::AFTER_DRAIN) { E(acc, cur, wr, wc, fr, fq); S.done(cur); }
        if (!has_next) break;
#pragma unroll
        for (int a = 0; a < 2; ++a)
#pragma unroll
            for (int b = 0; b < 2; ++b)
#pragma unroll
                for (int m = 0; m < 4; ++m)
#pragma unroll
                    for (int n = 0; n < 2; ++n) acc[a][b][m][n] = (f32x4){0.f, 0.f, 0.f, 0.f};
        cur = nxt; cA = nA; cB = nB; ++ui;
        if constexpr (ALIGN_EPI) { if (wr == 1) PG8_BAR; }
    }
    PG8_WAIT_V(0);
    if constexpr (!ALIGN_EPI) { if (wr == 0) PG8_BAR; }
    PG8_BAR;
    if constexpr (Epi::AFTER_DRAIN) { E.fused(acc, cur, wr, wc, fr, fq, lds, wid, lane); S.done(cur); }
#undef PG8_SA
#undef PG8_SB
#undef PG8_STAGE
#undef PG8_LDA
#undef PG8_LDB
#undef PG8_MMA
#undef PG8_WAIT_V
#undef PG8_WAIT_L
#undef PG8_BAR
#undef PG8_SCHED
}
}
namespace pg8 {
struct EpiRoute {
    static constexpr bool PERM = true, AFTER_DRAIN = false;
    bf16_t* base0; bf16_t* base1; int ldc0, ldc1, tile1;
    __device__ __forceinline__ void operator()(const f32x4 (&acc)[2][2][4][2], const Unit& u, int wr, int wc, int fr, int fq) const {
        const bool second = u.pn >= tile1;
        bf16_t* O = second ? base1 : base0; const int ld = second ? ldc1 : ldc0; const int colt = (second ? u.pn - tile1 : u.pn) * BM;
        const int row0 = u.pm * BM + wr * 64 + fr;
        const int col0 = colt + wc * 32 + 8 * fq;
#pragma unroll
        for (int ai = 0; ai < 2; ++ai)
#pragma unroll
            for (int m = 0; m < 4; ++m) { bf16_t* rowp = O + (size_t)(row0 + ai * HALF + m * 16) * ld + col0;
#pragma unroll
                for (int bj = 0; bj < 2; ++bj) { const f32x4 v0 = acc[ai][bj][m][0], v1 = acc[ai][bj][m][1];
                    u32x4 w; w.x = cvt_pk_bf16(v0[0], v0[1]); w.y = cvt_pk_bf16(v0[2], v0[3]); w.z = cvt_pk_bf16(v1[0], v1[1]); w.w = cvt_pk_bf16(v1[2], v1[3]);
                    *(u32x4*)(rowp + bj * HALF) = w; } }
    }
};
}
namespace pg8 {
struct EpiFrag {
    static constexpr bool PERM = true, AFTER_DRAIN = false;
    bf16_t* O; int NT;
    __device__ __forceinline__ void operator()(const f32x4 (&acc)[2][2][4][2], const Unit& u, int wr, int wc, int fr, int fq) const {
        bf16_t* base = O + (((size_t)u.pm * NT + u.pn) * 8 + (wr * 4 + wc)) * (16 * 512) + (fq * 16 + fr) * 8;
#pragma unroll
        for (int ai = 0; ai < 2; ++ai)
#pragma unroll
            for (int m = 0; m < 4; ++m)
#pragma unroll
                for (int bj = 0; bj < 2; ++bj) { const f32x4 v0 = acc[ai][bj][m][0], v1 = acc[ai][bj][m][1];
                    u32x4 w; w.x = cvt_pk_bf16(v0[0], v0[1]); w.y = cvt_pk_bf16(v0[2], v0[3]); w.z = cvt_pk_bf16(v1[0], v1[1]); w.w = cvt_pk_bf16(v1[2], v1[3]);
                    *(u32x4*)(base + ((ai * 4 + m) * 2 + bj) * 512) = w; }
    }
};
}
namespace pg8 {
__device__ __forceinline__ float sigm(float x) { return __builtin_amdgcn_rcpf(1.0f + __expf(-x)); }
struct EpiLora {
    static constexpr bool PERM = true, AFTER_DRAIN = false;
    bf16_t* O; const float* w0; const float* a0;
    __device__ __forceinline__ void operator()(const f32x4 (&acc)[2][2][4][2], const Unit& u, int wr, int wc, int fr, int fq) const {
        const int row0 = u.pm * BM + wr * 64 + fr, col0 = u.pn * BM + wc * 32 + 8 * fq;
        const float* par = (u.pn >= 4) ? (a0 - 1024) : w0;
#pragma unroll
        for (int ai = 0; ai < 2; ++ai)
#pragma unroll
            for (int m = 0; m < 4; ++m) {
#pragma unroll
                for (int bj = 0; bj < 2; ++bj) { bf16_t* rowp = O + (size_t)(row0 + ai * HALF + m * 16) * 2048 + col0 + bj * HALF;
                    const f32x4 x0 = acc[ai][bj][m][0] + *(const f32x4*)(par + col0 + bj * HALF), x1 = acc[ai][bj][m][1] + *(const f32x4*)(par + col0 + bj * HALF + 4); u32x4 w;
                    w.x = cvt_pk_bf16(sigm(x0[0]), sigm(x0[1])); w.y = cvt_pk_bf16(sigm(x0[2]), sigm(x0[3])); w.z = cvt_pk_bf16(sigm(x1[0]), sigm(x1[1])); w.w = cvt_pk_bf16(sigm(x1[2]), sigm(x1[3]));
                    *(u32x4*)rowp = w; }
                asm volatile("" ::: "memory"); }
    }
};
template <int MODE> struct EpiGate {
    static constexpr bool PERM = true, AFTER_DRAIN = false;
    bf16_t* O; const bf16_t* Gl; bf16_t* F;
    __device__ __forceinline__ void operator()(const f32x4 (&acc)[2][2][4][2], const Unit& u, int wr, int wc, int fr, int fq) const {
        const int row0 = u.pm * BM + wr * 64 + fr, col0 = u.pn * BM + wc * 32 + 8 * fq;
        bf16_t* fbase = F + (((size_t)u.pm * 4 + u.pn) * 8 + (wr * 4 + wc)) * (16 * 512) + (fq * 16 + fr) * 8;
        const bf16_t* gbase = Gl + (((size_t)u.pm * 8 + (u.pn + 4 * MODE)) * 8 + (wr * 4 + wc)) * (16 * 512) + (fq * 16 + fr) * 8;
        constexpr int D = MODE == 0 ? 4 : 3;
        u32x4 gq[8][2], tq[8][2];
#define PG8_EG_LOAD(s) do { _Pragma("unroll") for (int bj = 0; bj < 2; ++bj) { gq[s][bj] = *(const u32x4*)(gbase + ((s) * 2 + bj) * 512); if (MODE == 1) tq[s][bj] = *(const u32x4*)(fbase + ((s) * 2 + bj) * 512); } } while (0)
#pragma unroll
        for (int s = 0; s < D; ++s) PG8_EG_LOAD(s);
#pragma unroll
        for (int s = 0; s < 8; ++s) { const int ai = s >> 2, m = s & 3;
            if (s + D < 8) PG8_EG_LOAD(s + D);
#pragma unroll
            for (int bj = 0; bj < 2; ++bj) { const size_t row = (size_t)(row0 + ai * HALF + m * 16); const int col = col0 + bj * HALF;
                const unsigned gw[4] = {gq[s][bj].x, gq[s][bj].y, gq[s][bj].z, gq[s][bj].w}; float g[8];
#pragma unroll
                for (int e = 0; e < 4; ++e) { g[2 * e] = sigm(__builtin_bit_cast(float, gw[e] << 16)); g[2 * e + 1] = sigm(__builtin_bit_cast(float, gw[e] & 0xffff0000u)); }
                const f32x4 v0 = acc[ai][bj][m][0], v1 = acc[ai][bj][m][1];
                float r[8] = {g[0] * v0[0], g[1] * v0[1], g[2] * v0[2], g[3] * v0[3], g[4] * v1[0], g[5] * v1[1], g[6] * v1[2], g[7] * v1[3]};
                if (MODE == 1) { const unsigned tw[4] = {tq[s][bj].x, tq[s][bj].y, tq[s][bj].z, tq[s][bj].w};
#pragma unroll
                    for (int e = 0; e < 4; ++e) { r[2 * e] += __builtin_bit_cast(float, tw[e] << 16); r[2 * e + 1] += __builtin_bit_cast(float, tw[e] & 0xffff0000u); } }
                u32x4 w; w.x = cvt_pk_bf16(r[0], r[1]); w.y = cvt_pk_bf16(r[2], r[3]); w.z = cvt_pk_bf16(r[4], r[5]); w.w = cvt_pk_bf16(r[6], r[7]);
                if (MODE == 0) *(u32x4*)(fbase + (s * 2 + bj) * 512) = w; else *(u32x4*)(O + row * 1024 + col) = w; }
            asm volatile("" ::: "memory"); }
#undef PG8_EG_LOAD
    }
};
}
namespace pg8 {
struct EpiGateCat {
    static constexpr bool PERM = true, AFTER_DRAIN = false;
    bf16_t* O; const bf16_t* Gl;
    __device__ __forceinline__ void mid(f32x4 (&acc)[2][2][4][2], const Unit& u, int wr, int wc, int fr, int fq) const {
        const int row0 = u.pm * BM + wr * 64 + fr, col0 = u.pn * BM + wc * 32 + 8 * fq;
#pragma unroll
        for (int ai = 0; ai < 2; ++ai) {
            u32x4 gr[4][2], ga[4][2];
#pragma unroll
            for (int m = 0; m < 4; ++m)
#pragma unroll
                for (int bj = 0; bj < 2; ++bj) { const size_t row = (size_t)(row0 + ai * HALF + m * 16); const int col = col0 + bj * HALF;
                    gr[m][bj] = *(const u32x4*)(Gl + row * 2048 + col); ga[m][bj] = *(const u32x4*)(Gl + row * 2048 + 1024 + col); }
#pragma unroll
            for (int m = 0; m < 4; ++m)
#pragma unroll
                for (int bj = 0; bj < 2; ++bj) { const unsigned wr_[4] = {gr[m][bj].x, gr[m][bj].y, gr[m][bj].z, gr[m][bj].w}, wa_[4] = {ga[m][bj].x, ga[m][bj].y, ga[m][bj].z, ga[m][bj].w}; float rt[8];
#pragma unroll
                    for (int e = 0; e < 4; ++e) {
                        const float r0 = __builtin_bit_cast(float, wr_[e] << 16), r1 = __builtin_bit_cast(float, wr_[e] & 0xffff0000u), a0 = __builtin_bit_cast(float, wa_[e] << 16), a1 = __builtin_bit_cast(float, wa_[e] & 0xffff0000u);
                        rt[2 * e] = (1.0f + __expf(-a0)) * __builtin_amdgcn_rcpf(1.0f + __expf(-r0)); rt[2 * e + 1] = (1.0f + __expf(-a1)) * __builtin_amdgcn_rcpf(1.0f + __expf(-r1)); }
                    acc[ai][bj][m][0] = acc[ai][bj][m][0] * (f32x4){rt[0], rt[1], rt[2], rt[3]}; acc[ai][bj][m][1] = acc[ai][bj][m][1] * (f32x4){rt[4], rt[5], rt[6], rt[7]}; }
        }
    }
    __device__ __forceinline__ void operator()(const f32x4 (&acc)[2][2][4][2], const Unit& u, int wr, int wc, int fr, int fq) const {
        const int row0 = u.pm * BM + wr * 64 + fr, col0 = u.pn * BM + wc * 32 + 8 * fq;
#pragma unroll
        for (int ai = 0; ai < 2; ++ai) {
            u32x4 ga[4][2];
#pragma unroll
            for (int m = 0; m < 4; ++m)
#pragma unroll
                for (int bj = 0; bj < 2; ++bj) { const size_t row = (size_t)(row0 + ai * HALF + m * 16); const int col = col0 + bj * HALF; ga[m][bj] = *(const u32x4*)(Gl + row * 2048 + 1024 + col); }
#pragma unroll
            for (int m = 0; m < 4; ++m)
#pragma unroll
                for (int bj = 0; bj < 2; ++bj) { const size_t row = (size_t)(row0 + ai * HALF + m * 16); const int col = col0 + bj * HALF;
                    const unsigned wa_[4] = {ga[m][bj].x, ga[m][bj].y, ga[m][bj].z, ga[m][bj].w}; float g[8];
#pragma unroll
                    for (int e = 0; e < 4; ++e) { g[2 * e] = sigm(__builtin_bit_cast(float, wa_[e] << 16)); g[2 * e + 1] = sigm(__builtin_bit_cast(float, wa_[e] & 0xffff0000u)); }
                    const f32x4 v0 = acc[ai][bj][m][0], v1 = acc[ai][bj][m][1];
                    u32x4 w; w.x = cvt_pk_bf16(g[0] * v0[0], g[1] * v0[1]); w.y = cvt_pk_bf16(g[2] * v0[2], g[3] * v0[3]); w.z = cvt_pk_bf16(g[4] * v1[0], g[5] * v1[1]); w.w = cvt_pk_bf16(g[6] * v1[2], g[7] * v1[3]);
                    *(u32x4*)(O + row * 1024 + col) = w; }
        }
    }
};
}
namespace pg8 {
template <int CTRL> __device__ __forceinline__ float dppz(float v) { return __builtin_bit_cast(float, __builtin_amdgcn_update_dpp(0, __builtin_bit_cast(int, v), CTRL, 0xf, 0xf, true)); }
template <size_t OFF_R, size_t OFF_LA, size_t OFF_PA, size_t OFF_EDGE, size_t OFF_KK, int Mrows> struct EpiShift {
    static constexpr bool PERM = true, AFTER_DRAIN = false;
    unsigned char* ws;
    const float* mu;
    const float* k_k;
    PG8_LAS unsigned char* halo;
    __device__ __forceinline__ static int hidx(int wr, int wc, int ai, int edge, int bj, int n, int fq) { return ((((((wr * 4 + wc) * 2 + ai) * 2 + edge) * 2 + bj) * 2 + n) * 4 + fq) * 16; }
    __device__ __forceinline__ void operator()(const f32x4 (&acc)[2][2][4][2], const Unit& u, int wr, int wc, int fr_in, int fq_in) const {
        int fr = fr_in, fq = fq_in; asm volatile("" : "+v"(fr), "+v"(fq));
        const int row0 = u.pm * BM + wr * 64 + fr, colL = wc * 32 + 8 * fq;
        bf16_t* const R4 = (bf16_t*)(ws + OFF_R); bf16_t* const LAo = (bf16_t*)(ws + OFF_LA); bf16_t* const PAo = (bf16_t*)(ws + OFF_PA); bf16_t* const EDGE = (bf16_t*)(ws + OFF_EDGE); bf16_t* const KKo = (bf16_t*)(ws + OFF_KK);
        if (u.pn >= 9) {
            const int col0 = (u.pn - 9) * BM + colL;
#pragma unroll
            for (int ai = 0; ai < 2; ++ai)
#pragma unroll
                for (int m = 0; m < 4; ++m) { bf16_t* rowp = PAo + (size_t)(row0 + ai * HALF + m * 16) * 1280 + col0;
#pragma unroll
                    for (int bj = 0; bj < 2; ++bj) { const f32x4 v0 = acc[ai][bj][m][0], v1 = acc[ai][bj][m][1];
                        u32x4 w; w.x = cvt_pk_bf16(v0[0], v0[1]); w.y = cvt_pk_bf16(v0[2], v0[3]); w.z = cvt_pk_bf16(v1[0], v1[1]); w.w = cvt_pk_bf16(v1[2], v1[3]);
                        *(u32x4*)(rowp + bj * HALF) = w; } }
            return;
        }
        if (fr == 0 || fr == 15) { const int edge = fr == 15, mm = edge ? 3 : 0;
#pragma unroll
            for (int ai = 0; ai < 2; ++ai)
#pragma unroll
                for (int bj = 0; bj < 2; ++bj)
#pragma unroll
                    for (int n = 0; n < 2; ++n) *(PG8_LAS f32x4*)(halo + hidx(wr, wc, ai, edge, bj, n, fq)) = edge ? acc[ai][bj][3][n] : acc[ai][bj][0][n];
            (void)mm; }
        if ((wr == 0 && fr < 2) || (wr == 1 && fr >= 14)) { const int slot = wr == 0 ? fr : fr - 12;
            bf16_t* ep = EDGE + ((size_t)u.pm * 4 + slot) * 2304 + u.pn * BM + colL;
#pragma unroll
            for (int bj = 0; bj < 2; ++bj) { const f32x4 v0 = wr == 0 ? acc[0][bj][0][0] : acc[1][bj][3][0], v1 = wr == 0 ? acc[0][bj][0][1] : acc[1][bj][3][1];
                u32x4 w; w.x = cvt_pk_bf16(v0[0], v0[1]); w.y = cvt_pk_bf16(v0[2], v0[3]); w.z = cvt_pk_bf16(v1[0], v1[1]); w.w = cvt_pk_bf16(v1[2], v1[3]);
                *(u32x4*)(ep + bj * HALF) = w; } }
        asm volatile("s_waitcnt lgkmcnt(0)" ::: "memory");
        __builtin_amdgcn_s_barrier();
        asm volatile("" ::: "memory");
        const bool isla = u.pn == 8;
        bf16_t* obase = isla ? LAo : R4 + (size_t)(u.pn >> 1) * Mrows * 512 + (u.pn & 1) * 256;
        const int ld = isla ? 256 : 512;
#pragma unroll
        for (int bj = 0; bj < 2; ++bj) {
            const float* mup = mu + u.pn * BM + bj * HALF + colL;
            f32x4 m0[2], m1[2], c0[2];
#pragma unroll
            for (int n = 0; n < 2; ++n) { m0[n] = *(const f32x4*)(mup + 4 * n); m1[n] = *(const f32x4*)(mup + 2304 + 4 * n); c0[n] = 1.0f - m0[n] - m1[n]; }
#pragma unroll
            for (int ai = 0; ai < 2; ++ai) {
                f32x4 hp[2], hn[2];
                const bool hasp = (wr == 1) || (ai == 1), hasn = (wr == 0) || (ai == 0);
                const int pw = wr ^ 1, pai = (wr == 1) ? ai : 0, nai = (wr == 0) ? ai : 1;
#pragma unroll
                for (int n = 0; n < 2; ++n) { hp[n] = hasp ? *(const PG8_LAS f32x4*)(halo + hidx(pw, wc, pai, 1, bj, n, fq)) : (f32x4){0.f, 0.f, 0.f, 0.f};
                                              hn[n] = hasn ? *(const PG8_LAS f32x4*)(halo + hidx(pw, wc, nai, 0, bj, n, fq)) : (f32x4){0.f, 0.f, 0.f, 0.f}; }
                unsigned wq[4][4];
#pragma unroll
                for (int n = 0; n < 2; ++n) {
                    f32x4 A[4], B[4];
#pragma unroll
                    for (int m = 0; m < 4; ++m) { A[m] = acc[ai][bj][m][n] * m0[n]; B[m] = acc[ai][bj][m][n] * m1[n]; }
                    const f32x4 Ah = hp[n] * m0[n], Bh = hn[n] * m1[n];
#pragma unroll
                    for (int m = 0; m < 4; ++m) { const f32x4 p = acc[ai][bj][m][n], Am = m > 0 ? A[m > 0 ? m - 1 : 0] : Ah, Bp = m < 3 ? B[m < 3 ? m + 1 : 3] : Bh; float o[4];
#pragma unroll
                        for (int k = 0; k < 4; ++k) { float v = c0[n][k] * p[k];
                            v += dppz<0x111>(A[m][k]); v += dppz<0x10F>(Am[k]);
                            v += dppz<0x101>(B[m][k]); v += dppz<0x11F>(Bp[k]);
                            o[k] = v; }
                        if (isla && bj == 0) {
#pragma unroll
                            for (int e = 0; e < 4; ++e) o[e] = 1.0f - 2.0f * __builtin_amdgcn_rcpf(1.0f + __expf(2.0f * o[e])); }
                        wq[m][2 * n] = cvt_pk_bf16(o[0], o[1]); wq[m][2 * n + 1] = cvt_pk_bf16(o[2], o[3]); }
                }
#pragma unroll
                for (int m = 0; m < 4; ++m) { u32x4 w; w.x = wq[m][0]; w.y = wq[m][1]; w.z = wq[m][2]; w.w = wq[m][3];
                    *(u32x4*)(obase + (size_t)(row0 + ai * HALF + m * 16) * ld + bj * HALF + colL) = w; }
            }
        }
        if (u.pn == 2 || u.pn == 3) {
            asm volatile("s_waitcnt vmcnt(0)" ::: "memory");
            __builtin_amdgcn_s_barrier();
            asm volatile("" ::: "memory");
            const int lane = fq * 16 + fr, wave = wr * 4 + wc, cc = (u.pn - 2) * BM + 8 * (lane & 31);
            const f32x4 ka = *(const f32x4*)(k_k + cc), kb = *(const f32x4*)(k_k + cc + 4);
            const float kw[8] = {ka[0], ka[1], ka[2], ka[3], kb[0], kb[1], kb[2], kb[3]};
            const bf16_t* Kt = R4 + (size_t)Mrows * 512;
            const size_t rbase = (size_t)u.pm * BM + wave * 32 + (lane >> 5);
#pragma unroll
            for (int i0 = 0; i0 < 16; i0 += 8) {
            u32x4 kq[8];
#pragma unroll
            for (int i = 0; i < 8; ++i) kq[i] = *(const u32x4*)(Kt + (rbase + 2 * (i0 + i)) * 512 + cc);
#pragma unroll
            for (int ii = 0; ii < 8; ++ii) { const int i = i0 + ii; const unsigned w4[4] = {kq[ii].x, kq[ii].y, kq[ii].z, kq[ii].w}; float kr[8]; float ss = 0.f;
#pragma unroll
                for (int e = 0; e < 4; ++e) { kr[2 * e] = __builtin_bit_cast(float, w4[e] << 16) * kw[2 * e]; kr[2 * e + 1] = __builtin_bit_cast(float, w4[e] & 0xffff0000u) * kw[2 * e + 1]; ss += kr[2 * e] * kr[2 * e] + kr[2 * e + 1] * kr[2 * e + 1]; }
                ss += dppz<0xB1>(ss); ss += dppz<0x4E>(ss); ss += dppz<0x141>(ss);
                const float inv = 1.0f / fmaxf(sqrtf(ss), 1e-12f);
                u32x4 w; w.x = cvt_pk_bf16(kr[0] * inv, kr[1] * inv); w.y = cvt_pk_bf16(kr[2] * inv, kr[3] * inv); w.z = cvt_pk_bf16(kr[4] * inv, kr[5] * inv); w.w = cvt_pk_bf16(kr[6] * inv, kr[7] * inv);
                *(u32x4*)(KKo + (rbase + 2 * i) * 512 + cc) = w; }
            asm volatile("" ::: "memory"); }
        }
    }
};
}
#define GAS __attribute__((address_space(1)))
#define LAS __attribute__((address_space(3)))
typedef unsigned short bf16;
typedef unsigned v4u __attribute__((ext_vector_type(4)));
typedef float f32x4 __attribute__((ext_vector_type(4)));
typedef short bf16x8 __attribute__((ext_vector_type(8)));
typedef GAS unsigned gu32;
typedef GAS unsigned long long gu64;
#define RLX_AGENT __ATOMIC_RELAXED, __HIP_MEMORY_SCOPE_AGENT
#define LDS_WAIT() asm volatile("s_waitcnt lgkmcnt(0)" ::: "memory")
#define VM_WAIT() asm volatile("s_waitcnt vmcnt(0)" ::: "memory")
__device__ __forceinline__ unsigned long long rt() { return __builtin_amdgcn_s_memrealtime(); }
__device__ __forceinline__ unsigned f2bf(float f) { unsigned u = __builtin_bit_cast(unsigned, f); return (u + 0x7fffu + ((u >> 16) & 1u)) >> 16; }
__device__ __forceinline__ unsigned pk2(float lo, float hi) { return f2bf(lo) | (f2bf(hi) << 16); }
#define XB_TMO      128
#define XB_XCNT(j)  (256  + 64 * (j))
#define XB_XSUB(j)  (1280 + 64 * (j))
#define XB_XGEN(j)  (2304 + 64 * (j))
#define XB_TOP      3328
#define XB_TOPGEN   3392
#define XCD_BAR_WORDS 3456
#define XB_SPIN_CAP (1u << 18)

__device__ __forceinline__ unsigned xb_ld(unsigned* p)              { return __hip_atomic_load(p, __ATOMIC_RELAXED, __HIP_MEMORY_SCOPE_AGENT); }
__device__ __forceinline__ unsigned xb_add(unsigned* p, unsigned v) { return __hip_atomic_fetch_add(p, v, __ATOMIC_RELAXED, __HIP_MEMORY_SCOPE_AGENT); }
__device__ __forceinline__ unsigned xb_xcc_id() { return (unsigned)__builtin_amdgcn_s_getreg((3 << 11) | 20) & 0xFu; }
#define XB_SPIN(cond, bar) do { unsigned _sp = 0; while (cond) { __builtin_amdgcn_s_sleep(1); \
    if ((++_sp & 255u) == 0u) { if (xb_ld(&(bar)[XB_TMO])) break; if (_sp > XB_SPIN_CAP) { atomicAdd(&(bar)[XB_TMO], 1u); break; } } } } while (0)

struct XcdBarrier {
    unsigned* bar; unsigned x;
    volatile LAS unsigned* st;
};

__device__ __forceinline__ XcdBarrier xcd_barrier_post(unsigned* bar, volatile LAS unsigned* st) {
    XcdBarrier b; b.bar = bar; b.x = xb_xcc_id(); b.st = st;
    if (threadIdx.x == 0) (void)xb_add(&bar[XB_XCNT(b.x)], 1u);
    return b;
}
__device__ __forceinline__ void xcd_barrier_complete(unsigned* bar, unsigned x, unsigned& nloc, unsigned& nx) {
    const unsigned G = gridDim.x * gridDim.y * gridDim.z;
    unsigned sum, cnt, mine, sp = 0u;
    for (;;) {
        sum = 0u; cnt = 0u; mine = 0u;
#pragma unroll
        for (unsigned j = 0; j < 16; ++j) { const unsigned c = xb_ld(&bar[XB_XCNT(j)]); sum += c; cnt += (c > 0u) ? 1u : 0u; mine = (j == x) ? c : mine; }
        if (sum == G) break;
        __builtin_amdgcn_s_sleep(1);
        if ((++sp & 255u) == 0u) { if (xb_ld(&bar[XB_TMO])) break; if (sp > XB_SPIN_CAP) { atomicAdd(&bar[XB_TMO], 1u); break; } }
    }
    nloc = mine > 0u ? mine : 1u; nx = cnt > 0u ? cnt : 1u;
}

__device__ __forceinline__ void xcd_barrier(const XcdBarrier& b) {
    asm volatile("s_waitcnt vmcnt(0)" ::: "memory");
    __syncthreads();
    if (threadIdx.x == 0) {
        unsigned* bar = b.bar;
        __builtin_amdgcn_s_waitcnt(0);
        unsigned nloc = b.st[0], nx = b.st[1];
        if (nloc == 0u) { xcd_barrier_complete(bar, b.x, nloc, nx); b.st[0] = nloc; b.st[1] = nx; }
        const unsigned old = xb_add(&bar[XB_XSUB(b.x)], 1u);
        const unsigned gen = old / nloc;
        if (old + 1u == (gen + 1u) * nloc) {
            __builtin_amdgcn_fence(__ATOMIC_RELEASE, "agent");
            asm volatile("s_waitcnt vmcnt(0)" ::: "memory");
            const unsigned og = xb_add(&bar[XB_TOP], 1u);
            const unsigned tg = og / nx;
            if (og + 1u == (tg + 1u) * nx) xb_add(&bar[XB_TOPGEN], 1u);
            else XB_SPIN(xb_ld(&bar[XB_TOPGEN]) == tg, bar);
            __builtin_amdgcn_fence(__ATOMIC_ACQUIRE, "agent");
            xb_add(&bar[XB_XGEN(b.x)], 1u);
            asm volatile("s_waitcnt vmcnt(0)" ::: "memory");
        } else {
            XB_SPIN(xb_ld(&bar[XB_XGEN(b.x)]) == gen, bar);
            __builtin_amdgcn_fence(__ATOMIC_ACQUIRE, "agent");
            asm volatile("s_waitcnt vmcnt(0)" ::: "memory");
        }
    }
    __syncthreads();
}
constexpr int NWAVES = 8;
constexpr int BATCH = 32, SEQ = 2048, DM = 1024, M = BATCH * SEQ;
constexpr int RW = 512, RCOLS = 2304, ACOLS = 1280, GCOLS = 2048;
enum { I_X = 0, I_C, I_WADA, I_BADA, I_GPRE, I_GPOST, I_WIN, I_MU, I_W0, I_WUP, I_A0, I_AUP, I_KK, I_KA, I_RK, I_GNW, I_GNB, I_SINK, I_WBRR, I_WBRA, I_WOUT, NIN };
#ifndef MK_N_LAUNCHES
#define MK_N_LAUNCHES 1
#endif
constexpr int N_PHASES = 12;
#ifndef MK_PLAN
#define MK_PLAN {{0, N_PHASES}}
#endif
#ifndef MK_PROBE_FLAGS
#define MK_PROBE_FLAGS 0
#endif
constexpr int N_LAUNCHES = MK_N_LAUNCHES;
constexpr size_t MiB = 1u << 20;
constexpr size_t WS_CTL = 0, CTL_ZERO_BYTES = 1 * MiB;
constexpr size_t WS_ADA = 512 * 1024;
constexpr size_t WS_BSUM = 2 * MiB;
constexpr size_t WS_BP4 = 984 * MiB;
constexpr size_t WS_WINT = 4 * MiB;
constexpr size_t WS_WBRR = 15 * MiB, WS_WBRA = 16 * MiB, WS_WOUT = 17 * MiB, WS_WLORA = 19 * MiB;
constexpr size_t WS_H = 24 * MiB;
constexpr size_t WS_PA = 152 * MiB;
constexpr size_t WS_PR = 312 * MiB;
constexpr size_t WS_KD1 = 568 * MiB;
constexpr size_t WS_LA = 600 * MiB;
constexpr size_t WS_R = 632 * MiB, WS_K = 696 * MiB, WS_V = 760 * MiB, WS_G = 824 * MiB, WS_KK = 888 * MiB;
constexpr size_t WS_MG = 568 * MiB;
constexpr size_t WS_PG = 312 * MiB;
constexpr size_t WS_BR = 568 * MiB;
constexpr size_t WS_BA = 824 * MiB;
constexpr size_t WS_KB = 952 * MiB, WS_VB = 968 * MiB;
constexpr size_t WS_EDGE = 992 * MiB;
constexpr size_t WS_END = 1024 * MiB;
constexpr int CW_BAR = 4096;
constexpr int RING_BYTES = 155648, LDSCTL_OFF = RING_BYTES, MISC_OFF = LDSCTL_OFF + 320, LDS_BYTES = 163840;

__device__ __forceinline__ float bflo(unsigned w) { return __builtin_bit_cast(float, w << 16); }
__device__ __forceinline__ float bfhi(unsigned w) { return __builtin_bit_cast(float, w & 0xffff0000u); }
__device__ __forceinline__ float bf2f(bf16 u) { return __builtin_bit_cast(float, (unsigned)u << 16); }
__device__ __forceinline__ void unpack8(const v4u q, float* f) { f[0] = bflo(q.x); f[1] = bfhi(q.x); f[2] = bflo(q.y); f[3] = bfhi(q.y); f[4] = bflo(q.z); f[5] = bfhi(q.z); f[6] = bflo(q.w); f[7] = bfhi(q.w); }
__device__ __forceinline__ unsigned cvtpk_c(float lo, float hi);
__device__ __forceinline__ v4u pack8(const float* f) { v4u o; o.x = cvtpk_c(f[0], f[1]); o.y = cvtpk_c(f[2], f[3]); o.z = cvtpk_c(f[4], f[5]); o.w = cvtpk_c(f[6], f[7]); return o; }
__device__ __forceinline__ float sigmoidf_(float x) { return __builtin_amdgcn_rcpf(1.0f + __expf(-x)); }
__device__ __forceinline__ float wave_sum(float v) {
#pragma unroll
    for (int o = 1; o < 64; o <<= 1) v += __shfl_xor(v, o);
    return v;
}
__device__ __forceinline__ void transpose_item(const float* W, int K, int N, bf16* WT, int ldwt, int row_off, int kcol_off, LAS float* scr, int item, int lane) {
    const int nblk = N / 32, kb = item / nblk, nb = item % nblk, k0 = 64 * kb, n0 = 32 * nb;
#pragma unroll 8
    for (int i = 0; i < 32; ++i) { const int kk = 2 * i + (lane >> 5); scr[kk * 33 + (lane & 31)] = W[(size_t)(k0 + kk) * N + n0 + (lane & 31)]; }
    LDS_WAIT(); asm volatile("" ::: "memory");
    const int c = lane & 7;
#pragma unroll
    for (int j = 0; j < 4; ++j) { const int n = (lane >> 3) + 8 * j; const LAS float* s = scr + (8 * c) * 33 + n;
        v4u o; o.x = pk2(s[0 * 33], s[1 * 33]); o.y = pk2(s[2 * 33], s[3 * 33]); o.z = pk2(s[4 * 33], s[5 * 33]); o.w = pk2(s[6 * 33], s[7 * 33]);
        *(GAS v4u*)(WT + (size_t)(row_off + n0 + n) * ldwt + kcol_off + k0 + 8 * c) = o; }
    LDS_WAIT(); asm volatile("" ::: "memory");
}

typedef unsigned u32x2_t __attribute__((ext_vector_type(2)));
typedef float f32x2_c __attribute__((ext_vector_type(2))); typedef __bf16 bf16x2_c __attribute__((ext_vector_type(2)));
__device__ __forceinline__ unsigned cvtpk_c(float lo, float hi) { const f32x2_c v = {lo, hi}; const bf16x2_c b = __builtin_convertvector(v, bf16x2_c); return __builtin_bit_cast(unsigned, b); }
__device__ __forceinline__ bf16x8 ldsfrag_perm(const LAS unsigned char* p) { const u32x2_t a = *(const LAS u32x2_t*)p, b = *(const LAS u32x2_t*)(p + 16); return __builtin_bit_cast(bf16x8, (v4u){a.x, a.y, b.x, b.y}); }
template <int CTRL> __device__ __forceinline__ float dppf(float v) { return __builtin_bit_cast(float, __builtin_amdgcn_update_dpp(0, __builtin_bit_cast(int, v), CTRL, 0xf, 0xf, true)); }
struct Args { const float* in[NIN]; float* out; unsigned char* ws; int ph_lo, ph_hi, li, pad; };

#define PTRS const int G = gridDim.x, bx = blockIdx.x; const int vcu = (G % 8 == 0) ? (bx % 8) * (G / 8) + bx / 8 : bx; const int gw = vcu * NWAVES + wave, NGW = G * NWAVES; (void)gw; (void)NGW; const float* x = args.in[I_X]; const float* cin = args.in[I_C]; const float* wada = args.in[I_WADA]; const float* bada = args.in[I_BADA]; const float* gpre = args.in[I_GPRE]; const float* gpost = args.in[I_GPOST]; const float* win = args.in[I_WIN]; const float* mu = args.in[I_MU]; const float* w0 = args.in[I_W0]; const float* wup = args.in[I_WUP]; const float* a0 = args.in[I_A0]; const float* aup = args.in[I_AUP]; const float* k_k = args.in[I_KK]; const float* k_a = args.in[I_KA]; const float* r_k = args.in[I_RK]; const float* gnw = args.in[I_GNW]; const float* gnb = args.in[I_GNB]; const float* sink = args.in[I_SINK]; const float* wbrr = args.in[I_WBRR]; const float* wbra = args.in[I_WBRA]; const float* wout = args.in[I_WOUT]; float* out = args.out; float* ADA = (float*)(ws + WS_ADA); float* BSUM = (float*)(ws + WS_BSUM); float* BP4 = (float*)(ws + WS_BP4); (void)BSUM; bf16* WinT = (bf16*)(ws + WS_WINT); bf16* WbrrT = (bf16*)(ws + WS_WBRR); bf16* WbraT = (bf16*)(ws + WS_WBRA); bf16* WoutT = (bf16*)(ws + WS_WOUT); bf16* WloraT = (bf16*)(ws + WS_WLORA); bf16* Hb = (bf16*)(ws + WS_H); bf16* MG = (bf16*)(ws + WS_MG); bf16* PA = (bf16*)(ws + WS_PA); bf16* PR = (bf16*)(ws + WS_PR); bf16* RAW = (bf16*)(ws + WS_PR); bf16* PGT = (bf16*)(ws + WS_PG); bf16* OUTB = (bf16*)(ws + WS_PR); bf16* KD1 = (bf16*)(ws + WS_KD1); bf16* LA = (bf16*)(ws + WS_LA); bf16* Rb = (bf16*)(ws + WS_R); bf16* Kb = (bf16*)(ws + WS_K); bf16* Vb = (bf16*)(ws + WS_V); bf16* Gb = (bf16*)(ws + WS_G); bf16* KKb = (bf16*)(ws + WS_KK); bf16* KB = (bf16*)(ws + WS_KB); bf16* VB = (bf16*)(ws + WS_VB); bf16* EDGE = (bf16*)(ws + WS_EDGE); bf16* BR = (bf16*)(ws + WS_BR); bf16* BA = (bf16*)(ws + WS_BA);
__global__ void __launch_bounds__(NWAVES * 64, 2) mk_fwd(Args args) {
    extern __shared__ __attribute__((aligned(16))) unsigned char lds_raw[];
    LAS unsigned char* lds = (LAS unsigned char*)lds_raw;
    volatile LAS unsigned* MISC = (volatile LAS unsigned*)(lds + MISC_OFF);
    const int tid = threadIdx.x, lane = tid & 63, wave = __builtin_amdgcn_readfirstlane(tid >> 6);
    unsigned char* ws = args.ws;
    gu32* ctl = (gu32*)(ws + WS_CTL);
    for (int u = tid; u < (LDS_BYTES - LDSCTL_OFF) / 4; u += NWAVES * 64) ((LAS unsigned*)(lds + LDSCTL_OFF))[u] = 0u;
    __syncthreads();
    XcdBarrier bar; bar.bar = (unsigned*)(ctl + CW_BAR); bar.x = 0; bar.st = nullptr;
    const bool use_bar = (args.ph_hi - args.ph_lo) > 1;
    if (use_bar) bar = xcd_barrier_post((unsigned*)(ctl + CW_BAR) + args.li * XCD_BAR_WORDS, MISC + 8);
#define GRID_BAR() do { if (use_bar) xcd_barrier(bar); } while (0)
#define IN(k) (args.ph_lo <= (k) && (k) < args.ph_hi)
#define BOTH(k) (IN(k) && IN((k) + 1))
    if (IN(0)) { PTRS
        LAS float* scr = (LAS float*)(lds + wave * 16384);
        constexpr int I_IN = 16 * 176, I_BRR = 8 * 32, I_OUT = 16 * 32, I_LORA = 64, NT = I_IN + 2 * I_BRR + I_OUT + I_LORA;
        for (int it = gw; it < NT; it += NGW) {
            int r = it;
            if (r < I_IN) { transpose_item(win, 1024, 5632, WinT, 1024, 0, 0, scr, r, lane); continue; } r -= I_IN;
            if (r < I_BRR) { transpose_item(wbrr, 512, 1024, WbrrT, 512, 0, 0, scr, r, lane); continue; } r -= I_BRR;
            if (r < I_BRR) { transpose_item(wbra, 512, 1024, WbraT, 512, 0, 0, scr, r, lane); continue; } r -= I_BRR;
            if (r < I_OUT) { transpose_item(wout, 1024, 1024, WoutT, 1024, 0, 0, scr, r, lane); continue; } r -= I_OUT;
            { const int mat = r >> 4, nb = r & 15, half = mat >> 1, dd = mat & 1; const float* W = (half ? aup : wup) + (size_t)dd * 64 * 512;
              bf16* WL = WloraT + (size_t)half * 1024 * 128;
              transpose_item(W, 64, 512, WL, 128, dd * 512, dd * 64, scr, nb, lane);
#pragma unroll
              for (int i = 0; i < 4; ++i) { const int q = lane + 64 * i, row = q >> 3, chunk = (q & 7) + (dd ? 0 : 8);
                  *(GAS v4u*)(WL + (size_t)(dd * 512 + nb * 32 + row) * 128 + chunk * 8) = (v4u){0u, 0u, 0u, 0u}; } }
        }
        for (int it = gw; it < 1536; it += NGW) {
            const int nblk = it % 48, r_ = it / 48, bg = r_ & 7, kq = r_ >> 3, n = nblk * 64 + lane, b0 = bg * 4, kbase = kq * 256;
#pragma unroll
            for (int bb = 0; bb < 4; ++bb)
#pragma unroll
                for (int kk = 0; kk < 4; ++kk) { const int k = lane + 64 * kk; const float cv = cin[(b0 + bb) * 1024 + kbase + k]; scr[k * 4 + bb] = cv * sigmoidf_(cv); }
            LDS_WAIT(); asm volatile("" ::: "memory");
            float acc[4] = {0.f, 0.f, 0.f, 0.f};
#pragma unroll 32
            for (int k = 0; k < 256; ++k) { const float wv = wada[(size_t)(kbase + k) * 3072 + n]; const f32x4 s = *(const LAS f32x4*)(scr + k * 4);
                acc[0] += s[0] * wv; acc[1] += s[1] * wv; acc[2] += s[2] * wv; acc[3] += s[3] * wv; }
            const float bn = kq == 0 ? bada[n] : 0.f;
#pragma unroll
            for (int bb = 0; bb < 4; ++bb) atomicAdd(ADA + (b0 + bb) * 3072 + n, acc[bb] + bn);
            LDS_WAIT(); asm volatile("" ::: "memory");
        }
        if (BOTH(0)) GRID_BAR();
    }
    if (IN(1)) { PTRS
        {
            f32x4 v[4], vn[4];
#define P1_LOAD(mm, V) do { const GAS f32x4* xr_ = (const GAS f32x4*)(x + (size_t)(mm) * DM) + lane; _Pragma("unroll") for (int j = 0; j < 4; ++j) V[j] = xr_[64 * j]; } while (0)
            if (gw < M) P1_LOAD(gw, vn);
            for (int m = gw; m < M; m += NGW) {
                const int b = m >> 11;
#pragma unroll
                for (int j = 0; j < 4; ++j) v[j] = vn[j];
                if (m + NGW < M) P1_LOAD(m + NGW, vn);
                float s = 0.f;
#pragma unroll
                for (int j = 0; j < 4; ++j) s += (v[j].x * v[j].x + v[j].y * v[j].y) + (v[j].z * v[j].z + v[j].w * v[j].w);
                const float rinv = 1.0f / sqrtf(wave_sum(s) * (1.f / DM) + 1e-6f);
                GAS unsigned long long* o8 = (GAS unsigned long long*)(Hb + (size_t)m * DM) + lane;
#pragma unroll
                for (int j = 0; j < 4; ++j) { const int c = 4 * (lane + 64 * j);
                    const f32x4 gp = *(const f32x4*)(gpre + c), sh = *(const f32x4*)(ADA + b * 3072 + c), sc = *(const f32x4*)(ADA + b * 3072 + 1024 + c);
                    const f32x4 hh = v[j] * rinv * gp * (sc + 1.0f) + sh;
                    o8[64 * j] = (unsigned long long)cvtpk_c(hh.x, hh.y) | ((unsigned long long)cvtpk_c(hh.z, hh.w) << 32); }
            }
#undef P1_LOAD
        }
        if (BOTH(1)) GRID_BAR();
    }
    if (IN(2)) { PTRS
        pg8::Gemm g{Hb, WinT, M, 3584, 1024, 1024}; pg8::StaticOrder S; S.init(M, 3584, G, bx);
        typedef pg8::EpiShift<WS_R, WS_LA, WS_PA, WS_EDGE, WS_KK, M> EpiShiftT;
        EpiShiftT E{ws, mu, k_k, lds + pg8::STAGE_BYTES};
        pg8::gemm_phase<EpiShiftT, pg8::StaticOrder, true, true>(lds, g, S, E);
        if (BOTH(2)) GRID_BAR();
    }
    if (IN(3)) { PTRS
        {
            const v4u zero4 = (v4u){0u, 0u, 0u, 0u};
            for (int it = gw; it < 2 * (M / 256); it += NGW) {
                const int pm = it >> 1, e = it & 1, m = pm * 256 + (e ? 255 : 0), tseg = pm & 7;
                const bf16* ec = EDGE + ((size_t)pm * 4 + (e ? 3 : 0)) * RCOLS;
                const bf16* ep = e ? EDGE + ((size_t)pm * 4 + 2) * RCOLS : EDGE + ((size_t)(pm - 1) * 4 + 3) * RCOLS;
                const bf16* en = e ? EDGE + ((size_t)(pm + 1) * 4 + 0) * RCOLS : EDGE + ((size_t)pm * 4 + 1) * RCOLS;
                const bool hasp = e || tseg > 0, hasn = !e || tseg < 7;
#pragma unroll
                for (int i = 0; i < 5; ++i) {
                    if (i == 4 && lane >= 32) break;
                    const int c = 8 * (lane + 64 * i);
                    const v4u cu = *(const v4u*)(ec + c), pv = hasp ? *(const v4u*)(ep + c) : zero4, nx = hasn ? *(const v4u*)(en + c) : zero4;
                    const f32x4 m0a = *(const f32x4*)(mu + c), m0b = *(const f32x4*)(mu + c + 4), m1a = *(const f32x4*)(mu + RCOLS + c), m1b = *(const f32x4*)(mu + RCOLS + c + 4);
                    const float mm0[8] = {m0a.x, m0a.y, m0a.z, m0a.w, m0b.x, m0b.y, m0b.z, m0b.w}, mm1[8] = {m1a.x, m1a.y, m1a.z, m1a.w, m1b.x, m1b.y, m1b.z, m1b.w};
                    float p[8], pp[8], pn[8], o[8];
                    unpack8(cu, p); unpack8(pv, pp); unpack8(nx, pn);
#pragma unroll
                    for (int e8 = 0; e8 < 8; ++e8) o[e8] = p[e8] + mm0[e8] * (pp[e8] - p[e8]) + mm1[e8] * (pn[e8] - p[e8]);
                    if (i == 0) { *(v4u*)(Rb + (size_t)m * RW + c) = pack8(o); }
                    else if (i == 1) { const int cc = c - 512;
                        *(v4u*)(Kb + (size_t)m * RW + cc) = pack8(o);
                        const f32x4 ka_ = *(const f32x4*)(k_k + cc), kb_ = *(const f32x4*)(k_k + cc + 4);
                        const float kkw[8] = {ka_.x, ka_.y, ka_.z, ka_.w, kb_.x, kb_.y, kb_.z, kb_.w};
                        float kr[8]; float ss = 0.f;
#pragma unroll
                        for (int e8 = 0; e8 < 8; ++e8) { kr[e8] = o[e8] * kkw[e8]; ss += kr[e8] * kr[e8]; }
                        ss += __shfl_xor(ss, 1); ss += __shfl_xor(ss, 2); ss += __shfl_xor(ss, 4);
                        const float inv = 1.0f / fmaxf(sqrtf(ss), 1e-12f);
#pragma unroll
                        for (int e8 = 0; e8 < 8; ++e8) kr[e8] *= inv;
                        *(v4u*)(KKb + (size_t)m * RW + cc) = pack8(kr); }
                    else if (i == 2) { *(v4u*)(Vb + (size_t)m * RW + (c - 1024)) = pack8(o); }
                    else if (i == 3) { *(v4u*)(Gb + (size_t)m * RW + (c - 1536)) = pack8(o); }
                    else { if (lane < 16) {
#pragma unroll
                            for (int e8 = 0; e8 < 8; ++e8) o[e8] = 1.0f - 2.0f * __builtin_amdgcn_rcpf(1.0f + __expf(2.0f * o[e8])); }
                        *(v4u*)(LA + (size_t)m * 256 + (c - 2048)) = pack8(o); }
                }
            }
        }
        {
            LAS unsigned char* scr8 = lds + wave * 16384;
            for (int u = gw; u < 2048; u += NGW) {
                const int b = u >> 6, kvh = (u >> 5) & 1, tb = u & 31;
                const bf16* srck = PA + ((size_t)b * SEQ + tb * 64 + lane) * ACOLS + 512 + kvh * 64;
                const size_t tile0 = ((size_t)(b * 2 + kvh) * 64 + 2 * tb);
#pragma unroll
                for (int j8 = 0; j8 < 8; ++j8) *(LAS v4u*)(scr8 + lane * 144 + 16 * j8) = *(const v4u*)(srck + 8 * j8);
                LDS_WAIT(); asm volatile("" ::: "memory");
#pragma unroll
                for (int tt = 0; tt < 2; ++tt)
#pragma unroll
                    for (int ks = 0; ks < 4; ++ks) *(v4u*)(KB + (((tile0 + tt) * 4 + ks) * 64 + lane) * 8) = *(const LAS v4u*)(scr8 + (32 * tt + (lane & 31)) * 144 + (16 * ks + 8 * (lane >> 5)) * 2);
                LDS_WAIT(); asm volatile("" ::: "memory");
                LAS unsigned short* tile = (LAS unsigned short*)scr8;
                const bf16* srcv = srck + 128;
#pragma unroll
                for (int j8 = 0; j8 < 8; ++j8) { const v4u qv = *(const v4u*)(srcv + 8 * j8); LAS unsigned* dst = (LAS unsigned*)(tile + lane * 66 + 8 * j8);
                    dst[0] = qv.x; dst[1] = qv.y; dst[2] = qv.z; dst[3] = qv.w; }
                LDS_WAIT(); asm volatile("" ::: "memory");
#pragma unroll
                for (int tt = 0; tt < 2; ++tt)
#pragma unroll
                    for (int mb = 0; mb < 2; ++mb)
#pragma unroll
                        for (int k2 = 0; k2 < 2; ++k2) { unsigned w[4];
#pragma unroll
                            for (int e = 0; e < 4; ++e) { const int j0 = 2 * e, key0 = 32 * tt + 16 * k2 + 8 * (j0 >> 2) + 4 * (lane >> 5) + (j0 & 3);
                                const unsigned lo16 = tile[key0 * 66 + 32 * mb + (lane & 31)], hi16 = tile[(key0 + 1) * 66 + 32 * mb + (lane & 31)]; w[e] = lo16 | (hi16 << 16); }
                            *(v4u*)(VB + ((((tile0 + tt) * 2 + mb) * 2 + k2) * 64 + lane) * 8) = (v4u){w[0], w[1], w[2], w[3]}; }
                LDS_WAIT(); asm volatile("" ::: "memory");
            }
        }
        if (BOTH(3)) GRID_BAR();
    }
    if (IN(4)) { PTRS
        pg8::Gemm g{LA, WloraT, M, 2048, 128, 256, 4, 256}; pg8::StaticOrder S; S.init(M, 2048, G, bx);
        pg8::EpiLora E{RAW, w0, a0};
        pg8::gemm_phase<pg8::EpiLora, pg8::StaticOrder, true, true>(lds, g, S, E);
        if (BOTH(4)) GRID_BAR();
    }
    if (IN(6)) { PTRS
        typedef float f32x16 __attribute__((ext_vector_type(16)));
#define MF(a, b, c) __builtin_amdgcn_mfma_f32_32x32x16_bf16(a, b, c, 0, 0, 0)
#define ACCF(x, s) __builtin_bit_cast(bf16x8, (v4u){cvtpk_c((x)[8 * (s) + 0], (x)[8 * (s) + 1]), cvtpk_c((x)[8 * (s) + 2], (x)[8 * (s) + 3]), cvtpk_c((x)[8 * (s) + 4], (x)[8 * (s) + 5]), cvtpk_c((x)[8 * (s) + 6], (x)[8 * (s) + 7])})
#define LDN(img, pitch, rowb, k0) (*(const LAS bf16x8*)((img) + ((rowb) + q) * (pitch) + ((k0) + 8 * hh) * 2))
#define LDP(img, pitch, rowb, k0) ldsfrag_perm((img) + ((rowb) + q) * (pitch) + ((k0) + 4 * hh) * 2)
#define ZERO16(x) do { _Pragma("unroll") for (int r_ = 0; r_ < 16; ++r_) (x)[r_] = 0.f; } while (0)
#define MMAA(X, Y, Cacc) do { const bf16x8 xa_ = ACCF(X, 0), xb_ = ACCF(X, 1), ya_ = ACCF(Y, 0), yb_ = ACCF(Y, 1); Cacc = MF(xa_, ya_, Cacc); Cacc = MF(xb_, yb_, Cacc); } while (0)
#define PROGW(k) ((volatile LAS unsigned*)(lds + LDSCTL_OFF + 1024 + (k) * 64))
#define SPIN_UNTIL(cond) do { while (!(cond)) __builtin_amdgcn_s_sleep(1); asm volatile("" ::: "memory"); } while (0)
        constexpr int NCH = SEQ / 32;
        const int q = lane & 31, hh = lane >> 5;
        const bool run_scan = !(args.pad & 1);
        if (wave < 4 && run_scan) {
            const int sl = wave >> 1, ib = wave & 1;
            const int s = 2 * vcu + sl; const int d = s & 1, bh = s >> 1, b = bh >> 3, h = bh & 7;
            LAS unsigned char* sbase = lds + sl * 57856;
            LAS unsigned char* VT0 = lds + 115712 + wave * 5120;
            const LAS unsigned char* FR = lds + 136192 + sl * 8192;
            volatile LAS unsigned* progE = PROGW(wave); volatile LAS unsigned* ptE = PROGW(wave ^ 1); volatile LAS unsigned* progM = PROGW(4 + wave); volatile LAS unsigned* ptM = PROGW(4 + (wave ^ 1));
            volatile LAS unsigned* progF = PROGW(8 + wave); volatile LAS unsigned* progH = PROGW(12 + sl);
            const int cp = lane & 15, tq = lane >> 4;
            bf16* pY = RAW + d * 512 + h * 64 + ib * 32 + q;
            const unsigned tsel = d ? (unsigned)(3 - tq) : (unsigned)tq;
            const unsigned offS = tsel * 8u * 4096u + 64u * ib + 4u * cp, offT = tsel * 8u * 1024u + 64u * ib + 4u * cp;
            const unsigned oS = (unsigned)((d * 512 + h * 64) * 2), oT = (unsigned)(h * 128);
            unsigned pf[5][8], vq[8];
#define PF_TOK(cc, tl) ((unsigned)(b * SEQ + (d ? (SEQ - 1 - 32 * (cc) - (tl) - 24) : (32 * (cc) + (tl)))))
#define PF_ISSUE(cc, T0, T1) do { unsigned vS_ = offS, vT_ = offT; asm volatile("" : "+v"(vS_), "+v"(vT_));        \
            _Pragma("unroll") for (int tl = (T0); tl < (T1); ++tl) { const unsigned m0 = PF_TOK(cc, tl); \
                pf[0][tl] = *(const unsigned*)((ws + ((unsigned)WS_PR + oS + m0 * 4096u)) + vS_); pf[1][tl] = *(const unsigned*)((ws + ((unsigned)WS_PR + 2048u + oS + m0 * 4096u)) + vS_); pf[2][tl] = *(const unsigned*)((ws + ((unsigned)WS_KK + oT + m0 * 1024u)) + vT_); \
                pf[3][tl] = *(const unsigned*)((ws + ((unsigned)WS_K + oT + m0 * 1024u)) + vT_); pf[4][tl] = *(const unsigned*)((ws + ((unsigned)WS_R + oT + m0 * 1024u)) + vT_); } } while (0)
            PF_ISSUE(0, 0, 8);
            { unsigned vT_ = offT; asm volatile("" : "+v"(vT_));
#pragma unroll
              for (int tl = 0; tl < 8; ++tl) { const unsigned m0 = PF_TOK(0, tl); vq[tl] = *(const unsigned*)((ws + ((unsigned)WS_V + oT + m0 * 1024u)) + vT_); } }
            f32x16 H0a, H0b; ZERO16(H0a); ZERO16(H0b);
            for (int it = 0; it <= NCH; ++it) {
                if (it < NCH) {
                    LAS unsigned char* KQ = sbase + (it & 1) * 28928, *RQ = KQ + 4608, *KKI = KQ + 9216, *BKI = KQ + 13824, *KCT = KQ + 18432, *BCT = KQ + 23552; LAS float* GC = (LAS float*)(KQ + 28672);
                    LAS unsigned char* VTI = VT0 + (it & 1) * 2560;
                    if (it >= 2) SPIN_UNTIL(*progH + 1u >= (unsigned)it && *ptM + 1u >= (unsigned)it);
                    {
                    const float ka0 = k_a[h * 64 + 32 * ib + 2 * cp], ka1 = k_a[h * 64 + 32 * ib + 2 * cp + 1];
                    const float rk0 = r_k[h * 64 + 32 * ib + 2 * cp], rk1 = r_k[h * 64 + 32 * ib + 2 * cp + 1];
                    const int cn = it + 1 < NCH ? it + 1 : it;
                    unsigned nS_ = offS, nT_ = offT; asm volatile("" : "+v"(nS_), "+v"(nT_));
                    float t0 = 0.f, t1 = 0.f;
#pragma unroll
                    for (int tl = 0; tl < 8; ++tl) { t0 += bflo(pf[0][tl]); t1 += bfhi(pf[0][tl]); }
                    t0 *= -0.6065306597f; t1 *= -0.6065306597f;
                    float o0, o1, tot0, tot1;
                    {   const auto a0_ = __builtin_amdgcn_permlane16_swap(__float_as_uint(t0), __float_as_uint(t0), false, false), a1_ = __builtin_amdgcn_permlane16_swap(__float_as_uint(t1), __float_as_uint(t1), false, false);
                        const float n0 = (tq & 1) ? __uint_as_float(a0_[0]) : __uint_as_float(a0_[1]), n1 = (tq & 1) ? __uint_as_float(a1_[0]) : __uint_as_float(a1_[1]);
                        const float p0 = t0 + n0, p1 = t1 + n1;
                        const auto b0_ = __builtin_amdgcn_permlane32_swap(__float_as_uint(p0), __float_as_uint(p0), false, false), b1_ = __builtin_amdgcn_permlane32_swap(__float_as_uint(p1), __float_as_uint(p1), false, false);
                        const float q0 = (tq & 2) ? __uint_as_float(b0_[0]) : __uint_as_float(b0_[1]), q1 = (tq & 2) ? __uint_as_float(b1_[0]) : __uint_as_float(b1_[1]);
                        o0 = ((tq & 1) ? n0 : 0.f) + ((tq & 2) ? q0 : 0.f); o1 = ((tq & 1) ? n1 : 0.f) + ((tq & 2) ? q1 : 0.f); tot0 = p0 + q0; tot1 = p1 + q1; }
                    const float gC0 = __expf(tot0), gC1 = __expf(tot1);
                    float L0 = o0, L1 = o1; float eLp0 = __expf(L0), eLp1 = __expf(L1);
                    if (tq == 0) { GC[32 * ib + 2 * cp] = gC0; GC[32 * ib + 2 * cp + 1] = gC1; }
                    float bpk = 0.f;
#pragma unroll
                    for (int t2 = 0; t2 < 4; ++t2) {
                        float kc0[2], kc1[2], bc0[2], bc1[2];
#pragma unroll
                        for (int e = 0; e < 2; ++e) { const int tl = 2 * t2 + e, tau = 8 * tq + tl;
                            const float sg0 = bflo(pf[0][tl]), sg1 = bfhi(pf[0][tl]), a0_ = bflo(pf[1][tl]), a1_ = bfhi(pf[1][tl]), kk0 = bflo(pf[2][tl]), kk1 = bfhi(pf[2][tl]);
                            const float k0_ = bflo(pf[3][tl]), k1_ = bfhi(pf[3][tl]), r0_ = bflo(pf[4][tl]), r1_ = bfhi(pf[4][tl]);
                            L0 += -0.6065306597f * sg0; L1 += -0.6065306597f * sg1;
                            const float eL0 = __expf(L0), eL1 = __expf(L1), en0 = __builtin_amdgcn_rcpf(eL0), en1 = __builtin_amdgcn_rcpf(eL1);
                            const float kd0 = k0_ * (1.0f + (a0_ - 1.0f) * ka0), kd1 = k1_ * (1.0f + (a1_ - 1.0f) * ka1);
                            const float kkf0 = kd0 * en0, kkf1 = kd1 * en1, bkf0 = kk0 * a0_ * en0, bkf1 = kk1 * a1_ * en1;
                            {
                                float bp = r0_ * kd0 * rk0 + r1_ * kd1 * rk1;
                                bp += __shfl_xor(bp, 1); bp += __shfl_xor(bp, 2); bp += __shfl_xor(bp, 4); bp += __shfl_xor(bp, 8);
                                bpk = (cp == tl) ? bp : bpk; }
                            ((LAS unsigned*)KQ)[tau * 36 + 16 * ib + cp] = pg8::cvt_pk_bf16(kk0 * eLp0, kk1 * eLp1); ((LAS unsigned*)RQ)[tau * 36 + 16 * ib + cp] = pg8::cvt_pk_bf16(r0_ * eL0, r1_ * eL1);
                            ((LAS unsigned*)KKI)[tau * 36 + 16 * ib + cp] = pg8::cvt_pk_bf16(kkf0, kkf1); ((LAS unsigned*)BKI)[tau * 36 + 16 * ib + cp] = pg8::cvt_pk_bf16(bkf0, bkf1);
                            kc0[e] = kkf0 * gC0; kc1[e] = kkf1 * gC1; bc0[e] = -bkf0 * gC0; bc1[e] = -bkf1 * gC1;
                            eLp0 = eL0; eLp1 = eL1;
                            { const unsigned m0 = PF_TOK(cn, tl);
                              pf[0][tl] = *(const unsigned*)((ws + ((unsigned)WS_PR + oS + m0 * 4096u)) + nS_); pf[1][tl] = *(const unsigned*)((ws + ((unsigned)WS_PR + 2048u + oS + m0 * 4096u)) + nS_); pf[2][tl] = *(const unsigned*)((ws + ((unsigned)WS_KK + oT + m0 * 1024u)) + nT_);
                              pf[3][tl] = *(const unsigned*)((ws + ((unsigned)WS_K + oT + m0 * 1024u)) + nT_); pf[4][tl] = *(const unsigned*)((ws + ((unsigned)WS_R + oT + m0 * 1024u)) + nT_); } }
                        const int sp = 4 * tq + t2;
                        const int j0 = 32 * ib + 2 * cp;
                        ((LAS unsigned*)KCT)[j0 * 20 + sp] = pg8::cvt_pk_bf16(kc0[0], kc0[1]); ((LAS unsigned*)KCT)[(j0 + 1) * 20 + sp] = pg8::cvt_pk_bf16(kc1[0], kc1[1]);
                        ((LAS unsigned*)BCT)[j0 * 20 + sp] = pg8::cvt_pk_bf16(bc0[0], bc0[1]); ((LAS unsigned*)BCT)[(j0 + 1) * 20 + sp] = pg8::cvt_pk_bf16(bc1[0], bc1[1]);
                    }
                    if (cp < 8) { const int tt_ = 32 * it + 8 * tq + cp; const size_t mt_ = (size_t)b * SEQ + (d ? (SEQ - 1 - tt_) : tt_); BP4[((size_t)(d * 2 + ib) * M + mt_) * 8 + h] = bpk; }
#pragma unroll
                    for (int t2 = 0; t2 < 4; ++t2) { const int sp = 4 * tq + t2; const unsigned va = vq[2 * t2], vb = vq[2 * t2 + 1];
                        ((LAS unsigned*)VTI)[(2 * cp) * 20 + sp] = (va & 0xffffu) | (vb << 16); ((LAS unsigned*)VTI)[(2 * cp + 1) * 20 + sp] = (va >> 16) | (vb & 0xffff0000u); }
#pragma unroll
                    for (int tl = 0; tl < 8; ++tl) { const unsigned m0 = PF_TOK(cn, tl); vq[tl] = *(const unsigned*)((ws + ((unsigned)WS_V + oT + m0 * 1024u)) + nT_); }
                }
                    asm volatile("s_waitcnt lgkmcnt(0)" ::: "memory");
                    *progE = (unsigned)(it + 1);
                }
                if (it >= 1) {
                    const int c = it - 1;
                    const LAS unsigned char* KQ = sbase + (c & 1) * 28928, *RQ = KQ + 4608, *KCT = KQ + 18432, *BCT = KQ + 23552; const LAS float* GC = (const LAS float*)(KQ + 28672);
                    const LAS unsigned char* VTI = VT0 + (c & 1) * 2560;
                    SPIN_UNTIL(*ptE >= (unsigned)(c + 1));
                    f32x16 Zacc, Yacc, U; ZERO16(Zacc); ZERO16(Yacc); ZERO16(U);
                    const bf16x8 h0f0 = ACCF(H0a, 0), h0f1 = ACCF(H0a, 1), h0f2 = ACCF(H0b, 0), h0f3 = ACCF(H0b, 1);
                    Zacc = MF(LDP(KQ, 144, 0, 0), h0f0, Zacc); Zacc = MF(LDP(KQ, 144, 0, 16), h0f1, Zacc); Zacc = MF(LDP(KQ, 144, 0, 32), h0f2, Zacc); Zacc = MF(LDP(KQ, 144, 0, 48), h0f3, Zacc);
                    Yacc = MF(LDP(RQ, 144, 0, 0), h0f0, Yacc); Yacc = MF(LDP(RQ, 144, 0, 16), h0f1, Yacc); Yacc = MF(LDP(RQ, 144, 0, 32), h0f2, Yacc); Yacc = MF(LDP(RQ, 144, 0, 48), h0f3, Yacc);
#pragma unroll
                    for (int r_ = 0; r_ < 16; ++r_) { const int row_ = (r_ & 3) + 8 * (r_ >> 2) + 4 * hh; H0a[r_] *= GC[row_]; H0b[r_] *= GC[32 + row_]; }
                    H0a = MF(LDN(KCT, 80, 0, 0), LDN(VTI, 80, 0, 0), H0a); H0a = MF(LDN(KCT, 80, 0, 16), LDN(VTI, 80, 0, 16), H0a);
                    H0b = MF(LDN(KCT, 80, 32, 0), LDN(VTI, 80, 0, 0), H0b); H0b = MF(LDN(KCT, 80, 32, 16), LDN(VTI, 80, 0, 16), H0b);
                    SPIN_UNTIL(*progH >= (unsigned)(c + 1));
                    bf16x8 fr[8];
#pragma unroll
                    for (int f = 0; f < 8; ++f) fr[f] = *(const LAS bf16x8*)(FR + f * 1024 + lane * 16);
                    asm volatile("s_waitcnt lgkmcnt(0)" ::: "memory");
                    *progF = (unsigned)(c + 1);
                    Zacc = MF(fr[2], LDP(VTI, 80, 0, 0), Zacc); Zacc = MF(fr[3], LDP(VTI, 80, 0, 16), Zacc);
                    Yacc = MF(fr[4], LDP(VTI, 80, 0, 0), Yacc); Yacc = MF(fr[5], LDP(VTI, 80, 0, 16), Yacc);
                    U = MF(fr[0], ACCF(Zacc, 0), U); U = MF(fr[1], ACCF(Zacc, 1), U);
                    { const bf16x8 u0 = ACCF(U, 0), u1 = ACCF(U, 1);
                      Yacc = MF(fr[6], u0, Yacc); Yacc = MF(fr[7], u1, Yacc);
#pragma unroll
                      for (int r_ = 0; r_ < 16; ++r_) { const int tt = 32 * c + (r_ & 3) + 8 * (r_ >> 2) + 4 * hh; const size_t m = (size_t)b * SEQ + (d ? (SEQ - 1 - tt) : tt);
                          pY[m * 2048] = (bf16)(cvtpk_c(Yacc[r_], 0.f) & 0xffffu); }
                      H0a = MF(LDP(BCT, 80, 0, 0), u0, H0a); H0a = MF(LDP(BCT, 80, 0, 16), u1, H0a);
                      H0b = MF(LDP(BCT, 80, 32, 0), u0, H0b); H0b = MF(LDP(BCT, 80, 32, 16), u1, H0b); }
                    asm volatile("s_waitcnt lgkmcnt(0)" ::: "memory");
                    *progM = (unsigned)(c + 1);
                }
            }
#undef PF_ISSUE
#undef PF_TOK
        } else if (wave < 6 && run_scan) {
            const int sl = wave - 4;
            const LAS unsigned char* sbase = lds + sl * 57856;
            LAS unsigned char* FR = lds + 136192 + sl * 8192;
            volatile LAS unsigned* pE0 = PROGW(2 * sl), *pE1 = PROGW(2 * sl + 1), *pF0 = PROGW(8 + 2 * sl), *pF1 = PROGW(8 + 2 * sl + 1); volatile LAS unsigned* progH = PROGW(12 + sl);
            for (int c = 0; c < NCH; ++c) {
                const LAS unsigned char* KQ = sbase + (c & 1) * 28928, *RQ = KQ + 4608, *KKI = KQ + 9216, *BKI = KQ + 13824;
                SPIN_UNTIL(*pE0 >= (unsigned)(c + 1) && *pE1 >= (unsigned)(c + 1));
                f32x16 Rm, P, Pt, Rt, Aa, Ar, Ab;
                ZERO16(P); ZERO16(Pt); ZERO16(Aa); ZERO16(Ar); ZERO16(Ab);
#pragma unroll
                for (int ks = 0; ks < 4; ++ks) { const bf16x8 fb = LDN(BKI, 144, 0, 16 * ks), fq = LDN(KQ, 144, 0, 16 * ks), fk = LDN(KKI, 144, 0, 16 * ks), frq = LDN(RQ, 144, 0, 16 * ks);
                    P = MF(fb, fq, P); Pt = MF(fq, fb, Pt); Aa = MF(fk, fq, Aa); Ar = MF(fk, frq, Ar); Ab = MF(fb, frq, Ab); }
#pragma unroll
                for (int r_ = 0; r_ < 16; ++r_) { const int row_ = (r_ & 3) + 8 * (r_ >> 2) + 4 * hh; P[r_] = row_ < q ? -P[r_] : 0.f; Pt[r_] = row_ > q ? -Pt[r_] : 0.f; Rm[r_] = P[r_] + (row_ == q ? 1.0f : 0.f); Rt[r_] = Pt[r_] + (row_ == q ? 1.0f : 0.f);
                    Aa[r_] = row_ < q ? Aa[r_] : 0.f; Ar[r_] = row_ <= q ? Ar[r_] : 0.f; Ab[r_] = row_ <= q ? -Ab[r_] : 0.f; }
                const bf16x8 fa0 = ACCF(Aa, 0), fa1 = ACCF(Aa, 1), fr0 = ACCF(Ar, 0), fr1 = ACCF(Ar, 1), fb0 = ACCF(Ab, 0), fb1 = ACCF(Ab, 1);
#pragma unroll
                for (int k = 0; k < 4; ++k) {
                    f32x16 P2; ZERO16(P2); MMAA(Pt, P, P2);
                    MMAA(Rt, P2, Rm);
                    if (k < 3) { f32x16 P2t; ZERO16(P2t); MMAA(P, Pt, P2t); MMAA(P2, Rt, Rt); Pt = P2t; }
                    P = P2;
                }
                const bf16x8 ft0 = ACCF(Rm, 0), ft1 = ACCF(Rm, 1);
                asm volatile("s_waitcnt lgkmcnt(0)" ::: "memory");
                if (c >= 1) SPIN_UNTIL(*pF0 >= (unsigned)c && *pF1 >= (unsigned)c);
                *(LAS bf16x8*)(FR + 0 * 1024 + lane * 16) = ft0; *(LAS bf16x8*)(FR + 1 * 1024 + lane * 16) = ft1; *(LAS bf16x8*)(FR + 2 * 1024 + lane * 16) = fa0; *(LAS bf16x8*)(FR + 3 * 1024 + lane * 16) = fa1;
                *(LAS bf16x8*)(FR + 4 * 1024 + lane * 16) = fr0; *(LAS bf16x8*)(FR + 5 * 1024 + lane * 16) = fr1; *(LAS bf16x8*)(FR + 6 * 1024 + lane * 16) = fb0; *(LAS bf16x8*)(FR + 7 * 1024 + lane * 16) = fb1;
                asm volatile("s_waitcnt lgkmcnt(0)" ::: "memory");
                *progH = (unsigned)(c + 1);
            }
        }
        if (!(args.pad & 2)) {
            const int b = vcu >> 3, kvh = (vcu >> 2) & 1, qseg = vcu & 3;
            const bf16* kb0 = KB + ((size_t)(b * 2 + kvh) * 64) * 4 * 64 * 8 + lane * 8;
            const bf16* vb0 = VB + ((size_t)(b * 2 + kvh) * 64) * 4 * 64 * 8 + lane * 8;
            LAS unsigned* qctr = (LAS unsigned*)(lds + LDSCTL_OFF + 1024 + 14 * 64);
#define ATT_LOAD(kt_, KF, VF) do { _Pragma("unroll") for (int ks = 0; ks < 4; ++ks) KF[ks] = *(const bf16x8*)(kb0 + (size_t)((kt_) * 4 + ks) * 512); \
                _Pragma("unroll") for (int mb = 0; mb < 2; ++mb) _Pragma("unroll") for (int k2 = 0; k2 < 2; ++k2) VF[mb][k2] = *(const bf16x8*)(vb0 + (size_t)((kt_) * 4 + mb * 2 + k2) * 512); } while (0)
            for (;;) {
                unsigned e_ = 0; if (lane == 0) e_ = __hip_atomic_fetch_add(qctr, 1u, __ATOMIC_RELAXED, __HIP_MEMORY_SCOPE_WORKGROUP);
                const int e = __builtin_amdgcn_readfirstlane((int)e_);
                if (e >= 64) break;
                const int g = e & 3, qb = qseg * 16 + (e >> 2), hq = kvh * 4 + g;
                const int t = 32 * qb + q;
                const float slope = exp2f(-(float)(hq + 1));
                bf16* qrow = PA + ((size_t)b * SEQ + t) * ACOLS + hq * 64;
                bf16x8 qf[4];
#pragma unroll
                for (int ks = 0; ks < 4; ++ks) qf[ks] = *(const bf16x8*)(qrow + 16 * ks + 8 * hh);
                float mrun = sink[hq], lrun = 1.0f;
                f32x16 O0, O1; ZERO16(O0); ZERO16(O1);
                const int kt0 = qb - 4 < 0 ? 0 : qb - 4, kt1 = qb + 4 > 63 ? 63 : qb + 4;
                float nb[16];
#pragma unroll
                for (int r = 0; r < 16; ++r) nb[r] = slope * (float)(q - 4 * hh - ((r & 3) + 8 * (r >> 2)));
                bf16x8 kfA[4], vfA[2][2], kfB[4], vfB[2][2];
#define ATT_TILE(kt_, KF, VF) do { \
                    f32x16 acc; ZERO16(acc); \
                    _Pragma("unroll") for (int ks = 0; ks < 4; ++ks) acc = MF(KF[ks], qf[ks], acc); \
                      \
                    const int dlt = qb - (kt_); float sc[16]; float mx = -1e30f; \
                    if (dlt > 0) { _Pragma("unroll") for (int r = 0; r < 16; ++r) sc[r] = acc[r] * 0.125f - nb[r]; \
                        if (dlt == 4) { _Pragma("unroll") for (int r = 0; r < 16; ++r) sc[r] = nb[r] <= 0.f ? sc[r] : -1e30f; } } \
                    else if (dlt < 0) { _Pragma("unroll") for (int r = 0; r < 16; ++r) sc[r] = acc[r] * 0.125f + nb[r]; \
                        if (dlt == -4) { _Pragma("unroll") for (int r = 0; r < 16; ++r) sc[r] = nb[r] >= 0.f ? sc[r] : -1e30f; } } \
                    else { _Pragma("unroll") for (int r = 0; r < 16; ++r) sc[r] = acc[r] * 0.125f - fabsf(nb[r]); } \
                    const float coff = slope * 32.0f * (float)(dlt < 0 ? -dlt : dlt); \
                    _Pragma("unroll") for (int r = 0; r < 16; ++r) mx = fmaxf(mx, sc[r]); \
                    { const auto rr_ = __builtin_amdgcn_permlane32_swap(__float_as_uint(mx), __float_as_uint(mx), false, false); mx = fmaxf(__uint_as_float(rr_[0]), __uint_as_float(rr_[1])) - coff; }     \
                    const float mn = fmaxf(mrun, mx), alpha = __expf(mrun - mn); mrun = mn; \
                    const float sh = mn + coff; float rs = 0.f; \
                    _Pragma("unroll") for (int r = 0; r < 16; ++r) { sc[r] = __expf(sc[r] - sh); rs += sc[r]; } \
                    lrun = lrun * alpha + rs;                                  \
                    bf16x8 pb[2]; \
                    _Pragma("unroll") for (int k2 = 0; k2 < 2; ++k2) pb[k2] = __builtin_bit_cast(bf16x8, (v4u){cvtpk_c(sc[8 * k2 + 0], sc[8 * k2 + 1]), cvtpk_c(sc[8 * k2 + 2], sc[8 * k2 + 3]), cvtpk_c(sc[8 * k2 + 4], sc[8 * k2 + 5]), cvtpk_c(sc[8 * k2 + 6], sc[8 * k2 + 7])}); \
                    if (__ballot(alpha != 1.0f) != 0ull) { _Pragma("unroll") for (int r = 0; r < 16; ++r) { O0[r] *= alpha; O1[r] *= alpha; } } \
                    _Pragma("unroll") for (int k2 = 0; k2 < 2; ++k2) { O0 = MF(VF[0][k2], pb[k2], O0); O1 = MF(VF[1][k2], pb[k2], O1); } } while (0)
                ATT_LOAD(kt0, kfA, vfA);
                for (int kt = kt0; kt <= kt1; kt += 2) {
                    if (kt + 1 <= kt1) ATT_LOAD(kt + 1, kfB, vfB);
                    ATT_TILE(kt, kfA, vfA);
                    if (kt + 1 <= kt1) {
                        if (kt + 2 <= kt1) ATT_LOAD(kt + 2, kfA, vfA);
                        ATT_TILE(kt + 1, kfB, vfB);
                    }
                }
#undef ATT_TILE
                { const auto rr_ = __builtin_amdgcn_permlane32_swap(__float_as_uint(lrun), __float_as_uint(lrun), false, false); lrun = __uint_as_float(rr_[0]) + __uint_as_float(rr_[1]) - __expf(sink[hq] - mrun); }
                const float inv = __builtin_amdgcn_rcpf(lrun);
                const bf16* grow = PA + ((size_t)b * SEQ + t) * ACOLS + 768 + hq * 64;
#pragma unroll
                for (int mb = 0; mb < 2; ++mb)
#pragma unroll
                    for (int r4 = 0; r4 < 4; ++r4) { const int dd = mb * 32 + 8 * r4 + 4 * hh;
                        const uint2 gq = *(const uint2*)(grow + dd);
                        const float g0 = bflo(gq.x), g1 = bfhi(gq.x), g2 = bflo(gq.y), g3 = bfhi(gq.y);
                        const float o0 = (mb ? O1[4 * r4 + 0] : O0[4 * r4 + 0]) * inv, o1 = (mb ? O1[4 * r4 + 1] : O0[4 * r4 + 1]) * inv, o2 = (mb ? O1[4 * r4 + 2] : O0[4 * r4 + 2]) * inv, o3 = (mb ? O1[4 * r4 + 3] : O0[4 * r4 + 3]) * inv;
                        *(uint2*)(qrow + dd) = make_uint2(cvtpk_c(o0 * g0 * pg8::sigm(g0), o1 * g1 * pg8::sigm(g1)), cvtpk_c(o2 * g2 * pg8::sigm(g2), o3 * g3 * pg8::sigm(g3))); }
            }
#undef ATT_LOAD
        }
#undef MF
#undef ACCF
#undef LDN
#undef LDP
#undef ZERO16
#undef MMAA
#undef PROGW
#undef SPIN_UNTIL
        if (BOTH(6)) GRID_BAR();
    }
    if (IN(7)) { PTRS
        {
            const int c0 = 8 * lane;
            v4u q8[4], q8n[4]; float bsn = 0.f;
#define P7_LOAD(mm, Q, B) do { const bf16* rr_ = RAW + (size_t)(mm) * 2048 + c0; Q[0] = *(const v4u*)(rr_); Q[1] = *(const v4u*)(rr_ + 512); \
                Q[2] = *(const v4u*)(Vb + (size_t)(mm) * RW + c0); Q[3] = *(const v4u*)(Gb + (size_t)(mm) * RW + c0); { const size_t bi_ = (size_t)(mm) * 8 + (lane >> 3); B = (BP4[bi_] + BP4[(size_t)M * 8 + bi_]) + (BP4[(size_t)2 * M * 8 + bi_] + BP4[(size_t)3 * M * 8 + bi_]); } } while (0)
            const f32x4 gwa = *(const f32x4*)(gnw + c0), gwb = *(const f32x4*)(gnw + c0 + 4), gba = *(const f32x4*)(gnb + c0), gbb = *(const f32x4*)(gnb + c0 + 4);
            const float gw8[8] = {gwa.x, gwa.y, gwa.z, gwa.w, gwb.x, gwb.y, gwb.z, gwb.w}, gb8[8] = {gba.x, gba.y, gba.z, gba.w, gbb.x, gbb.y, gbb.z, gbb.w};
            if (gw < M) P7_LOAD(gw, q8n, bsn);
            for (int m = gw; m < M; m += NGW) {
#pragma unroll
                for (int i = 0; i < 4; ++i) q8[i] = q8n[i];
                const float bs = bsn;
                if (m + NGW < M) P7_LOAD(m + NGW, q8n, bsn);
                float y0[8], y1[8], vf[8], gf[8], y[8];
                unpack8(q8[0], y0); unpack8(q8[1], y1); unpack8(q8[2], vf); unpack8(q8[3], gf);
                float s = 0.f;
#pragma unroll
                for (int e = 0; e < 8; ++e) { y[e] = y0[e] + y1[e]; s += y[e]; }
                s += __shfl_xor(s, 1); s += __shfl_xor(s, 2); s += __shfl_xor(s, 4);
                const float mean = s * (1.f / 64.f); float qq = 0.f;
#pragma unroll
                for (int e = 0; e < 8; ++e) { const float dd = y[e] - mean; qq += dd * dd; }
                qq += __shfl_xor(qq, 1); qq += __shfl_xor(qq, 2); qq += __shfl_xor(qq, 4);
                const float rstd = 1.0f / sqrtf(qq * (1.f / 64.f) + 64e-5f);
                float r[8];
#pragma unroll
                for (int e = 0; e < 8; ++e) { const float yn = (y[e] - mean) * rstd * gw8[e] + gb8[e]; r[e] = (yn + bs * vf[e]) * gf[e] * sigmoidf_(gf[e]); }
                *(v4u*)(Vb + (size_t)m * RW + c0) = pack8(r);
            }
#undef P7_LOAD
        }
        if (BOTH(7)) GRID_BAR();
    }
    if (IN(8)) { PTRS
        { pg8::Gemm g{Hb, WinT + (size_t)3584 * 1024, M, 2048, 1024, 1024}; pg8::StaticOrder S; S.init(M, 2048, G, bx);
          pg8::EpiFrag E{PGT, 8};
          pg8::gemm_phase<pg8::EpiFrag, pg8::StaticOrder, true, true>(lds, g, S, E); }
        if (BOTH(8)) GRID_BAR();
    }
    if (IN(9)) { PTRS
        { pg8::Gemm g{Vb, WbrrT, M, 1024, 512, 512}; pg8::StaticOrder S; S.init(M, 1024, G, bx);
          pg8::EpiGate<0> E{MG, PGT, Hb};
          pg8::gemm_phase<pg8::EpiGate<0>, pg8::StaticOrder, true, true>(lds, g, S, E); }
        { pg8::Gemm g{PA, WbraT, M, 1024, 512, ACOLS}; pg8::StaticOrder S; S.init(M, 1024, G, bx);
          pg8::EpiGate<1> E{MG, PGT, Hb};
          pg8::gemm_phase<pg8::EpiGate<1>, pg8::StaticOrder, true, true>(lds, g, S, E); }
        if (BOTH(9)) GRID_BAR();
    }
    if (IN(10)) { PTRS
        pg8::Gemm g{MG, WoutT, M, 1024, 1024, 1024}; pg8::StaticOrder S; S.init(M, 1024, G, bx);
        pg8::EpiRoute E{OUTB, OUTB, 1024, 1024, 1 << 20};
        pg8::gemm_phase<pg8::EpiRoute, pg8::StaticOrder, true, true>(lds, g, S, E);
        if (BOTH(10)) GRID_BAR();
    }
    if (IN(11)) { PTRS
        {
            v4u oq[2], oqn[2]; f32x4 xq[4], xqn[4];
#define P11_LOAD(mm, O, X) do { _Pragma("unroll") for (int j = 0; j < 2; ++j) { O[j] = *(const v4u*)(OUTB + (size_t)(mm) * 1024 + 8 * (lane + 64 * j)); \
                X[2 * j] = *(const f32x4*)(x + (size_t)(mm) * DM + 8 * (lane + 64 * j)); X[2 * j + 1] = *(const f32x4*)(x + (size_t)(mm) * DM + 8 * (lane + 64 * j) + 4); } } while (0)
            if (gw < M) P11_LOAD(gw, oqn, xqn);
            for (int m = gw; m < M; m += NGW) {
                const int b = m >> 11;
#pragma unroll
                for (int j = 0; j < 2; ++j) { oq[j] = oqn[j]; xq[2 * j] = xqn[2 * j]; xq[2 * j + 1] = xqn[2 * j + 1]; }
                if (m + NGW < M) P11_LOAD(m + NGW, oqn, xqn);
                float o[2][8]; float s = 0.f;
#pragma unroll
                for (int j = 0; j < 2; ++j) { unpack8(oq[j], o[j]);
#pragma unroll
                    for (int e = 0; e < 8; ++e) s += o[j][e] * o[j][e]; }
                const float rinv = 1.0f / sqrtf(wave_sum(s) * (1.f / DM) + 1e-6f);
#pragma unroll
                for (int j = 0; j < 2; ++j) { const int c = 8 * (lane + 64 * j);
#pragma unroll
                    for (int hlf = 0; hlf < 2; ++hlf) { const int cc = c + 4 * hlf;
                        const f32x4 gp = *(const f32x4*)(gpost + cc), gt = *(const f32x4*)(ADA + b * 3072 + 2048 + cc);
                        f32x4 ov; ov.x = o[j][4 * hlf + 0]; ov.y = o[j][4 * hlf + 1]; ov.z = o[j][4 * hlf + 2]; ov.w = o[j][4 * hlf + 3];
                        *(f32x4*)(out + (size_t)m * DM + cc) = xq[2 * j + hlf] + gt * (ov * rinv * gp); } }
            }
#undef P11_LOAD
        }
    }
#undef IN
#undef BOTH
#undef GRID_BAR
}

extern "C" void kernel_launch(void* const* d_in, const int* in_sizes, int n_in, void* d_out, int out_size, void* d_ws, size_t ws_size, hipStream_t stream) {
    static int grid = 0;
    if (grid == 0) {
        if (n_in != NIN || in_sizes[0] != M * DM || out_size != M * DM || ws_size < WS_END) { fprintf(stderr, "kernel_launch: unexpected shapes: n_in %d in0 %d out %d ws %zu (need %zu)\n", n_in, n_in > 0 ? in_sizes[0] : -1, out_size, ws_size, (size_t)WS_END); grid = -1; return; }
        int dev = 0, cus = 0;
        if (hipGetDevice(&dev) != hipSuccess || hipDeviceGetAttribute(&cus, hipDeviceAttributeMultiprocessorCount, dev) != hipSuccess) { fprintf(stderr, "kernel_launch: device query failed\n"); grid = -1; return; }
        if (hipFuncSetAttribute((const void*)mk_fwd, hipFuncAttributeMaxDynamicSharedMemorySize, LDS_BYTES) != hipSuccess) { fprintf(stderr, "kernel_launch: hipFuncSetAttribute failed\n"); grid = -1; return; }
        (void)hipGetLastError();
        grid = cus;
        if (grid != 256) fprintf(stderr, "kernel_launch: %d CUs (built for 256)\n", grid);
    }
    if (grid < 0) return;
    if (hipMemsetAsync((char*)d_ws + WS_CTL, 0, CTL_ZERO_BYTES, stream) != hipSuccess) { fprintf(stderr, "kernel_launch: memset failed\n"); return; }
    Args a{};
    for (int i = 0; i < NIN; ++i) a.in[i] = (const float*)d_in[i];
    a.out = (float*)d_out; a.ws = (unsigned char*)d_ws;
    static const int plan[][2] = MK_PLAN;
    const int nl = (int)(sizeof(plan) / sizeof(plan[0]));
    for (int li = 0; li < nl; ++li) {
        a.ph_lo = plan[li][0]; a.ph_hi = plan[li][1]; a.li = li; a.pad = (li < nl - 1) ? MK_PROBE_FLAGS : 0;
        hipLaunchKernelGGL(mk_fwd, dim3(grid), dim3(NWAVES * 64), LDS_BYTES, stream, a);
        const hipError_t le = hipPeekAtLastError();
        if (le != hipSuccess) { fprintf(stderr, "kernel_launch: launch %d failed: %s\n", li, hipGetErrorName(le)); break; }
    }
}
```
